# Optimizing an MI355X kernel written in HIP

```python
import jax, jax.numpy as jnp
from jax import lax
import numpy as np

D_MODEL = 1024
BATCH = 8
SEQ = 2048
DEPTH = 2
DEC_BATCH = 128
DEC_SEQ = 1
PAST_LEN = 16384
PAGE_SIZE = 128

N_MIXERS = 2
N_HGRN = (DEPTH + 1) // 2
N_POOL = DEPTH // 2
HGRN_EXPAND = 128
HGRN_HEADS = D_MODEL // HGRN_EXPAND
HGRN_DK = HGRN_EXPAND
HGRN_DV = D_MODEL // HGRN_HEADS
HGRN_KTOT = HGRN_HEADS * HGRN_DK
HGRN_VTOT = HGRN_HEADS * HGRN_DV
HGRN_CHUNK = 32
POOL_WINDOWS = (2, 4, 8, 16)
POOL_GROUPS = len(POOL_WINDOWS)
POOL_GW = D_MODEL // POOL_GROUPS
POOL_HIST = max(POOL_WINDOWS) - 1
D_FF = 4 * D_MODEL
EPS = 1e-6

kernel_name = "hgrn2_pool_interleaved_decode_step"


def _rmsnorm(x, g):
    xf = x.astype(jnp.float32)
    y = xf * lax.rsqrt(jnp.mean(xf * xf, axis=-1, keepdims=True) + EPS) * g.astype(jnp.float32)
    return y.astype(x.dtype)


def _gated_recurrence(q, k, v, g, s0):
    B, L, H, _ = q.shape
    C = min(HGRN_CHUNK, L)
    n = -(-L // C)
    Lp = n * C

    def chunks(a):
        a = jnp.pad(a, ((0, 0), (0, Lp - L), (0, 0), (0, 0)))
        return a.reshape(B, n, C, H, a.shape[-1]).swapaxes(0, 1)

    causal = jnp.tril(jnp.ones((C, C), dtype=bool))[None, :, :, None, None]

    def step(S, blk):
        qc, kc, vc, gc = blk
        G = jnp.cumsum(gc, axis=1)
        diff = G[:, :, None] - G[:, None, :]
        decay = jnp.exp(jnp.where(causal, diff, -jnp.inf))
        A = jnp.einsum('bthd,bshd,btshd->btsh', qc, kc, decay)
        o = (jnp.einsum('btsh,bshv->bthv', A, vc)
             + jnp.einsum('bthd,bhdv->bthv', qc * jnp.exp(G), S))
        G_last = G[:, -1]
        S = (jnp.exp(G_last)[..., None] * S
             + jnp.einsum('bshd,bshv->bhdv', kc * jnp.exp(G_last[:, None] - G), vc))
        return S, o

    S, o = lax.scan(step, s0, (chunks(q), chunks(k), chunks(v), chunks(g)))
    o = o.swapaxes(0, 1).reshape(B, Lp, H, v.shape[-1])[:, :L]
    return o, S


def _hgrn2(x, s0, norm_g, w_in, lb, onorm_g, w_out):
    B, L, _ = x.shape
    u = _rmsnorm(x, norm_g)
    proj = jnp.einsum('bld,de->ble', u, w_in).astype(jnp.float32)
    q, fz, inp, og = jnp.split(proj, [HGRN_KTOT, 2 * HGRN_KTOT, 2 * HGRN_KTOT + HGRN_VTOT], axis=-1)
    q = jax.nn.silu(q) * (HGRN_DK ** -0.5)
    f = lb + (1.0 - lb) * jax.nn.sigmoid(fz)
    k = 1.0 - f
    logf = jnp.log(f)
    hd = lambda a, d: a.reshape(B, L, HGRN_HEADS, d)
    o, s_new = _gated_recurrence(hd(q, HGRN_DK), hd(k, HGRN_DK), hd(inp, HGRN_DV),
                                 hd(logf, HGRN_DK), s0.astype(jnp.float32))
    o = o * lax.rsqrt(jnp.mean(o * o, axis=-1, keepdims=True) + EPS)
    o = o.reshape(B, L, HGRN_VTOT) * onorm_g.astype(jnp.float32) * jax.nn.sigmoid(og)
    y = jnp.einsum('ble,ed->bld', o.astype(x.dtype), w_out)
    return y, s_new.astype(s0.dtype)


def _pool(x, hist, start, norm_g, w_grp, scale):
    B, L, _ = x.shape
    u = _rmsnorm(x, norm_g)
    ext = jnp.concatenate([hist.astype(jnp.float32), u.astype(jnp.float32)], axis=1)
    cs = jnp.concatenate([jnp.zeros((B, 1, D_MODEL), jnp.float32), jnp.cumsum(ext, axis=1)], axis=1)
    P = POOL_HIST
    pos = start + jnp.arange(L)
    parts = []
    for gi, w in enumerate(POOL_WINDOWS):
        sl = slice(gi * POOL_GW, (gi + 1) * POOL_GW)
        hi = cs[:, P + 1:P + 1 + L, sl]
        lo = cs[:, P + 1 - w:P + 1 - w + L, sl]
        cnt = jnp.minimum(w, pos + 1).astype(jnp.float32)[None, :, None]
        parts.append((hi - lo) / cnt)
    pooled = jnp.concatenate(parts, axis=-1)
    z = (pooled - u.astype(jnp.float32)).reshape(B, L, POOL_GROUPS, POOL_GW)
    y = jnp.einsum('blgc,gcd->blgd', z.astype(x.dtype), w_grp).reshape(B, L, D_MODEL) * scale
    return y.astype(x.dtype), ext[:, -P:].astype(hist.dtype)


def _mlp(x, norm_g, w_up, w_down):
    h = _rmsnorm(x, norm_g)
    a = jnp.square(jax.nn.relu(jnp.einsum('bld,df->blf', h, w_up)))
    return jnp.einsum('blf,fd->bld', a, w_down)


def _trunk(x, s_hgrn, hist_pool, start, lbs, params):
    (hgrn_norm, hgrn_w_in, hgrn_onorm, hgrn_w_out, pool_norm, pool_w, pool_scale,
     mlp_norm, mlp_up, mlp_down, final_norm) = params
    new_h, new_p = [], []
    for layer in range(DEPTH):
        j = layer // N_MIXERS
        if layer % N_MIXERS == 0:
            y, s = _hgrn2(x, s_hgrn[j], hgrn_norm[j], hgrn_w_in[j], lbs[j], hgrn_onorm[j], hgrn_w_out[j])
            new_h.append(s)
        else:
            y, h = _pool(x, hist_pool[j], start, pool_norm[j], pool_w[j], pool_scale[j])
            new_p.append(h)
        x = x + y
        x = x + _mlp(x, mlp_norm[layer], mlp_up[layer], mlp_down[layer])
    return _rmsnorm(x, final_norm), jnp.stack(new_h), jnp.stack(new_p)


def setup_inputs(seed: int = 0) -> dict:
    key = jax.random.key(seed)
    ks = jax.random.split(key, 20)
    nrm = lambda k, shape, s: jax.random.normal(k, shape, jnp.float32) * s
    gain = lambda k, shape: 1.0 + nrm(k, shape, 0.05)
    return {
        "x_prompt": nrm(ks[0], (BATCH, SEQ, D_MODEL), 1.0),
        "x_sample": nrm(ks[1], (DEC_BATCH, DEC_SEQ, D_MODEL), 1.0),
        "state_hgrn": nrm(ks[2], (N_HGRN, DEC_BATCH, HGRN_HEADS, HGRN_DK, HGRN_DV), 0.5),
        "state_pool": nrm(ks[3], (N_POOL, DEC_BATCH, POOL_HIST, D_MODEL), 1.0),
        "hgrn_norm": gain(ks[4], (N_HGRN, D_MODEL)),
        "hgrn_w_in": nrm(ks[5], (N_HGRN, D_MODEL, 2 * HGRN_KTOT + 2 * HGRN_VTOT), D_MODEL ** -0.5),
        "hgrn_lb": nrm(ks[6], (N_HGRN + 1, HGRN_KTOT), 0.1),
        "hgrn_onorm": gain(ks[7], (N_HGRN, HGRN_VTOT)),
        "hgrn_w_out": nrm(ks[8], (N_HGRN, HGRN_VTOT, D_MODEL), HGRN_VTOT ** -0.5),
        "pool_norm": gain(ks[9], (N_POOL, D_MODEL)),
        "pool_w": nrm(ks[10], (N_POOL, POOL_GROUPS, POOL_GW, POOL_GW), POOL_GW ** -0.5),
        "pool_scale": gain(ks[11], (N_POOL, D_MODEL)),
        "mlp_norm": gain(ks[12], (DEPTH, D_MODEL)),
        "mlp_up": nrm(ks[13], (DEPTH, D_MODEL, D_FF), D_MODEL ** -0.5),
        "mlp_down": nrm(ks[14], (DEPTH, D_FF, D_MODEL), D_FF ** -0.5),
        "final_norm": gain(ks[15], (D_MODEL,)),
    }


def reference(x_prompt, x_sample, state_hgrn, state_pool, hgrn_norm, hgrn_w_in, hgrn_lb, hgrn_onorm,
              hgrn_w_out, pool_norm, pool_w, pool_scale, mlp_norm, mlp_up, mlp_down, final_norm):
    lbs = jnp.cumsum(jax.nn.softmax(hgrn_lb.astype(jnp.float32), axis=0), axis=0)[:N_HGRN]
    params = (hgrn_norm, hgrn_w_in, hgrn_onorm, hgrn_w_out, pool_norm, pool_w, pool_scale,
              mlp_norm, mlp_up, mlp_down, final_norm)
    b = x_prompt.shape[0]
    s0 = jnp.zeros((N_HGRN, b, HGRN_HEADS, HGRN_DK, HGRN_DV), state_hgrn.dtype)
    h0 = jnp.zeros((N_POOL, b, POOL_HIST, D_MODEL), state_pool.dtype)
    y_prompt, hgrn_p, pool_p = _trunk(x_prompt, s0, h0, 0, lbs, params)
    y_sample, hgrn_s, pool_s = _trunk(x_sample, state_hgrn, state_pool, PAST_LEN, lbs, params)
    return (y_prompt, y_sample, hgrn_p, hgrn_s, pool_p, pool_s)
```

```cpp
#include <hip/hip_runtime.h>
#include <hip/hip_cooperative_groups.h>
#include <cstdio>
namespace cg = cooperative_groups;

#define LAS __attribute__((address_space(3)))
typedef unsigned short bf16_t;
typedef short bf16x8 __attribute__((ext_vector_type(8)));
typedef float f32x4 __attribute__((ext_vector_type(4)));
typedef float f32x2 __attribute__((ext_vector_type(2)));
typedef unsigned u32x4 __attribute__((ext_vector_type(4)));
typedef unsigned u32x2 __attribute__((ext_vector_type(2)));

#ifndef PHMASK
#define PHMASK 0x7ff
#endif
#ifndef DUP_PHASE
#define DUP_PHASE -1
#endif
#ifndef EXTRA_SYNCS
#define EXTRA_SYNCS 0
#endif
#ifndef MK_LAUNCHES
#define MK_LAUNCHES 1
#endif

constexpr int D = 1024, TP = 16384, TS = 128, MP = TP + TS, FF = 4096, SEQ = 2048;
constexpr float EPS = 1e-6f;
constexpr int NPHASE = 11;
constexpr int LDS_BYTES = 151552 + 16;

constexpr size_t WS_WIN = 0;
constexpr size_t WS_WOUT = WS_WIN + (size_t)4096 * 1024 * 2;
constexpr size_t WS_WUP0 = WS_WOUT + (size_t)1024 * 1024 * 2;
constexpr size_t WS_WDN0 = WS_WUP0 + (size_t)4096 * 1024 * 2;
constexpr size_t WS_WP = WS_WDN0 + (size_t)4096 * 1024 * 2;
constexpr size_t WS_WUP1 = WS_WP + (size_t)1024 * 256 * 2;
constexpr size_t WS_WDN1 = WS_WUP1 + (size_t)4096 * 1024 * 2;
constexpr size_t WS_SSQ = WS_WDN1 + (size_t)4096 * 1024 * 2;
constexpr size_t WS_LB = WS_SSQ + 264192;
constexpr size_t WS_BAR = WS_SSQ + 268288;
constexpr size_t WS_R2 = WS_SSQ + 284672;
constexpr size_t ACT_B = (size_t)MP * 1024 * 2;
constexpr size_t WS_R1 = WS_R2 + ACT_B;
constexpr size_t WS_Q = WS_R1, WS_V = WS_R1 + ACT_B, WS_OG = WS_R1 + 2 * ACT_B, WS_G = WS_R1 + 3 * ACT_B;
constexpr size_t WS_H = WS_R1;
constexpr size_t WS_XB = WS_R1 + (size_t)MP * 4096 * 2;
constexpr size_t WS_END = WS_R1 + 5 * ACT_B;
constexpr size_t WS_PART = WS_END;
constexpr size_t PART_SLOT = (size_t)TP * 16 * 4 + (size_t)TS * 64 * 4;
constexpr size_t WS_END2 = WS_PART + 4 * PART_SLOT;
constexpr size_t WS_LSEG = WS_END2;
constexpr size_t WS_END3 = WS_LSEG + (size_t)64 * 3 * 16384 * 4;
constexpr size_t WS_DSEG = WS_SSQ;

constexpr size_t O_YP = 0, O_YS = 16777216, O_HP = 16908288, O_HS = 17956864, O_PP = 34734080, O_PS = 34856960;

struct Params {
    const float *x_prompt, *x_sample, *state_hgrn, *state_pool, *hgrn_norm, *hgrn_w_in, *hgrn_lb, *hgrn_onorm, *hgrn_w_out,
        *pool_norm, *pool_w, *pool_scale, *mlp_norm, *mlp_up, *mlp_down, *final_norm;
    float* out;
    unsigned char* ws;
    int ph_lo, ph_hi;
};

typedef __bf16 bf16x2_native __attribute__((ext_vector_type(2)));
__device__ __forceinline__ unsigned cvt_pk_bf16(float lo, float hi) { const f32x2 f = {lo, hi}; return __builtin_bit_cast(unsigned, __builtin_convertvector(f, bf16x2_native)); }
__device__ __forceinline__ float bf2f(bf16_t b) { return __uint_as_float(((unsigned)b) << 16); }
__device__ __forceinline__ float bflo(unsigned w) { return __uint_as_float(w << 16); }
__device__ __forceinline__ float bfhi(unsigned w) { return __uint_as_float(w & 0xffff0000u); }
__device__ __forceinline__ bf16_t f2bf(float f) { return (bf16_t)(cvt_pk_bf16(f, 0.f) & 0xffffu); }
typedef _Float16 half2_t __attribute__((ext_vector_type(2)));
__device__ __forceinline__ unsigned cvt_pk_f16(float a, float b) { half2_t h = {(_Float16)a, (_Float16)b}; return __builtin_bit_cast(unsigned, h); }
__device__ __forceinline__ f32x2 h2_to_f2(unsigned w) { const half2_t h = __builtin_bit_cast(half2_t, w); return (f32x2){(float)h[0], (float)h[1]}; }
__device__ __forceinline__ float sigmoidf_(float x) { return __builtin_amdgcn_rcpf(1.f + __expf(-x)); }
__device__ __forceinline__ float wave_sum(float v) {
#pragma unroll
    for (int o = 1; o < 64; o <<= 1) v += __shfl_xor(v, o);
    return v;
}
__device__ __forceinline__ float ein_elem(int type, float x, float lbc) {
    if (type == 0) return x * sigmoidf_(x) * 0.08838834764831845f;
    if (type == 1) return __builtin_amdgcn_logf(lbc + (1.f - lbc) * sigmoidf_(x)) * 0.6931471805599453f;
    if (type == 2) return x;
    return sigmoidf_(x);
}
__device__ __forceinline__ float lb_of(const float* lb, int c) { return 1.f / (1.f + __expf(lb[1024 + c] - lb[c])); }

namespace pg8 {
constexpr int BM = 256, BK = 64, HALF = 128, HTB = HALF * BK * 2, STAGE_BYTES = 8 * HTB, NXCD = 8, WGM = 8;
__host__ __device__ __forceinline__ int lds_byte(int r, int c) { const int st = (r >> 4) * 2 + (c >> 5), rr = r & 15, cc = c & 31, ob = rr * 64 + cc * 2; return st * 1024 + (ob ^ (((ob >> 9) & 1) << 5)); }
__host__ __device__ __forceinline__ void stage_rc(int b, int& R, int& C) { const int st = b / 1024, sb = b % 1024, swz = sb ^ (((sb >> 9) & 1) << 5); R = (st >> 1) * 16 + swz / 64; C = (st & 1) * 32 + (swz % 64) / 2; }
__host__ __device__ __forceinline__ int perm32(int rho) { const int n = rho >> 4, i = rho & 15; return 8 * (i >> 2) + 4 * n + (i & 3); }
struct Unit { int pm, pn; };
struct Gemm { const bf16_t* A; const bf16_t* Bt; int M, N, K, lda, agroup; };
struct StaticOrder {
    int nM, nN, nwg, G, c;
    __device__ void init(int M, int N, int G_, int c_) { nM = M / BM; nN = N / BM; nwg = nM * nN; G = G_; c = c_; }
    __device__ bool next(int i, Unit& u) const {
        const long L = (long)i * G + c; if (L >= nwg) return false;
        int wgid = (int)L; { const int q = nwg / NXCD, r = nwg % NXCD, xcd = wgid % NXCD, off = wgid / NXCD; wgid = (xcd < r ? xcd * (q + 1) : r * (q + 1) + (xcd - r) * q) + off; }
        const int nig = WGM * nN, gid = wgid / nig, fm = gid * WGM, gsz = (nM - fm) < WGM ? (nM - fm) : WGM;
        u.pm = fm + ((wgid % nig) % gsz); u.pn = (wgid % nig) / gsz; return true;
    }
};

template <class Epi>
__device__ __forceinline__ void gemm_phase(LAS unsigned char* lds, const Gemm g, const StaticOrder& S, const Epi& E) {
    int tid_ = threadIdx.x; asm volatile("" : "+v"(tid_));
    const int tid = tid_, wid = __builtin_amdgcn_readfirstlane(tid >> 6), lane = tid & 63, wr = wid >> 2, wc = wid & 3, fr = lane & 15, fq = lane >> 4;
    const int K = g.K, nt = K / BK, lda = g.lda;
    unsigned voffA[2], voffB[2];
#pragma unroll
    for (int i = 0; i < 2; ++i) { int R, C; stage_rc(tid * 16 + i * 8192, R, C); const int Rb = (R & ~31) + perm32(R & 31);
        voffA[i] = (unsigned)(R * lda + C) * 2u; voffB[i] = (unsigned)(Rb * K + C) * 2u; }
    const size_t kstep = (size_t)(BK * 2);
    const size_t hstepA = (size_t)HALF * lda * 2, hstepB = (size_t)HALF * K * 2;
    const size_t tstepA = 2 * hstepA, tstepB = 2 * hstepB;
    const unsigned ldsw = (unsigned)wid * 1024u;
    const int aoff = lds_byte(wr * 64 + fr, fq * 8), boff = lds_byte(wc * 32 + fr, fq * 8);
#define PG8_SA(b, h) (((b) * 2 + (h)) * HTB)
#define PG8_SB(b, h) ((4 + (b) * 2 + (h)) * HTB)
#define PG8_STAGE(bufoff, gbase, voff) do { _Pragma("unroll") for (int _i = 0; _i < 2; ++_i) \
        __builtin_amdgcn_global_load_lds((const unsigned*)((const char*)(gbase) + (voff)[_i]), (LAS unsigned*)(lds + (bufoff) + ldsw + _i * 8192), 16, 0, 0); } while (0)
#define PG8_LDA(dst, b, h) do { _Pragma("unroll") for (int m = 0; m < 4; ++m) _Pragma("unroll") for (int k = 0; k < 2; ++k) dst[m][k] = *(const LAS bf16x8*)(lds + PG8_SA(b, h) + aoff + m * 2048 + k * 1024); } while (0)
#define PG8_LDB(dst, b, h) do { _Pragma("unroll") for (int n = 0; n < 2; ++n) _Pragma("unroll") for (int k = 0; k < 2; ++k) dst[n][k] = *(const LAS bf16x8*)(lds + PG8_SB(b, h) + boff + n * 2048 + k * 1024); } while (0)
#define PG8_MMA(ai, bj, At, Bt) do { __builtin_amdgcn_s_setprio(1); _Pragma("unroll") for (int m = 0; m < 4; ++m) _Pragma("unroll") for (int n = 0; n < 2; ++n) _Pragma("unroll") for (int k = 0; k < 2; ++k) \
        acc[ai][bj][m][n] = __builtin_amdgcn_mfma_f32_16x16x32_bf16(Bt[n][k], At[m][k], acc[ai][bj][m][n], 0, 0, 0); __builtin_amdgcn_s_setprio(0); } while (0)
#define PG8_WAIT_V(n) asm volatile("s_waitcnt vmcnt(" #n ")" ::: "memory")
#define PG8_WAIT_L(n) asm volatile("s_waitcnt lgkmcnt(" #n ")" ::: "memory")
#define PG8_BAR __builtin_amdgcn_s_barrier()
#define PG8_SCHED __builtin_amdgcn_sched_barrier(0)
    Unit cur, nxt; int ui = 0;
    if (!S.next(0, cur)) return;
    f32x4 acc[2][2][4][2];
#pragma unroll
    for (int a = 0; a < 2; ++a)
#pragma unroll
        for (int b = 0; b < 2; ++b)
#pragma unroll
            for (int m = 0; m < 4; ++m)
#pragma unroll
                for (int n = 0; n < 2; ++n) acc[a][b][m][n] = (f32x4){0.f, 0.f, 0.f, 0.f};
    bf16x8 At[4][2], B0[2][2], B1[2][2];
    const char* cA = (const char*)g.A + (size_t)cur.pm * tstepA + (size_t)cur.pn * g.agroup * 2; const char* cB = (const char*)g.Bt + (size_t)cur.pn * tstepB;
    PG8_STAGE(PG8_SB(0, 0), cB, voffB); PG8_STAGE(PG8_SA(0, 0), cA, voffA); PG8_STAGE(PG8_SB(0, 1), cB + hstepB, voffB); PG8_STAGE(PG8_SA(0, 1), cA + hstepA, voffA);
    if (wr == 1) PG8_BAR;
    PG8_WAIT_V(4); PG8_BAR;
    PG8_STAGE(PG8_SB(1, 0), cB + kstep, voffB); PG8_STAGE(PG8_SA(1, 0), cA + kstep, voffA); PG8_STAGE(PG8_SB(1, 1), cB + hstepB + kstep, voffB);
    PG8_WAIT_V(6); PG8_BAR;
    for (;;) {
        const bool has_next = S.next(ui + 1, nxt);
        const char* nA = has_next ? (const char*)g.A + (size_t)nxt.pm * tstepA + (size_t)nxt.pn * g.agroup * 2 : cA; const char* nB = has_next ? (const char*)g.Bt + (size_t)nxt.pn * tstepB : cB;
        for (int t = 0; t < nt; t += 2) {
            const bool last = (t == nt - 2);
            const char* a1 = cA + (size_t)(t + 1) * kstep;
            const char* a2 = last ? nA : cA + (size_t)(t + 2) * kstep; const char* b2 = last ? nB : cB + (size_t)(t + 2) * kstep;
            const char* a3 = a2 + kstep; const char* b3 = b2 + kstep;
            PG8_LDB(B0, 0, 0); PG8_SCHED; PG8_LDA(At, 0, 0); PG8_STAGE(PG8_SA(1, 1), a1 + hstepA, voffA);
            PG8_WAIT_L(8); PG8_BAR; PG8_WAIT_L(0); PG8_MMA(0, 0, At, B0); PG8_BAR; PG8_SCHED;
            PG8_LDB(B1, 0, 1); PG8_STAGE(PG8_SB(0, 0), b2, voffB);
            PG8_BAR; PG8_WAIT_L(0); PG8_MMA(0, 1, At, B1); PG8_BAR;
            PG8_LDA(At, 0, 1); PG8_STAGE(PG8_SA(0, 0), a2, voffA);
            PG8_BAR; PG8_WAIT_L(0); PG8_MMA(1, 0, At, B0); PG8_BAR; PG8_SCHED;
            PG8_STAGE(PG8_SB(0, 1), b2 + hstepB, voffB);
            PG8_WAIT_V(6); PG8_BAR; PG8_MMA(1, 1, At, B1); PG8_BAR;
            PG8_LDB(B0, 1, 0); PG8_SCHED; PG8_LDA(At, 1, 0); PG8_STAGE(PG8_SA(0, 1), a2 + hstepA, voffA);
            PG8_WAIT_L(8); PG8_BAR; PG8_WAIT_L(0); PG8_MMA(0, 0, At, B0); PG8_BAR; PG8_SCHED;
            PG8_LDB(B1, 1, 1); PG8_STAGE(PG8_SB(1, 0), b3, voffB);
            PG8_BAR; PG8_WAIT_L(0); PG8_MMA(0, 1, At, B1); PG8_BAR;
            PG8_LDA(At, 1, 1); PG8_STAGE(PG8_SA(1, 0), a3, voffA);
            PG8_BAR; PG8_WAIT_L(0); PG8_MMA(1, 0, At, B0); PG8_BAR; PG8_SCHED;
            PG8_STAGE(PG8_SB(1, 1), b3 + hstepB, voffB);
            PG8_WAIT_V(6); PG8_BAR; PG8_MMA(1, 1, At, B1); PG8_BAR;
        }
        if constexpr (!Epi::AFTER_DRAIN) E(acc, cur, wr, wc, fr, fq);
        if (!has_next) break;
#pragma unroll
        for (int a = 0; a < 2; ++a)
#pragma unroll
            for (int b = 0; b < 2; ++b)
#pragma unroll
                for (int m = 0; m < 4; ++m)
#pragma unroll
                    for (int n = 0; n < 2; ++n) acc[a][b][m][n] = (f32x4){0.f, 0.f, 0.f, 0.f};
        cur = nxt; cA = nA; cB = nB; ++ui;
    }
    PG8_WAIT_V(0);
    if (wr == 0) PG8_BAR;
    PG8_BAR;
    if constexpr (Epi::AFTER_DRAIN) E.fused(acc, cur, wr, wc, fr, fq, lds);
#undef PG8_SA
#undef PG8_SB
#undef PG8_STAGE
#undef PG8_LDA
#undef PG8_LDB
#undef PG8_MMA
#undef PG8_WAIT_V
#undef PG8_WAIT_L
#undef PG8_BAR
#undef PG8_SCHED
}
}

struct EpiIn {
    static constexpr bool AFTER_DRAIN = false;
    bf16_t *Q, *V, *OG; bf16_t* G; const float* lb;
    __device__ __forceinline__ void operator()(const f32x4 (&acc)[2][2][4][2], const pg8::Unit& u, int wr, int wc, int fr, int fq) const {
        const int type = u.pn >> 2;
        const int row0 = u.pm * 256 + wr * 64 + fr, col0 = (u.pn & 3) * 256 + wc * 32 + 8 * fq;
        if (type == 1) {
            f32x4 lbv[2][2];
#pragma unroll
            for (int bj = 0; bj < 2; ++bj) { lbv[bj][0] = *(const f32x4*)(lb + col0 + bj * 128); lbv[bj][1] = *(const f32x4*)(lb + col0 + bj * 128 + 4); }
#pragma unroll
            for (int ai = 0; ai < 2; ++ai)
#pragma unroll
                for (int m = 0; m < 4; ++m) { bf16_t* rowp = G + (size_t)(row0 + ai * 128 + m * 16) * 1024 + col0;
#pragma unroll
                    for (int bj = 0; bj < 2; ++bj) { f32x4 o0, o1; const f32x4 l0 = lbv[bj][0], l1 = lbv[bj][1];
#pragma unroll
                        for (int e = 0; e < 4; ++e) { o0[e] = ein_elem(1, acc[ai][bj][m][0][e], l0[e]); o1[e] = ein_elem(1, acc[ai][bj][m][1][e], l1[e]); }
                        u32x4 w; w.x = cvt_pk_f16(o0[0], o0[1]); w.y = cvt_pk_f16(o0[2], o0[3]); w.z = cvt_pk_f16(o1[0], o1[1]); w.w = cvt_pk_f16(o1[2], o1[3]);
                        *(u32x4*)(rowp + bj * 128) = w; }
                    asm volatile("" ::: "memory"); }
        } else {
            bf16_t* base = Q + (size_t)(type == 0 ? 0 : type - 1) * (ACT_B / 2);
            if (type == 0) store_bf16<0>(acc, base, row0, col0);
            else if (type == 2) store_bf16<2>(acc, base, row0, col0);
            else store_bf16<3>(acc, base, row0, col0);
        }
    }
    template <int TYPE> __device__ __forceinline__ void store_bf16(const f32x4 (&acc)[2][2][4][2], bf16_t* base, int row0, int col0) const {
#pragma unroll
        for (int ai = 0; ai < 2; ++ai)
#pragma unroll
            for (int m = 0; m < 4; ++m) { bf16_t* rowp = base + (size_t)(row0 + ai * 128 + m * 16) * 1024 + col0;
#pragma unroll
                for (int bj = 0; bj < 2; ++bj) { f32x4 o0, o1;
#pragma unroll
                    for (int e = 0; e < 4; ++e) { o0[e] = ein_elem(TYPE, acc[ai][bj][m][0][e], 0.f); o1[e] = ein_elem(TYPE, acc[ai][bj][m][1][e], 0.f); }
                    u32x4 w; w.x = cvt_pk_bf16(o0[0], o0[1]); w.y = cvt_pk_bf16(o0[2], o0[3]); w.z = cvt_pk_bf16(o1[0], o1[1]); w.w = cvt_pk_bf16(o1[2], o1[3]);
                    *(u32x4*)(rowp + bj * 128) = w; }
                asm volatile("" ::: "memory"); }
    }
};
template <bool IN16, bool OUT32> struct EpiRes {
    static constexpr bool AFTER_DRAIN = false;
    const float* Xin32; const bf16_t* Xin16; float* Xout32; bf16_t* Xb; const float* scale; float* part;
    __device__ __forceinline__ void operator()(const f32x4 (&acc)[2][2][4][2], const pg8::Unit& u, int wr, int wc, int fr, int fq) const {
        const int row0 = u.pm * 256 + wr * 64 + fr, col0 = u.pn * 256 + wc * 32 + 8 * fq;
        constexpr int NB = 2;
        f32x4 sc[2][2];
#pragma unroll
        for (int bj = 0; bj < 2; ++bj) { sc[bj][0] = scale ? *(const f32x4*)(scale + col0 + bj * 128) : (f32x4){1.f, 1.f, 1.f, 1.f}; sc[bj][1] = scale ? *(const f32x4*)(scale + col0 + bj * 128 + 4) : (f32x4){1.f, 1.f, 1.f, 1.f}; }
        constexpr int AIB = 2 / NB;
#pragma unroll
        for (int bt = 0; bt < NB; ++bt) {
            f32x4 xr[AIB][4][2][IN16 ? 1 : 2];
#pragma unroll
            for (int a2 = 0; a2 < AIB; ++a2)
#pragma unroll
                for (int m = 0; m < 4; ++m) { const int ai = bt * AIB + a2; const size_t off = (size_t)(row0 + ai * 128 + m * 16) * 1024 + col0;
#pragma unroll
                    for (int bj = 0; bj < 2; ++bj) {
                        if (IN16) xr[a2][m][bj][0] = __builtin_bit_cast(f32x4, *(const u32x4*)(Xin16 + off + bj * 128));
                        else { xr[a2][m][bj][0] = *(const f32x4*)(Xin32 + off + bj * 128); xr[a2][m][bj][IN16 ? 0 : 1] = *(const f32x4*)(Xin32 + off + bj * 128 + 4); } } }
#pragma unroll
            for (int a2 = 0; a2 < AIB; ++a2)
#pragma unroll
                for (int m = 0; m < 4; ++m) { const int ai = bt * AIB + a2; const int row = row0 + ai * 128 + m * 16; const size_t off = (size_t)row * 1024 + col0; float ss = 0.f;
#pragma unroll
                    for (int bj = 0; bj < 2; ++bj) {
                        const f32x4 a0 = acc[ai][bj][m][0] * sc[bj][0], a1 = acc[ai][bj][m][1] * sc[bj][1];
                        f32x4 x0, x1;
                        if (IN16) { const u32x4 w = __builtin_bit_cast(u32x4, xr[a2][m][bj][0]); x0 = (f32x4){bflo(w.x), bfhi(w.x), bflo(w.y), bfhi(w.y)}; x1 = (f32x4){bflo(w.z), bfhi(w.z), bflo(w.w), bfhi(w.w)}; }
                        else { x0 = xr[a2][m][bj][0]; x1 = xr[a2][m][bj][IN16 ? 0 : 1]; }
                        x0 = x0 + a0; x1 = x1 + a1;
                        if (OUT32) { *(f32x4*)(Xout32 + off + bj * 128) = x0; *(f32x4*)(Xout32 + off + bj * 128 + 4) = x1; }
                        if (Xb) { u32x4 w; w.x = cvt_pk_bf16(x0[0], x0[1]); w.y = cvt_pk_bf16(x0[2], x0[3]); w.z = cvt_pk_bf16(x1[0], x1[1]); w.w = cvt_pk_bf16(x1[2], x1[3]); *(u32x4*)(Xb + off + bj * 128) = w; }
                        ss += x0[0] * x0[0] + x0[1] * x0[1] + x0[2] * x0[2] + x0[3] * x0[3] + x1[0] * x1[0] + x1[1] * x1[1] + x1[2] * x1[2] + x1[3] * x1[3]; }
                    ss += __shfl_xor(ss, 16); ss += __shfl_xor(ss, 32);
                    if (fq == 0 && part) part[(size_t)row * 16 + u.pn * 4 + wc] = ss; }
            asm volatile("" ::: "memory"); }
    }
};
struct EpiFinal {
    static constexpr bool AFTER_DRAIN = true;
    const bf16_t* Xin16; float* Y; const float* gfin; float* part; unsigned* cnt;
    __device__ __forceinline__ void fused(f32x4 (&acc)[2][2][4][2], const pg8::Unit& u, int wr, int wc, int fr, int fq, LAS unsigned char* lds) const {
        const int row0 = u.pm * 256 + wr * 64 + fr, col0 = u.pn * 256 + wc * 32 + 8 * fq;
        u32x4 xr[2][4][2];
#pragma unroll
        for (int ai = 0; ai < 2; ++ai)
#pragma unroll
            for (int m = 0; m < 4; ++m) { const size_t off = (size_t)(row0 + ai * 128 + m * 16) * 1024 + col0;
#pragma unroll
                for (int bj = 0; bj < 2; ++bj) xr[ai][m][bj] = *(const u32x4*)(Xin16 + off + bj * 128); }
#pragma unroll
        for (int ai = 0; ai < 2; ++ai) {
#pragma unroll
            for (int m = 0; m < 4; ++m) { const int row = row0 + ai * 128 + m * 16; float ss = 0.f;
#pragma unroll
                for (int bj = 0; bj < 2; ++bj) { const u32x4 w = xr[ai][m][bj];
                    const f32x4 x0 = (f32x4){bflo(w.x), bfhi(w.x), bflo(w.y), bfhi(w.y)} + acc[ai][bj][m][0], x1 = (f32x4){bflo(w.z), bfhi(w.z), bflo(w.w), bfhi(w.w)} + acc[ai][bj][m][1];
                    acc[ai][bj][m][0] = x0; acc[ai][bj][m][1] = x1;
                    ss += x0[0] * x0[0] + x0[1] * x0[1] + x0[2] * x0[2] + x0[3] * x0[3] + x1[0] * x1[0] + x1[1] * x1[1] + x1[2] * x1[2] + x1[3] * x1[3]; }
                ss += __shfl_xor(ss, 16); ss += __shfl_xor(ss, 32);
                if (fq == 0) __hip_atomic_store(part + (size_t)row * 16 + u.pn * 4 + wc, ss, __ATOMIC_RELAXED, __HIP_MEMORY_SCOPE_AGENT); }
            asm volatile("" ::: "memory"); }
        asm volatile("s_waitcnt vmcnt(0)" ::: "memory");
        __syncthreads();
        if (threadIdx.x == 0) {
            __hip_atomic_fetch_add(cnt + u.pm, 1u, __ATOMIC_RELAXED, __HIP_MEMORY_SCOPE_AGENT);
            unsigned sp = 0;
            while (__hip_atomic_load(cnt + u.pm, __ATOMIC_RELAXED, __HIP_MEMORY_SCOPE_AGENT) < 4u) { __builtin_amdgcn_s_sleep(1); if (++sp > (1u << 20)) break; }
        }
        __syncthreads();
        LAS float* rsl = (LAS float*)lds;
        if (threadIdx.x < 256) { const float* pr = part + (size_t)(u.pm * 256 + threadIdx.x) * 16; float sq = 0.f;
#pragma unroll
            for (int i = 0; i < 16; ++i) sq += __hip_atomic_load(pr + i, __ATOMIC_RELAXED, __HIP_MEMORY_SCOPE_AGENT);
            rsl[threadIdx.x] = rsqrtf(sq * (1.f / 1024.f) + EPS); }
        __syncthreads();
#pragma unroll
        for (int ai = 0; ai < 2; ++ai)
#pragma unroll
            for (int m = 0; m < 4; ++m) { const int rl = ai * 128 + wr * 64 + m * 16 + fr; const float rs = rsl[rl]; float* yp = Y + (size_t)(u.pm * 256 + rl) * 1024 + col0;
#pragma unroll
                for (int bj = 0; bj < 2; ++bj) { const f32x4 g0 = *(const f32x4*)(gfin + col0 + bj * 128), g1 = *(const f32x4*)(gfin + col0 + bj * 128 + 4);
                    *(f32x4*)(yp + bj * 128) = acc[ai][bj][m][0] * rs * g0; *(f32x4*)(yp + bj * 128 + 4) = acc[ai][bj][m][1] * rs * g1; } }
        __syncthreads();
    }
};
struct EpiNull { float* sink; static constexpr bool AFTER_DRAIN = false;
    __device__ __forceinline__ void operator()(const f32x4 (&acc)[2][2][4][2], const pg8::Unit& u, int wr, int wc, int fr, int fq) const {
        f32x4 t = (f32x4){0.f, 0.f, 0.f, 0.f};
#pragma unroll
        for (int a = 0; a < 2; ++a)
#pragma unroll
            for (int b = 0; b < 2; ++b)
#pragma unroll
                for (int m = 0; m < 4; ++m)
#pragma unroll
                    for (int n = 0; n < 2; ++n) t = t + acc[a][b][m][n];
        if (t[0] + t[1] + t[2] + t[3] == 12345.678f) sink[0] = 1.f; } };
struct SNull { float* sink; __device__ __forceinline__ void rowpart(int, int, float) const {}
    __device__ __forceinline__ float operator()(int r, int c, f32x4 v) const { if (v[0] + v[1] + v[2] + v[3] == 12345.678f) sink[0] = 1.f; return 0.f; } };
struct EpiUp {
    static constexpr bool AFTER_DRAIN = false;
    bf16_t* H; const float* part;
    __device__ __forceinline__ void operator()(const f32x4 (&acc)[2][2][4][2], const pg8::Unit& u, int wr, int wc, int fr, int fq) const {
        const int row0 = u.pm * 256 + wr * 64 + fr, col0 = u.pn * 256 + wc * 32 + 8 * fq;
        f32x4 pv[2][4]; float rs[2][4];
#pragma unroll
        for (int ai = 0; ai < 2; ++ai)
#pragma unroll
            for (int m = 0; m < 4; ++m) pv[ai][m] = *(const f32x4*)(part + (size_t)(row0 + ai * 128 + m * 16) * 16 + fq * 4);
#pragma unroll
        for (int ai = 0; ai < 2; ++ai)
#pragma unroll
            for (int m = 0; m < 4; ++m) { float sq = (pv[ai][m][0] + pv[ai][m][1]) + (pv[ai][m][2] + pv[ai][m][3]); sq += __shfl_xor(sq, 16); sq += __shfl_xor(sq, 32); rs[ai][m] = rsqrtf(sq * (1.f / 1024.f) + EPS); }
#pragma unroll
        for (int ai = 0; ai < 2; ++ai)
#pragma unroll
            for (int m = 0; m < 4; ++m) { const int row = row0 + ai * 128 + m * 16; const float r = rs[ai][m]; bf16_t* rowp = H + (size_t)row * 4096 + col0;
#pragma unroll
                for (int bj = 0; bj < 2; ++bj) { f32x4 o0, o1;
#pragma unroll
                    for (int e = 0; e < 4; ++e) { float a = fmaxf(acc[ai][bj][m][0][e] * r, 0.f), b2 = fmaxf(acc[ai][bj][m][1][e] * r, 0.f); o0[e] = a * a; o1[e] = b2 * b2; }
                    u32x4 w; w.x = cvt_pk_bf16(o0[0], o0[1]); w.y = cvt_pk_bf16(o0[2], o0[3]); w.z = cvt_pk_bf16(o1[0], o1[1]); w.w = cvt_pk_bf16(o1[2], o1[3]);
                    *(u32x4*)(rowp + bj * 128) = w; } }
    }
};

template <int NCT, class F>
__device__ __forceinline__ void sample_gemm(LAS unsigned char* lds, const bf16_t* A, int lda, int agroup, const bf16_t* Bt, int K, const F& f) {
    constexpr int CT = NCT * 16;
    const int tid = threadIdx.x, wid = tid >> 6, lane = tid & 63, fr = lane & 15, fq = lane >> 4;
    LAS float* red = (LAS float*)lds;
    for (int blk = blockIdx.x; blk < 256; blk += gridDim.x) {
        const int rb = blk & 3, cb = blk >> 2, r0 = rb * 32, c0 = cb * CT;
        const int Kw = K >> 3, kb = wid * Kw;
        const bf16_t* Ab = A + (size_t)(c0 >> 8) * agroup;
        f32x4 acc[2][NCT];
#pragma unroll
        for (int i = 0; i < 2; ++i)
#pragma unroll
            for (int j = 0; j < NCT; ++j) acc[i][j] = (f32x4){0.f, 0.f, 0.f, 0.f};
        constexpr int UN = NCT == 1 ? 8 : 2;
        for (int k = kb; k < kb + Kw; k += 32 * UN) {
            bf16x8 af[UN][2], bfr[UN][NCT];
#pragma unroll
            for (int uu = 0; uu < UN; ++uu) { const int ku = k + 32 * uu; const bool ok = ku < kb + Kw;
#pragma unroll
                for (int i = 0; i < 2; ++i) af[uu][i] = ok ? *(const bf16x8*)(Ab + (size_t)(r0 + i * 16 + fr) * lda + ku + fq * 8) : (bf16x8){0, 0, 0, 0, 0, 0, 0, 0};
#pragma unroll
                for (int j = 0; j < NCT; ++j) bfr[uu][j] = ok ? *(const bf16x8*)(Bt + (size_t)(c0 + j * 16 + fr) * K + ku + fq * 8) : (bf16x8){0, 0, 0, 0, 0, 0, 0, 0}; }
#pragma unroll
            for (int uu = 0; uu < UN; ++uu)
#pragma unroll
                for (int i = 0; i < 2; ++i)
#pragma unroll
                    for (int j = 0; j < NCT; ++j) acc[i][j] = __builtin_amdgcn_mfma_f32_16x16x32_bf16(bfr[uu][j], af[uu][i], acc[i][j], 0, 0, 0);
        }
#pragma unroll
        for (int i = 0; i < 2; ++i)
#pragma unroll
            for (int j = 0; j < NCT; ++j) *(LAS f32x4*)(red + ((size_t)wid * 32 + i * 16 + fr) * CT + j * 16 + fq * 4) = acc[i][j];
        __syncthreads();
        constexpr int NG = 32 * CT / 4;
        for (int i = tid; i < NG; i += 512) { const int row = i / (CT / 4), cgp = i % (CT / 4);
            f32x4 s = (f32x4){0.f, 0.f, 0.f, 0.f};
#pragma unroll
            for (int w = 0; w < 8; ++w) s = s + *(const LAS f32x4*)(red + ((size_t)w * 32 + row) * CT + cgp * 4);
            float ss = f(r0 + row, c0 + cgp * 4, s);
#pragma unroll
            for (int o = 1; o < CT / 4; o <<= 1) ss += __shfl_xor(ss, o);
            if (cgp == 0) f.rowpart(r0 + row, cb, ss); }
        __syncthreads();
    }
}
struct SIn { bf16_t *Q, *V, *OG; bf16_t* G; const float* lb;
    __device__ __forceinline__ void rowpart(int, int, float) const {}
    __device__ __forceinline__ float operator()(int r, int c, f32x4 v) const { const int type = c >> 10, cc = c & 1023; const size_t off = (size_t)(TP + r) * 1024 + cc;
        if (type == 1) { f32x4 o;
#pragma unroll
            for (int e = 0; e < 4; ++e) o[e] = ein_elem(1, v[e], lb[cc + e]);
            u32x2 w; w.x = cvt_pk_f16(o[0], o[1]); w.y = cvt_pk_f16(o[2], o[3]); *(u32x2*)(G + off) = w; }
        else { bf16_t* base = Q + (size_t)(type == 0 ? 0 : type - 1) * (ACT_B / 2); f32x4 o;
            if (type == 0) {
#pragma unroll
                for (int e = 0; e < 4; ++e) o[e] = ein_elem(0, v[e], 0.f); }
            else if (type == 2) o = v;
            else {
#pragma unroll
                for (int e = 0; e < 4; ++e) o[e] = ein_elem(3, v[e], 0.f); }
            u32x2 w; w.x = cvt_pk_bf16(o[0], o[1]); w.y = cvt_pk_bf16(o[2], o[3]); *(u32x2*)(base + off) = w; } return 0.f; } };
struct SRes { const float* Xin; float* Xout; bf16_t* Xb; const float* scale; float* parts;
    __device__ __forceinline__ void rowpart(int r, int cb, float ss) const { if (parts) parts[r * 64 + cb] = ss; }
    __device__ __forceinline__ float operator()(int r, int c, f32x4 v) const { const size_t off = (size_t)r * 1024 + c;
        f32x4 x = *(const f32x4*)(Xin + off); if (scale) v = v * *(const f32x4*)(scale + c); x = x + v; *(f32x4*)(Xout + off) = x;
        if (Xb) { u32x2 w; w.x = cvt_pk_bf16(x[0], x[1]); w.y = cvt_pk_bf16(x[2], x[3]); *(u32x2*)(Xb + off) = w; }
        return x[0] * x[0] + x[1] * x[1] + x[2] * x[2] + x[3] * x[3]; } };
struct SUp { bf16_t* H; const float* parts;
    __device__ __forceinline__ void rowpart(int, int, float) const {}
    __device__ __forceinline__ float operator()(int r, int c, f32x4 v) const { f32x4 t = (f32x4){0.f, 0.f, 0.f, 0.f};
#pragma unroll
        for (int i = 0; i < 16; ++i) t = t + *(const f32x4*)(parts + r * 64 + i * 4);
        const float rs = rsqrtf(((t[0] + t[1]) + (t[2] + t[3])) * (1.f / 1024.f) + EPS); f32x4 o;
#pragma unroll
        for (int e = 0; e < 4; ++e) { float a = fmaxf(v[e] * rs, 0.f); o[e] = a * a; }
        u32x2 w; w.x = cvt_pk_bf16(o[0], o[1]); w.y = cvt_pk_bf16(o[2], o[3]); *(u32x2*)(H + (size_t)r * 4096 + c) = w; return 0.f; } };

struct TJob { const float* src; bf16_t* dst; const float* gain; int N, ldd, k0, n0; };
__device__ __forceinline__ bool prep_job(const Params& p, int it, TJob& j) {
    unsigned char* ws = p.ws;
    constexpr int T_IN = 1024, T_OUT = 256, T_UP = 1024, T_DN = 1024, T_P = 64;
    constexpr int NT = T_IN + T_OUT + 2 * T_UP + 2 * T_DN + T_P;
    if (it >= NT) return false;
    int r = it; j.gain = nullptr;
    if (r < T_IN) { j.src = p.hgrn_w_in; j.N = 4096; j.dst = (bf16_t*)(ws + WS_WIN); j.ldd = 1024; j.k0 = (r >> 6) * 64; j.n0 = (r & 63) * 64; return true; } r -= T_IN;
    if (r < T_OUT) { j.src = p.hgrn_w_out; j.N = 1024; j.dst = (bf16_t*)(ws + WS_WOUT); j.ldd = 1024; j.k0 = (r >> 4) * 64; j.n0 = (r & 15) * 64; return true; } r -= T_OUT;
    if (r < T_UP) { j.src = p.mlp_up; j.N = 4096; j.dst = (bf16_t*)(ws + WS_WUP0); j.ldd = 1024; j.k0 = (r >> 6) * 64; j.n0 = (r & 63) * 64; j.gain = p.mlp_norm; return true; } r -= T_UP;
    if (r < T_UP) { j.src = p.mlp_up + (size_t)1024 * 4096; j.N = 4096; j.dst = (bf16_t*)(ws + WS_WUP1); j.ldd = 1024; j.k0 = (r >> 6) * 64; j.n0 = (r & 63) * 64; j.gain = p.mlp_norm + 1024; return true; } r -= T_UP;
    if (r < T_DN) { j.src = p.mlp_down; j.N = 1024; j.dst = (bf16_t*)(ws + WS_WDN0); j.ldd = 4096; j.k0 = (r >> 4) * 64; j.n0 = (r & 15) * 64; return true; } r -= T_DN;
    if (r < T_DN) { j.src = p.mlp_down + (size_t)4096 * 1024; j.N = 1024; j.dst = (bf16_t*)(ws + WS_WDN1); j.ldd = 4096; j.k0 = (r >> 4) * 64; j.n0 = (r & 15) * 64; return true; } r -= T_DN;
    { const int g = r >> 4, rr = r & 15; j.src = p.pool_w + (size_t)g * 65536; j.N = 256; j.dst = (bf16_t*)(ws + WS_WP) + (size_t)g * 65536; j.ldd = 256; j.k0 = (rr >> 2) * 64; j.n0 = (rr & 3) * 64; }
    return true;
}
__device__ __forceinline__ void phase_prep(const Params& p, LAS unsigned char* lds) {
    LAS float* tiles = (LAS float*)lds;
    unsigned char* ws = p.ws;
    constexpr int NT = 1024 + 256 + 2 * 1024 + 2 * 1024 + 64;
    { const int tid = threadIdx.x, i = tid >> 4, j4 = (tid & 15) * 4, n = tid >> 3, k8 = (tid & 7) * 8;
#pragma unroll 1
      for (int it0 = blockIdx.x; it0 < NT; it0 += 2 * gridDim.x) {
          TJob j[2]; bool ok[2]; f32x4 v[2][2];
#pragma unroll
          for (int q = 0; q < 2; ++q) { ok[q] = prep_job(p, it0 + q * gridDim.x, j[q]);
              if (ok[q]) {
#pragma unroll
                  for (int hh = 0; hh < 2; ++hh) v[q][hh] = *(const f32x4*)(j[q].src + (size_t)(j[q].k0 + i + 32 * hh) * j[q].N + j[q].n0 + j4); } }
#pragma unroll
          for (int q = 0; q < 2; ++q) if (ok[q]) {
#pragma unroll
              for (int hh = 0; hh < 2; ++hh)
#pragma unroll
                  for (int e = 0; e < 4; ++e) tiles[q * 4160 + (j4 + e) * 65 + i + 32 * hh] = v[q][hh][e]; }
          __syncthreads();
#pragma unroll
          for (int q = 0; q < 2; ++q) if (ok[q]) { float o[8];
#pragma unroll
              for (int e = 0; e < 8; ++e) { o[e] = tiles[q * 4160 + n * 65 + k8 + e]; if (j[q].gain) o[e] *= j[q].gain[j[q].k0 + k8 + e]; }
              u32x4 w; w.x = cvt_pk_bf16(o[0], o[1]); w.y = cvt_pk_bf16(o[2], o[3]); w.z = cvt_pk_bf16(o[4], o[5]); w.w = cvt_pk_bf16(o[6], o[7]);
              *(u32x4*)(j[q].dst + (size_t)(j[q].n0 + n) * j[q].ldd + j[q].k0 + k8) = w; }
          __syncthreads();
      } }
    const int tid = threadIdx.x, wid = tid >> 6, lane = tid & 63;
    bf16_t* U = (bf16_t*)(ws + WS_R2);
    for (int row0 = blockIdx.x * 8 + wid; row0 < MP; row0 += gridDim.x * 32) {
        f32x4 v[4][4];
#pragma unroll
        for (int rr = 0; rr < 4; ++rr) { const int row = row0 + rr * gridDim.x * 8; if (row < MP) { const float* src = row < TP ? p.x_prompt + (size_t)row * 1024 : p.x_sample + (size_t)(row - TP) * 1024;
#pragma unroll
            for (int j = 0; j < 4; ++j) v[rr][j] = *(const f32x4*)(src + lane * 4 + 256 * j); } }
#pragma unroll
        for (int rr = 0; rr < 4; ++rr) { const int row = row0 + rr * gridDim.x * 8; if (row < MP) { float sacc = 0.f;
#pragma unroll
            for (int j = 0; j < 4; ++j) sacc += v[rr][j][0] * v[rr][j][0] + v[rr][j][1] * v[rr][j][1] + v[rr][j][2] * v[rr][j][2] + v[rr][j][3] * v[rr][j][3];
            const float rs = rsqrtf(wave_sum(sacc) * (1.f / 1024.f) + EPS);
#pragma unroll
            for (int j = 0; j < 4; ++j) { const f32x4 g = *(const f32x4*)(p.hgrn_norm + lane * 4 + 256 * j);
                u32x2 w; w.x = cvt_pk_bf16(v[rr][j][0] * rs * g[0], v[rr][j][1] * rs * g[1]); w.y = cvt_pk_bf16(v[rr][j][2] * rs * g[2], v[rr][j][3] * rs * g[3]);
                *(u32x2*)(U + (size_t)row * 1024 + lane * 4 + 256 * j) = w; } } }
    }
    if (blockIdx.x < 2) { const int c = blockIdx.x * 512 + tid; ((float*)(ws + WS_LB))[c] = lb_of(p.hgrn_lb, c); }
}

__device__ __forceinline__ bf16x8 lds_frag(const LAS bf16_t* p) { return *(const LAS bf16x8*)p; }
__device__ __forceinline__ void rec_prompt(const Params& p, LAS unsigned char* lds, int b, int h, int seg) {
    const int tid = threadIdx.x, wid = tid >> 6, lane = tid & 63, fr = lane & 15, fq = lane >> 4;
    LAS bf16_t* QT = (LAS bf16_t*)(lds + 0);
    LAS bf16_t* KT = (LAS bf16_t*)(lds + 17408);
    LAS bf16_t* KH = (LAS bf16_t*)(lds + 34816);
    LAS bf16_t* VT = (LAS bf16_t*)(lds + 53248);
    LAS bf16_t* SB = (LAS bf16_t*)(lds + 71680);
    LAS bf16_t* AM = (LAS bf16_t*)(lds + 106496);
    LAS float* TOT = (LAS float*)(lds + 115712);
    LAS float* DD = (LAS float*)(lds + 119808);
    LAS float* SSQ = (LAS float*)(lds + 120320);
    const unsigned char* ws = p.ws;
    const size_t gbase = (size_t)b * SEQ * 1024 + h * 128;
    const bf16_t* Qg = (const bf16_t*)(ws + WS_Q) + gbase; const bf16_t* Vg = (const bf16_t*)(ws + WS_V) + gbase; const bf16_t* OGg = (const bf16_t*)(ws + WS_OG) + gbase;
    const bf16_t* Gg = (const bf16_t*)(ws + WS_G) + gbase;
    bf16_t* Og = (bf16_t*)(p.ws + WS_R2) + gbase;
    bf16_t* QCg = (bf16_t*)(p.ws + WS_R2) + gbase;
    float* OLg = p.out + gbase;
    f32x2 Gseg = (f32x2){0.f, 0.f};
    f32x4 Sacc[8];
#pragma unroll
    for (int i = 0; i < 8; ++i) Sacc[i] = (f32x4){0.f, 0.f, 0.f, 0.f};
    const int d2 = (tid & 63) * 2, part = tid >> 6;
    unsigned gr[8], qr[8], vr[8];
#define REC_LOAD(c) do { const unsigned o_ = (unsigned)(((c) * 64 + part * 8) * 1024 + d2); \
        _Pragma("unroll") for (int i = 0; i < 8; ++i) { gr[i] = *(const unsigned*)(Gg + o_ + (unsigned)i * 1024u); qr[i] = *(const unsigned*)(Qg + o_ + (unsigned)i * 1024u); vr[i] = *(const unsigned*)(Vg + o_ + (unsigned)i * 1024u); } } while (0)
    REC_LOAD(seg * 8);
    const int tb = wid & 3, vh = wid >> 2;
    for (int cc = 0; cc < 8; ++cc) {
        const int c = seg * 8 + cc;
#pragma unroll
        for (int vb = 0; vb < 8; ++vb) { u32x2 w; w.x = cvt_pk_bf16(Sacc[vb][0], Sacc[vb][1]); w.y = cvt_pk_bf16(Sacc[vb][2], Sacc[vb][3]);
            *(LAS u32x2*)(SB + (vb * 16 + fr) * 136 + wid * 16 + fq * 4) = w; }
        f32x2 cs[8];
        { f32x2 run = (f32x2){0.f, 0.f};
#pragma unroll
          for (int i = 0; i < 8; ++i) { run = run + h2_to_f2(gr[i]); cs[i] = run; }
          *(LAS f32x2*)(TOT + part * 128 + d2) = run; }
        __syncthreads();
        { f32x2 off = (f32x2){0.f, 0.f}, Gl = (f32x2){0.f, 0.f};
#pragma unroll
          for (int pp = 0; pp < 8; ++pp) { const f32x2 tv = *(const LAS f32x2*)(TOT + pp * 128 + d2); Gl = Gl + tv; if (pp < part) off = off + tv; }
          const float eGl0 = __expf(Gl[0]), eGl1 = __expf(Gl[1]), eGs0 = __expf(Gseg[0]), eGs1 = __expf(Gseg[1]);
          float kh0[8], kh1[8];
#pragma unroll
          for (int i = 0; i < 8; ++i) { const int t = part * 8 + i; const f32x2 G = off + cs[i];
              const float e0 = __expf(G[0]), e1 = __expf(G[1]), ei0 = __builtin_amdgcn_rcpf(e0), ei1 = __builtin_amdgcn_rcpf(e1);
              const f32x2 gv = h2_to_f2(gr[i]); const float k0 = 1.f - __expf(gv[0]), k1 = 1.f - __expf(gv[1]);
              const float q0 = bflo(qr[i]) * e0, q1 = bfhi(qr[i]) * e1;
              *(LAS unsigned*)(QT + t * 136 + d2) = cvt_pk_bf16(q0, q1); *(LAS unsigned*)(KT + t * 136 + d2) = cvt_pk_bf16(k0 * ei0, k1 * ei1);
              kh0[i] = k0 * eGl0 * ei0; kh1[i] = k1 * eGl1 * ei1;
              if (seg > 0) *(unsigned*)(QCg + (unsigned)((c * 64 + t) * 1024 + d2)) = cvt_pk_bf16(q0 * eGs0, q1 * eGs1); }
          Gseg = Gseg + Gl;
          u32x4 w0, w1; w0.x = cvt_pk_bf16(kh0[0], kh0[1]); w0.y = cvt_pk_bf16(kh0[2], kh0[3]); w0.z = cvt_pk_bf16(kh0[4], kh0[5]); w0.w = cvt_pk_bf16(kh0[6], kh0[7]);
          w1.x = cvt_pk_bf16(kh1[0], kh1[1]); w1.y = cvt_pk_bf16(kh1[2], kh1[3]); w1.z = cvt_pk_bf16(kh1[4], kh1[5]); w1.w = cvt_pk_bf16(kh1[6], kh1[7]);
          *(LAS u32x4*)(KH + d2 * 72 + part * 8) = w0; *(LAS u32x4*)(KH + (d2 + 1) * 72 + part * 8) = w1;
          u32x4 v0, v1;
          v0.x = (vr[0] & 0xffffu) | (vr[1] << 16); v0.y = (vr[2] & 0xffffu) | (vr[3] << 16); v0.z = (vr[4] & 0xffffu) | (vr[5] << 16); v0.w = (vr[6] & 0xffffu) | (vr[7] << 16);
          v1.x = (vr[0] >> 16) | (vr[1] & 0xffff0000u); v1.y = (vr[2] >> 16) | (vr[3] & 0xffff0000u); v1.z = (vr[4] >> 16) | (vr[5] & 0xffff0000u); v1.w = (vr[6] >> 16) | (vr[7] & 0xffff0000u);
          *(LAS u32x4*)(VT + d2 * 72 + part * 8) = v0; *(LAS u32x4*)(VT + (d2 + 1) * 72 + part * 8) = v1;
          if (part == 0) *(LAS f32x2*)(DD + d2) = (f32x2){eGl0, eGl1}; }
        if (cc + 1 < 8) REC_LOAD(c + 1);
        __syncthreads();
        { const int sb = wid >> 1;
#pragma unroll
          for (int ti = 0; ti < 2; ++ti) { const int tbb = (wid & 1) * 2 + ti; f32x4 a = (f32x4){0.f, 0.f, 0.f, 0.f};
              if (sb <= tbb) {
#pragma unroll
                  for (int kk = 0; kk < 4; ++kk) a = __builtin_amdgcn_mfma_f32_16x16x32_bf16(lds_frag(KT + (sb * 16 + fr) * 136 + kk * 32 + fq * 8), lds_frag(QT + (tbb * 16 + fr) * 136 + kk * 32 + fq * 8), a, 0, 0, 0);
                  const int t = tbb * 16 + fr, s0 = sb * 16 + fq * 4;
#pragma unroll
                  for (int j = 0; j < 4; ++j) if (s0 + j > t) a[j] = 0.f; }
              u32x2 w; w.x = cvt_pk_bf16(a[0], a[1]); w.y = cvt_pk_bf16(a[2], a[3]);
              *(LAS u32x2*)(AM + (tbb * 16 + fr) * 72 + sb * 16 + fq * 4) = w; } }
        { const f32x4 dd = *(const LAS f32x4*)(DD + wid * 16 + fq * 4);
          const bf16x8 a0 = lds_frag(KH + (wid * 16 + fr) * 72 + fq * 8), a1 = lds_frag(KH + (wid * 16 + fr) * 72 + 32 + fq * 8);
#pragma unroll
          for (int vb = 0; vb < 8; ++vb) { f32x4 a = Sacc[vb] * dd;
              a = __builtin_amdgcn_mfma_f32_16x16x32_bf16(a0, lds_frag(VT + (vb * 16 + fr) * 72 + fq * 8), a, 0, 0, 0);
              a = __builtin_amdgcn_mfma_f32_16x16x32_bf16(a1, lds_frag(VT + (vb * 16 + fr) * 72 + 32 + fq * 8), a, 0, 0, 0);
              Sacc[vb] = a; } }
        __syncthreads();
        f32x4 oacc[4]; u32x2 ogv[4];
        const size_t tok = (size_t)c * 64 + tb * 16 + fr;
        if (seg == 0) {
#pragma unroll
        for (int vi = 0; vi < 4; ++vi) ogv[vi] = *(const u32x2*)(OGg + tok * 1024 + (vh * 4 + vi) * 16 + fq * 4); }
        { bf16x8 qf[4], af[2];
#pragma unroll
          for (int kk = 0; kk < 4; ++kk) qf[kk] = lds_frag(QT + (tb * 16 + fr) * 136 + kk * 32 + fq * 8);
#pragma unroll
          for (int kk = 0; kk < 2; ++kk) af[kk] = lds_frag(AM + (tb * 16 + fr) * 72 + kk * 32 + fq * 8);
#pragma unroll
          for (int vi = 0; vi < 4; ++vi) { const int vb = vh * 4 + vi; f32x4 a = (f32x4){0.f, 0.f, 0.f, 0.f};
#pragma unroll
              for (int kk = 0; kk < 4; ++kk) a = __builtin_amdgcn_mfma_f32_16x16x32_bf16(lds_frag(SB + (vb * 16 + fr) * 136 + kk * 32 + fq * 8), qf[kk], a, 0, 0, 0);
#pragma unroll
              for (int kk = 0; kk < 2; ++kk) a = __builtin_amdgcn_mfma_f32_16x16x32_bf16(lds_frag(VT + (vb * 16 + fr) * 72 + kk * 32 + fq * 8), af[kk], a, 0, 0, 0);
              oacc[vi] = a; } }
        if (seg == 0) {
        { float ss = 0.f;
#pragma unroll
          for (int vi = 0; vi < 4; ++vi) ss += oacc[vi][0] * oacc[vi][0] + oacc[vi][1] * oacc[vi][1] + oacc[vi][2] * oacc[vi][2] + oacc[vi][3] * oacc[vi][3];
          ss += __shfl_xor(ss, 16); ss += __shfl_xor(ss, 32);
          if (fq == 0) SSQ[vh * 64 + tb * 16 + fr] = ss; }
        __syncthreads();
        { const float tot = SSQ[tb * 16 + fr] + SSQ[64 + tb * 16 + fr]; const float rs = rsqrtf(tot * (1.f / 128.f) + EPS);
#pragma unroll
          for (int vi = 0; vi < 4; ++vi) { const f32x4 o = oacc[vi] * rs * *(const f32x4*)(p.hgrn_onorm + h * 128 + (vh * 4 + vi) * 16 + fq * 4);
              u32x2 w; w.x = cvt_pk_bf16(o[0] * bflo(ogv[vi].x), o[1] * bfhi(ogv[vi].x)); w.y = cvt_pk_bf16(o[2] * bflo(ogv[vi].y), o[3] * bfhi(ogv[vi].y));
              *(u32x2*)(Og + tok * 1024 + (vh * 4 + vi) * 16 + fq * 4) = w; } }
        } else {
#pragma unroll
          for (int vi = 0; vi < 4; ++vi) *(f32x4*)(OLg + tok * 1024 + (vh * 4 + vi) * 16 + fq * 4) = oacc[vi];
          __syncthreads();
        }
    }
#undef REC_LOAD
    float* So = seg == 3 ? p.out + O_HP + (size_t)(b * 8 + h) * 16384 : (float*)(p.ws + WS_LSEG) + ((size_t)(b * 8 + h) * 3 + seg) * 16384;
    if (part == 0) *(f32x2*)((float*)(p.ws + WS_DSEG) + ((size_t)(b * 8 + h) * 4 + seg) * 128 + d2) = (f32x2){__expf(Gseg[0]), __expf(Gseg[1])};
#pragma unroll
    for (int vb = 0; vb < 8; ++vb)
#pragma unroll
        for (int j = 0; j < 4; ++j) So[(size_t)(wid * 16 + fq * 4 + j) * 128 + vb * 16 + fr] = Sacc[vb][j];
    __syncthreads();
}
__device__ __forceinline__ void rec_sample(const Params& p, LAS unsigned char* lds, int item) {
    const int tid = threadIdx.x, b = item >> 3, h = item & 7;
    LAS float* qs = (LAS float*)lds; LAS float* fs = qs + 128; LAS float* ks = qs + 256; LAS float* vs = qs + 384; LAS float* red = qs + 512;
    LAS float* sq = qs + 512 + 2048;
    const unsigned char* ws = p.ws;
    const size_t roff = (size_t)(TP + b) * 1024 + h * 128;
    if (tid < 128) { qs[tid] = bf2f(((const bf16_t*)(ws + WS_Q))[roff + tid]); const float f = __expf((float)((const _Float16*)(ws + WS_G))[roff + tid]); fs[tid] = f; ks[tid] = 1.f - f;
        vs[tid] = bf2f(((const bf16_t*)(ws + WS_V))[roff + tid]); }
    __syncthreads();
    const int v4 = (tid & 31) * 4, dg = tid >> 5;
    const float* Sin = p.state_hgrn + (size_t)item * 16384; float* Sout = p.out + O_HS + (size_t)item * 16384;
    const f32x4 vv = *(const LAS f32x4*)(vs + v4);
    f32x4 o = (f32x4){0.f, 0.f, 0.f, 0.f};
    f32x4 sv[8];
#pragma unroll
    for (int i = 0; i < 8; ++i) sv[i] = *(const f32x4*)(Sin + (size_t)(dg * 8 + i) * 128 + v4);
#pragma unroll
    for (int i = 0; i < 8; ++i) { const int dd = dg * 8 + i; const f32x4 sn = sv[i] * fs[dd] + vv * ks[dd]; *(f32x4*)(Sout + (size_t)dd * 128 + v4) = sn; o = o + sn * qs[dd]; }
    *(LAS f32x4*)(red + dg * 128 + v4) = o;
    __syncthreads();
    float ov = 0.f;
    if (tid < 128) {
#pragma unroll
        for (int i = 0; i < 16; ++i) ov += red[i * 128 + tid];
        const float s = wave_sum(ov * ov); if ((tid & 63) == 0) sq[tid >> 6] = s; }
    __syncthreads();
    if (tid < 128) { const float rs = rsqrtf((sq[0] + sq[1]) * (1.f / 128.f) + EPS);
        const float og = bf2f(((const bf16_t*)(ws + WS_OG))[roff + tid]);
        ((bf16_t*)(p.ws + WS_R2))[roff + tid] = f2bf(ov * rs * p.hgrn_onorm[h * 128 + tid] * og); }
    __syncthreads();
}

__device__ __forceinline__ void rec_sample_list(const Params& p, LAS unsigned char* lds, int first, int stride, int count, size_t obase = WS_R2) {
    const int tid = threadIdx.x;
    LAS float* qs = (LAS float*)lds; LAS float* fs = qs + 128; LAS float* ks = qs + 256; LAS float* vs = qs + 384; LAS float* red = qs + 512;
    LAS float* sq = qs + 512 + 2048;
    const unsigned char* ws = p.ws;
    const int v4 = (tid & 31) * 4, dg = tid >> 5;
    f32x4 svA[8], svB[8]; float lqA = 0.f, lgA = 0.f, lvA = 0.f, loA = 0.f, lqB = 0.f, lgB = 0.f, lvB = 0.f, loB = 0.f;
#define RS_ISSUE(item_, sv, lq, lg, lv, lo) do { const int it_ = (item_); const size_t ro_ = (size_t)(TP + (it_ >> 3)) * 1024 + (it_ & 7) * 128; \
        if (tid < 128) { lq = bf2f(((const bf16_t*)(ws + WS_Q))[ro_ + tid]); lg = (float)((const _Float16*)(ws + WS_G))[ro_ + tid]; lv = bf2f(((const bf16_t*)(ws + WS_V))[ro_ + tid]); lo = bf2f(((const bf16_t*)(ws + WS_OG))[ro_ + tid]); } \
        const float* Sin_ = p.state_hgrn + (size_t)it_ * 16384; \
        _Pragma("unroll") for (int i = 0; i < 8; ++i) sv[i] = *(const f32x4*)(Sin_ + (size_t)(dg * 8 + i) * 128 + v4); } while (0)
#define RS_ITEM(j_, sv, lq, lg, lv, lo) do { \
        const int item = first + (j_) * stride, b = item >> 3, h = item & 7; \
        const size_t roff = (size_t)(TP + b) * 1024 + h * 128; \
        const float og = lo; \
        if (tid < 128) { const float f = __expf(lg); qs[tid] = lq; fs[tid] = f; ks[tid] = 1.f - f; vs[tid] = lv; } \
        __syncthreads(); \
        float* Sout = p.out + O_HS + (size_t)item * 16384; \
        const f32x4 vv = *(const LAS f32x4*)(vs + v4); \
        f32x4 o = (f32x4){0.f, 0.f, 0.f, 0.f}; \
        _Pragma("unroll") for (int i = 0; i < 8; ++i) { const int dd = dg * 8 + i; const f32x4 sn = sv[i] * fs[dd] + vv * ks[dd]; *(f32x4*)(Sout + (size_t)dd * 128 + v4) = sn; o = o + sn * qs[dd]; } \
        if ((j_) + 2 < count) RS_ISSUE(first + ((j_) + 2) * stride, sv, lq, lg, lv, lo); \
        *(LAS f32x4*)(red + dg * 128 + v4) = o; \
        __syncthreads(); \
        float ov = 0.f; \
        if (tid < 128) { \
            _Pragma("unroll") for (int i = 0; i < 16; ++i) ov += red[i * 128 + tid]; \
            const float s2 = wave_sum(ov * ov); if ((tid & 63) == 0) sq[tid >> 6] = s2; } \
        __syncthreads(); \
        if (tid < 128) { const float rs = rsqrtf((sq[0] + sq[1]) * (1.f / 128.f) + EPS); \
            ((bf16_t*)(p.ws + obase))[roff + tid] = f2bf(ov * rs * p.hgrn_onorm[h * 128 + tid] * og); } \
        __syncthreads(); } while (0)
    if (count > 0) RS_ISSUE(first, svA, lqA, lgA, lvA, loA);
    if (count > 1) RS_ISSUE(first + stride, svB, lqB, lgB, lvB, loB);
    for (int j = 0; j < count; j += 2) {
        RS_ITEM(j, svA, lqA, lgA, lvA, loA);
        if (j + 1 < count) RS_ITEM(j + 1, svB, lqB, lgB, lvB, loB);
    }
#undef RS_ITEM
#undef RS_ISSUE
}
__device__ __forceinline__ void rec_fix(const Params& p, LAS unsigned char* lds, int b, int h, int seg) {
    const int tid = threadIdx.x, wid = tid >> 6, lane = tid & 63, fr = lane & 15, fq = lane >> 4;
    LAS bf16_t* QT = (LAS bf16_t*)(lds + 0);
    LAS bf16_t* SB = (LAS bf16_t*)(lds + 71680);
    LAS float* SSQ = (LAS float*)(lds + 118272);
    const unsigned char* ws = p.ws;
    const int bh = b * 8 + h;
    const size_t gbase = (size_t)b * SEQ * 1024 + h * 128;
    const bf16_t* OGg = (const bf16_t*)(ws + WS_OG) + gbase; const bf16_t* QCg = (const bf16_t*)(ws + WS_R2) + gbase;
    const float* OLg = p.out + gbase; bf16_t* Og = (bf16_t*)(p.ws + WS_R2) + gbase;
    const float* Ls = (const float*)(ws + WS_LSEG) + (size_t)bh * 3 * 16384; const float* Ds = (const float*)(ws + WS_DSEG) + (size_t)bh * 4 * 128;
    { f32x4 S[8];
#pragma unroll
      for (int i = 0; i < 8; ++i) S[i] = (f32x4){0.f, 0.f, 0.f, 0.f};
      f32x4 Lr[3][8]; float Dr[3][8];
#pragma unroll
      for (int sp = 0; sp < 3; ++sp)
#pragma unroll
          for (int i = 0; i < 8; ++i) { const int e4 = (tid + 512 * i) * 4, dd = e4 >> 7;
              if (sp < seg) { Lr[sp][i] = *(const f32x4*)(Ls + (size_t)sp * 16384 + e4); Dr[sp][i] = Ds[sp * 128 + dd]; } else { Lr[sp][i] = (f32x4){0.f, 0.f, 0.f, 0.f}; Dr[sp][i] = 1.f; } }
#pragma unroll
      for (int sp = 0; sp < 3; ++sp)
#pragma unroll
          for (int i = 0; i < 8; ++i) S[i] = S[i] * Dr[sp][i] + Lr[sp][i];
#pragma unroll
      for (int i = 0; i < 8; ++i) { const int e4 = (tid + 512 * i) * 4, dd = e4 >> 7, v0 = e4 & 127;
#pragma unroll
          for (int j = 0; j < 4; ++j) SB[(v0 + j) * 136 + dd] = f2bf(S[i][j]);
          if (seg == 3) { float* So = p.out + O_HP + (size_t)bh * 16384 + e4; *(f32x4*)So = S[i] * Ds[3 * 128 + dd] + *(const f32x4*)So; } } }
    const int qrow0 = tid >> 4, qc8 = (tid & 15) * 8;
    const int tb = wid & 3, vh = wid >> 2;
    const f32x4 onv[4] = { *(const f32x4*)(p.hgrn_onorm + h * 128 + (vh * 4 + 0) * 16 + fq * 4), *(const f32x4*)(p.hgrn_onorm + h * 128 + (vh * 4 + 1) * 16 + fq * 4),
                           *(const f32x4*)(p.hgrn_onorm + h * 128 + (vh * 4 + 2) * 16 + fq * 4), *(const f32x4*)(p.hgrn_onorm + h * 128 + (vh * 4 + 3) * 16 + fq * 4) };
    u32x4 nq[2];
#pragma unroll
    for (int i = 0; i < 2; ++i) nq[i] = *(const u32x4*)(QCg + ((size_t)seg * 512 + qrow0 + 32 * i) * 1024 + qc8);
    f32x4 nol[4]; u32x2 nog[4];
    { const size_t tokf = (size_t)seg * 512 + tb * 16 + fr;
#pragma unroll
      for (int vi = 0; vi < 4; ++vi) { nol[vi] = *(const f32x4*)(OLg + tokf * 1024 + (vh * 4 + vi) * 16 + fq * 4); nog[vi] = *(const u32x2*)(OGg + tokf * 1024 + (vh * 4 + vi) * 16 + fq * 4); } }
    for (int cc = 0; cc < 8; ++cc) {
        const size_t t0 = (size_t)seg * 512 + cc * 64;
#pragma unroll
        for (int i = 0; i < 2; ++i) *(LAS u32x4*)(QT + (qrow0 + 32 * i) * 136 + qc8) = nq[i];
        __syncthreads();
        if (cc + 1 < 8) {
#pragma unroll
            for (int i = 0; i < 2; ++i) nq[i] = *(const u32x4*)(QCg + (t0 + 64 + qrow0 + 32 * i) * 1024 + qc8); }
        const size_t tok = t0 + tb * 16 + fr;
        f32x4 oacc[4]; u32x2 ogv[4];
#pragma unroll
        for (int vi = 0; vi < 4; ++vi) { oacc[vi] = nol[vi]; ogv[vi] = nog[vi]; }
        if (cc + 1 < 8) {
#pragma unroll
            for (int vi = 0; vi < 4; ++vi) { nol[vi] = *(const f32x4*)(OLg + (tok + 64) * 1024 + (vh * 4 + vi) * 16 + fq * 4); nog[vi] = *(const u32x2*)(OGg + (tok + 64) * 1024 + (vh * 4 + vi) * 16 + fq * 4); } }
        { bf16x8 qf[4];
#pragma unroll
          for (int kk = 0; kk < 4; ++kk) qf[kk] = lds_frag(QT + (tb * 16 + fr) * 136 + kk * 32 + fq * 8);
#pragma unroll
          for (int vi = 0; vi < 4; ++vi) { const int vb = vh * 4 + vi; f32x4 a = oacc[vi];
#pragma unroll
              for (int kk = 0; kk < 4; ++kk) a = __builtin_amdgcn_mfma_f32_16x16x32_bf16(lds_frag(SB + (vb * 16 + fr) * 136 + kk * 32 + fq * 8), qf[kk], a, 0, 0, 0);
              oacc[vi] = a; } }
        { float ss = 0.f;
#pragma unroll
          for (int vi = 0; vi < 4; ++vi) ss += oacc[vi][0] * oacc[vi][0] + oacc[vi][1] * oacc[vi][1] + oacc[vi][2] * oacc[vi][2] + oacc[vi][3] * oacc[vi][3];
          ss += __shfl_xor(ss, 16); ss += __shfl_xor(ss, 32);
          if (fq == 0) SSQ[vh * 64 + tb * 16 + fr] = ss; }
        __syncthreads();
        { const float tot = SSQ[tb * 16 + fr] + SSQ[64 + tb * 16 + fr]; const float rs = rsqrtf(tot * (1.f / 128.f) + EPS);
#pragma unroll
          for (int vi = 0; vi < 4; ++vi) { const f32x4 o = oacc[vi] * rs * onv[vi];
              u32x2 w; w.x = cvt_pk_bf16(o[0] * bflo(ogv[vi].x), o[1] * bfhi(ogv[vi].x)); w.y = cvt_pk_bf16(o[2] * bflo(ogv[vi].y), o[3] * bfhi(ogv[vi].y));
              *(u32x2*)(Og + tok * 1024 + (vh * 4 + vi) * 16 + fq * 4) = w; } }
    }
    __syncthreads();
}

__device__ __forceinline__ float* part_slot(unsigned char* ws, int k) { return (float*)(ws + WS_PART + (size_t)k * PART_SLOT); }
__device__ __forceinline__ float row_ssq16(const float* slot, size_t row) {
    const f32x4* pp = (const f32x4*)(slot + row * 16); const f32x4 t = (pp[0] + pp[1]) + (pp[2] + pp[3]); return (t[0] + t[1]) + (t[2] + t[3]); }
__device__ __forceinline__ float row_ssq64(const float* slot, int r) {
    const f32x4* pp = (const f32x4*)(slot + (size_t)TP * 16 + (size_t)r * 64); f32x4 t = pp[0];
#pragma unroll
    for (int i = 1; i < 16; ++i) t = t + pp[i];
    return (t[0] + t[1]) + (t[2] + t[3]); }
__device__ __forceinline__ void phase_pool(const Params& p, LAS unsigned char* lds) {
    const int tid = threadIdx.x, c = tid * 2, gi = c >> 8, w = 2 << gi;
    LAS f32x2* ring = (LAS f32x2*)lds;
    const float* slot = part_slot(p.ws, 1);
    bf16_t* Z = (bf16_t*)(p.ws + WS_R2);
    const bf16_t* XBs = (const bf16_t*)(p.ws + WS_XB);
    const f32x2 gp = *(const f32x2*)(p.pool_norm + c);
    for (int unit = blockIdx.x; unit < 256; unit += gridDim.x) {
        const int b = unit >> 5, t0 = (unit & 31) * 64;
#pragma unroll
        for (int i = 0; i < 16; ++i) ring[i * 512 + tid] = (f32x2){0.f, 0.f};
        f32x2 sum = (f32x2){0.f, 0.f};
        LAS float* rsl = (LAS float*)(lds + 65536);
        __syncthreads();
        if (tid < 80) { const int t = t0 - 16 + tid; rsl[tid] = t >= 0 ? rsqrtf(row_ssq16(slot, (size_t)b * SEQ + t) * (1.f / 1024.f) + EPS) : 0.f; }
        __syncthreads();
        for (int tt = -16; tt < 64; tt += 16) {
            unsigned xw[16];
#pragma unroll
            for (int i = 0; i < 16; ++i) { const int t = t0 + tt + i; xw[i] = t >= 0 ? *(const unsigned*)(XBs + ((size_t)b * SEQ + t) * 1024 + c) : 0u; }
#pragma unroll
            for (int i = 0; i < 16; ++i) { const int t = t0 + tt + i; const float rs = rsl[tt + 16 + i];
                const f32x2 u = (f32x2){bflo(xw[i]), bfhi(xw[i])} * rs * gp;
                const f32x2 old = ring[((t - w) & 15) * 512 + tid];
                ring[(t & 15) * 512 + tid] = u; sum = sum + u - old;
                if (tt + i >= 0) { const float cnt = (float)min(w, t + 1); const f32x2 z = sum / cnt - u; const size_t row = (size_t)b * SEQ + t;
                    *(unsigned*)(Z + row * 1024 + c) = cvt_pk_bf16(z[0], z[1]);
                    if (t >= SEQ - 15) *(f32x2*)(p.out + O_PP + ((size_t)b * 15 + (t - (SEQ - 15))) * 1024 + c) = u; } }
        }
    }
    for (int sb = blockIdx.x; sb < TS; sb += gridDim.x) {
        const size_t row = (size_t)TP + sb;
        const float rs = rsqrtf(row_ssq64(slot, sb) * (1.f / 1024.f) + EPS);
        const f32x2 u = *(const f32x2*)(p.out + row * 1024 + c) * rs * gp;
        const float* hist = p.state_pool + (size_t)sb * 15 * 1024 + c;
        float* ho = p.out + O_PS + (size_t)sb * 15 * 1024 + c;
        f32x2 sum = u;
#pragma unroll
        for (int j = 0; j < 15; ++j) { const f32x2 hv = *(const f32x2*)(hist + (size_t)j * 1024); if (j >= 16 - w) sum = sum + hv; if (j >= 1) *(f32x2*)(ho + (size_t)(j - 1) * 1024) = hv; }
        *(f32x2*)(ho + (size_t)14 * 1024) = u;
        const f32x2 z = sum / (float)w - u;
        *(unsigned*)(Z + row * 1024 + c) = cvt_pk_bf16(z[0], z[1]);
    }
}

__device__ __forceinline__ void phase_final(const Params& p) {
    const int tid = threadIdx.x, wid = tid >> 6, lane = tid & 63;
    const float* slot = part_slot(p.ws, 3);
    const int r = blockIdx.x * 8 + wid;
    if (r < TS) {
        float* xr = p.out + O_YS + (size_t)r * 1024;
        const float rs = rsqrtf(wave_sum(slot[(size_t)TP * 16 + (size_t)r * 64 + lane]) * (1.f / 1024.f) + EPS);
#pragma unroll
        for (int j = 0; j < 4; ++j) { const f32x4 v = *(const f32x4*)(xr + lane * 4 + 256 * j); const f32x4 g = *(const f32x4*)(p.final_norm + lane * 4 + 256 * j); *(f32x4*)(xr + lane * 4 + 256 * j) = v * rs * g; }
    }
}

#define XB_TMO      128
#define XB_XCNT(j)  (256  + 64 * (j))
#define XB_XSUB(j)  (1280 + 64 * (j))
#define XB_XGEN(j)  (2304 + 64 * (j))
#define XB_TOP      3328
#define XB_TOPGEN   3392
#define XCD_BAR_WORDS 3456
#define XB_SPIN_CAP (1u << 18)
__device__ __forceinline__ unsigned xb_ld(unsigned* p)              { return __hip_atomic_load(p, __ATOMIC_RELAXED, __HIP_MEMORY_SCOPE_AGENT); }
__device__ __forceinline__ unsigned xb_add(unsigned* p, unsigned v) { return __hip_atomic_fetch_add(p, v, __ATOMIC_RELAXED, __HIP_MEMORY_SCOPE_AGENT); }
__device__ __forceinline__ unsigned xb_xcc_id() { return (unsigned)__builtin_amdgcn_s_getreg((3 << 11) | 20) & 0xFu; }
#define XB_SPIN(cond, bar) do { unsigned _sp = 0; while (cond) { __builtin_amdgcn_s_sleep(1); \
    if ((++_sp & 255u) == 0u) { if (xb_ld(&(bar)[XB_TMO])) break; if (_sp > XB_SPIN_CAP) { atomicAdd(&(bar)[XB_TMO], 1u); break; } } } } while (0)
struct XcdBarrier { unsigned* bar; unsigned x; volatile LAS unsigned* st; };
__device__ __forceinline__ XcdBarrier xcd_barrier_post(unsigned* bar, volatile LAS unsigned* st) {
    XcdBarrier b; b.bar = bar; b.x = xb_xcc_id(); b.st = st;
    if (threadIdx.x == 0) (void)xb_add(&bar[XB_XCNT(b.x)], 1u);
    return b;
}
__device__ __forceinline__ void xcd_barrier_complete(unsigned* bar, unsigned x, unsigned& nloc, unsigned& nx) {
    const unsigned G = gridDim.x * gridDim.y * gridDim.z;
    unsigned sum, cnt, mine, sp = 0u;
    for (;;) {
        sum = 0u; cnt = 0u; mine = 0u;
#pragma unroll
        for (unsigned j = 0; j < 16; ++j) { const unsigned c = xb_ld(&bar[XB_XCNT(j)]); sum += c; cnt += (c > 0u) ? 1u : 0u; mine = (j == x) ? c : mine; }
        if (sum == G) break;
        __builtin_amdgcn_s_sleep(1);
        if ((++sp & 255u) == 0u) { if (xb_ld(&bar[XB_TMO])) break; if (sp > XB_SPIN_CAP) { atomicAdd(&bar[XB_TMO], 1u); break; } }
    }
    nloc = mine > 0u ? mine : 1u; nx = cnt > 0u ? cnt : 1u;
}
__device__ __forceinline__ void xcd_barrier(const XcdBarrier& b) {
    asm volatile("s_waitcnt vmcnt(0)" ::: "memory");
    __syncthreads();
    if (threadIdx.x == 0) {
        unsigned* bar = b.bar;
        __builtin_amdgcn_s_waitcnt(0);
        unsigned nloc = b.st[0], nx = b.st[1];
        if (nloc == 0u) { xcd_barrier_complete(bar, b.x, nloc, nx); b.st[0] = nloc; b.st[1] = nx; }
        const unsigned old = xb_add(&bar[XB_XSUB(b.x)], 1u);
        const unsigned gen = old / nloc;
        if (old + 1u == (gen + 1u) * nloc) {
            __builtin_amdgcn_fence(__ATOMIC_RELEASE, "agent");
            asm volatile("s_waitcnt vmcnt(0)" ::: "memory");
            const unsigned og = xb_add(&bar[XB_TOP], 1u);
            const unsigned tg = og / nx;
            if (og + 1u == (tg + 1u) * nx) xb_add(&bar[XB_TOPGEN], 1u);
            else XB_SPIN(xb_ld(&bar[XB_TOPGEN]) == tg, bar);
            __builtin_amdgcn_fence(__ATOMIC_ACQUIRE, "agent");
            xb_add(&bar[XB_XGEN(b.x)], 1u);
            asm volatile("s_waitcnt vmcnt(0)" ::: "memory");
        } else {
            XB_SPIN(xb_ld(&bar[XB_XGEN(b.x)]) == gen, bar);
            __builtin_amdgcn_fence(__ATOMIC_ACQUIRE, "agent");
            asm volatile("s_waitcnt vmcnt(0)" ::: "memory");
        }
    }
    __syncthreads();
}
#define PH_ON(n) ((PHMASK & (1 << (n))) && p.ph_lo <= (n) && (n) < p.ph_hi)
#define PH_SYNC(n) do { if (p.ph_lo < (n) && (n) < p.ph_hi) { xcd_barrier(xb); } } while (0)
__device__ __forceinline__ void ph_in(const Params& p, LAS unsigned char* lds) {
    unsigned char* ws = p.ws; pg8::StaticOrder S;
    EpiIn E{(bf16_t*)(ws + WS_Q), (bf16_t*)(ws + WS_V), (bf16_t*)(ws + WS_OG), (bf16_t*)(ws + WS_G), (const float*)(ws + WS_LB)};
    pg8::Gemm g{(const bf16_t*)(ws + WS_R2), (const bf16_t*)(ws + WS_WIN), TP, 4096, 1024, 1024, 0};
    S.init(g.M, g.N, gridDim.x, blockIdx.x); pg8::gemm_phase(lds, g, S, E);
    SIn F{E.Q, E.V, E.OG, E.G, (const float*)(ws + WS_LB)};
    sample_gemm<4>(lds, (const bf16_t*)(ws + WS_R2) + (size_t)TP * 1024, 1024, 0, (const bf16_t*)(ws + WS_WIN), 1024, F);
}
__device__ __forceinline__ void ph_rec1(const Params& p, LAS unsigned char* lds) {
    for (int it = blockIdx.x; it < 256; it += gridDim.x) { const int seg = it & 3, bh = it >> 2; rec_prompt(p, lds, bh >> 3, bh & 7, seg); }
}
__device__ __forceinline__ void ph_rec2(const Params& p, LAS unsigned char* lds) {
    for (int it = blockIdx.x; it < 256; it += gridDim.x) { const int seg = it & 3, bh = it >> 2; if (seg > 0) rec_fix(p, lds, bh >> 3, bh & 7, seg); }
    if (gridDim.x == 256) {
        const int seg = blockIdx.x & 3, bh = blockIdx.x >> 2;
        if (seg == 0) rec_sample_list(p, lds, bh * 10, 1, 10);
        else { const int k = bh * 3 + (seg - 1); rec_sample_list(p, lds, 640 + k, 192, 2); }
    } else rec_sample_list(p, lds, blockIdx.x, gridDim.x, (TS * 8 - (int)blockIdx.x + (int)gridDim.x - 1) / (int)gridDim.x);
}
__device__ __forceinline__ void ph_out(const Params& p, LAS unsigned char* lds, bool dummy = false) {
    unsigned char* ws = p.ws; pg8::StaticOrder S; float* slot = dummy ? (float*)nullptr : part_slot(ws, 0);
    EpiRes<false, false> E{p.x_prompt, nullptr, nullptr, (bf16_t*)(ws + WS_XB), nullptr, slot};
    pg8::Gemm g{(const bf16_t*)(ws + WS_R2), (const bf16_t*)(ws + WS_WOUT), TP, 1024, 1024, 1024, 0};
    S.init(g.M, g.N, gridDim.x, blockIdx.x); pg8::gemm_phase(lds, g, S, E);
    SRes F{p.x_sample, p.out + O_YS, (bf16_t*)(ws + WS_XB) + (size_t)TP * 1024, nullptr, dummy ? (float*)nullptr : slot + (size_t)TP * 16};
    sample_gemm<1>(lds, (const bf16_t*)(ws + WS_R2) + (size_t)TP * 1024, 1024, 0, (const bf16_t*)(ws + WS_WOUT), 1024, F);
}
__device__ __forceinline__ void ph_up(const Params& p, LAS unsigned char* lds, int L) {
    unsigned char* ws = p.ws; pg8::StaticOrder S; float* sq = part_slot(ws, L ? 2 : 0);
    const bf16_t* W = (const bf16_t*)(ws + (L ? WS_WUP1 : WS_WUP0));
    EpiUp E{(bf16_t*)(ws + WS_H), sq};
    pg8::Gemm g{(const bf16_t*)(ws + WS_XB), W, TP, 4096, 1024, 1024, 0};
    S.init(g.M, g.N, gridDim.x, blockIdx.x); pg8::gemm_phase(lds, g, S, E);
    SUp F{(bf16_t*)(ws + WS_H) + (size_t)TP * 4096, sq + (size_t)TP * 16};
    sample_gemm<4>(lds, (const bf16_t*)(ws + WS_XB) + (size_t)TP * 1024, 1024, 0, W, 1024, F);
}
__device__ __forceinline__ void ph_down(const Params& p, LAS unsigned char* lds, int L) {
    unsigned char* ws = p.ws; pg8::StaticOrder S; float* sq = part_slot(ws, L ? 3 : 1);
    const bf16_t* W = (const bf16_t*)(ws + (L ? WS_WDN1 : WS_WDN0));
    pg8::Gemm g{(const bf16_t*)(ws + WS_H), W, TP, 1024, 4096, 4096, 0};
    S.init(g.M, g.N, gridDim.x, blockIdx.x);
    if (L == 0) { EpiRes<true, false> E{nullptr, (const bf16_t*)(ws + WS_XB), nullptr, (bf16_t*)(ws + WS_XB), nullptr, sq}; pg8::gemm_phase(lds, g, S, E); }
    else { EpiFinal E{(const bf16_t*)(ws + WS_XB), p.out, p.final_norm, sq, (unsigned*)(ws + WS_BAR) + XCD_BAR_WORDS}; pg8::gemm_phase(lds, g, S, E); }
    SRes F{p.out + O_YS, p.out + O_YS, nullptr, nullptr, sq + (size_t)TP * 16};
    sample_gemm<1>(lds, (const bf16_t*)(ws + WS_H) + (size_t)TP * 4096, 4096, 0, W, 4096, F);
}
__device__ __forceinline__ void ph_poolg(const Params& p, LAS unsigned char* lds) {
    unsigned char* ws = p.ws; pg8::StaticOrder S; float* sq = part_slot(ws, 2);
    EpiRes<true, false> E{nullptr, (const bf16_t*)(ws + WS_XB), nullptr, (bf16_t*)(ws + WS_XB), p.pool_scale, sq};
    pg8::Gemm g{(const bf16_t*)(ws + WS_R2), (const bf16_t*)(ws + WS_WP), TP, 1024, 256, 1024, 256};
    S.init(g.M, g.N, gridDim.x, blockIdx.x); pg8::gemm_phase(lds, g, S, E);
    SRes F{p.out + O_YS, p.out + O_YS, (bf16_t*)(ws + WS_XB) + (size_t)TP * 1024, p.pool_scale, sq + (size_t)TP * 16};
    sample_gemm<1>(lds, (const bf16_t*)(ws + WS_R2) + (size_t)TP * 1024, 1024, 256, (const bf16_t*)(ws + WS_WP), 256, F);
}
__global__ void __launch_bounds__(512, 2) mega(Params p) {
    extern __shared__ __attribute__((aligned(16))) unsigned char shm[];
    LAS unsigned char* lds = (LAS unsigned char*)shm;
    volatile LAS unsigned* xst = (volatile LAS unsigned*)(lds + 151552);
    if (threadIdx.x == 0) { xst[0] = 0u; xst[1] = 0u; }
    __syncthreads();
    const XcdBarrier xb = xcd_barrier_post((unsigned*)(p.ws + WS_BAR), xst);
    if (p.ph_hi > 4096) cg::this_grid().sync();
    phase_prep(p, lds);
    if (DUP_PHASE == 0) { xcd_barrier(xb); phase_prep(p, lds); }
    if (DUP_PHASE == 20) { for (int i = 0; i < 20; ++i) xcd_barrier(xb); }
    xcd_barrier(xb); ph_in(p, lds);
    if (DUP_PHASE == 1) { xcd_barrier(xb); ph_in(p, lds); }
    xcd_barrier(xb); ph_rec1(p, lds);
    if (DUP_PHASE == 2) { xcd_barrier(xb); ph_rec1(p, lds); }
    xcd_barrier(xb); ph_rec2(p, lds);
    xcd_barrier(xb); ph_out(p, lds);
    if (DUP_PHASE == 3) { xcd_barrier(xb); ph_out(p, lds); }
    xcd_barrier(xb); ph_up(p, lds, 0);
    if (DUP_PHASE == 4) { xcd_barrier(xb); ph_up(p, lds, 0); }
    xcd_barrier(xb); ph_down(p, lds, 0);
    xcd_barrier(xb); phase_pool(p, lds);
    if (DUP_PHASE == 6) { xcd_barrier(xb); phase_pool(p, lds); }
    xcd_barrier(xb); ph_poolg(p, lds);
    xcd_barrier(xb); ph_up(p, lds, 1);
    xcd_barrier(xb); ph_down(p, lds, 1);
    if (DUP_PHASE == 9) { xcd_barrier(xb); ph_down(p, lds, 1); }
    xcd_barrier(xb);
    phase_final(p);
}

extern "C" void kernel_launch(void* const* d_in, const int* in_sizes, int n_in, void* d_out, int out_size, void* d_ws, size_t ws_size, hipStream_t stream) {
    static int grid = 0;
    if (grid == 0) {
        int dev = 0, cus = 0, per_cu = 0;
        hipGetDevice(&dev);
        hipDeviceGetAttribute(&cus, hipDeviceAttributeMultiprocessorCount, dev);
        if (hipFuncSetAttribute((const void*)mega, hipFuncAttributeMaxDynamicSharedMemorySize, LDS_BYTES) != hipSuccess) fprintf(stderr, "kernel_launch: hipFuncSetAttribute failed\n");
        if (hipOccupancyMaxActiveBlocksPerMultiprocessor(&per_cu, (const void*)mega, 512, LDS_BYTES) != hipSuccess || per_cu < 1) { fprintf(stderr, "kernel_launch: occupancy query gave %d\n", per_cu); per_cu = 1; }
        (void)hipGetLastError();
        grid = cus * per_cu;
        if (ws_size < WS_END3) fprintf(stderr, "kernel_launch: workspace too small: %zu < %zu\n", ws_size, (size_t)WS_END3);
        fprintf(stderr, "kernel_launch: grid %d (cus %d x %d), ws %zu\n", grid, cus, per_cu, ws_size);
    }
    Params p{};
    const float** pp = (const float**)&p;
    for (int i = 0; i < 16; ++i) pp[i] = (const float*)d_in[i];
    p.out = (float*)d_out; p.ws = (unsigned char*)d_ws;
    (void)hipMemsetAsync((unsigned char*)d_ws + WS_BAR, 0, 16384, stream);
    p.ph_lo = 0; p.ph_hi = NPHASE;
    void* args[] = {&p};
    hipError_t e = hipLaunchCooperativeKernel((const void*)mega, dim3(grid), dim3(512), args, LDS_BYTES, stream);
    if (e != hipSuccess) fprintf(stderr, "cooperative launch failed: %s (grid %d)\n", hipGetErrorString(e), grid);
}
```

```cpp
#include <hip/hip_runtime.h>
#include <hip/hip_cooperative_groups.h>
#include <cstdio>
namespace cg = cooperative_groups;

#define LAS __attribute__((address_space(3)))
typedef unsigned short bf16_t;
typedef short bf16x8 __attribute__((ext_vector_type(8)));
typedef float f32x4 __attribute__((ext_vector_type(4)));
typedef float f32x2 __attribute__((ext_vector_type(2)));
typedef unsigned u32x4 __attribute__((ext_vector_type(4)));
typedef unsigned u32x2 __attribute__((ext_vector_type(2)));

#ifndef PHMASK
#define PHMASK 0x7ff
#endif
#ifndef DUP_PHASE
#define DUP_PHASE -1
#endif
#ifndef EXTRA_SYNCS
#define EXTRA_SYNCS 0
#endif
#ifndef MK_LAUNCHES
#define MK_LAUNCHES 1
#endif

constexpr int D = 1024, TP = 16384, TS = 128, MP = TP + TS, FF = 4096, SEQ = 2048;
constexpr float EPS = 1e-6f;
constexpr int NPHASE = 11;
constexpr int LDS_BYTES = 151552 + 16;

constexpr size_t WS_WIN = 0;
constexpr size_t WS_WOUT = WS_WIN + (size_t)4096 * 1024 * 2;
constexpr size_t WS_WUP0 = WS_WOUT + (size_t)1024 * 1024 * 2;
constexpr size_t WS_WDN0 = WS_WUP0 + (size_t)4096 * 1024 * 2;
constexpr size_t WS_WP = WS_WDN0 + (size_t)4096 * 1024 * 2;
constexpr size_t WS_WUP1 = WS_WP + (size_t)1024 * 256 * 2;
constexpr size_t WS_WDN1 = WS_WUP1 + (size_t)4096 * 1024 * 2;
constexpr size_t WS_SSQ = WS_WDN1 + (size_t)4096 * 1024 * 2;
constexpr size_t WS_LB = WS_SSQ + 264192;
constexpr size_t WS_BAR = WS_SSQ + 268288;
constexpr size_t WS_R2 = WS_SSQ + 284672;
constexpr size_t ACT_B = (size_t)MP * 1024 * 2;
constexpr size_t WS_R1 = WS_R2 + ACT_B;
constexpr size_t WS_Q = WS_R1, WS_V = WS_R1 + ACT_B, WS_OG = WS_R1 + 2 * ACT_B, WS_G = WS_R1 + 3 * ACT_B;
constexpr size_t WS_H = WS_R1;
constexpr size_t WS_XB = WS_R1 + (size_t)MP * 4096 * 2;
constexpr size_t WS_END = WS_R1 + 5 * ACT_B;
constexpr size_t WS_PART = WS_END;
constexpr size_t PART_SLOT = (size_t)TP * 16 * 4 + (size_t)TS * 64 * 4;
constexpr size_t WS_END2 = WS_PART + 4 * PART_SLOT;
constexpr size_t WS_LSEG = WS_END2;
constexpr size_t WS_END3 = WS_LSEG + (size_t)64 * 3 * 16384 * 4;
constexpr size_t WS_DSEG = WS_SSQ;

constexpr size_t O_YP = 0, O_YS = 16777216, O_HP = 16908288, O_HS = 17956864, O_PP = 34734080, O_PS = 34856960;

struct Params {
    const float *x_prompt, *x_sample, *state_hgrn, *state_pool, *hgrn_norm, *hgrn_w_in, *hgrn_lb, *hgrn_onorm, *hgrn_w_out,
        *pool_norm, *pool_w, *pool_scale, *mlp_norm, *mlp_up, *mlp_down, *final_norm;
    float* out;
    unsigned char* ws;
    int ph_lo, ph_hi;
};

typedef __bf16 bf16x2_native __attribute__((ext_vector_type(2)));
__device__ __forceinline__ unsigned cvt_pk_bf16(float lo, float hi) { const f32x2 f = {lo, hi}; return __builtin_bit_cast(unsigned, __builtin_convertvector(f, bf16x2_native)); }
__device__ __forceinline__ float bf2f(bf16_t b) { return __uint_as_float(((unsigned)b) << 16); }
__device__ __forceinline__ float bflo(unsigned w) { return __uint_as_float(w << 16); }
__device__ __forceinline__ float bfhi(unsigned w) { return __uint_as_float(w & 0xffff0000u); }
__device__ __forceinline__ bf16_t f2bf(float f) { return (bf16_t)(cvt_pk_bf16(f, 0.f) & 0xffffu); }
typedef _Float16 half2_t __attribute__((ext_vector_type(2)));
__device__ __forceinline__ unsigned cvt_pk_f16(float a, float b) { half2_t h = {(_Float16)a, (_Float16)b}; return __builtin_bit_cast(unsigned, h); }
__device__ __forceinline__ f32x2 h2_to_f2(unsigned w) { const half2_t h = __builtin_bit_cast(half2_t, w); return (f32x2){(float)h[0], (float)h[1]}; }
__device__ __forceinline__ float sigmoidf_(float x) { return __builtin_amdgcn_rcpf(1.f + __expf(-x)); }
__device__ __forceinline__ float wave_sum(float v) {
#pragma unroll
    for (int o = 1; o < 64; o <<= 1) v += __shfl_xor(v, o);
    return v;
}
__device__ __forceinline__ float ein_elem(int type, float x, float lbc) {
    if (type == 0) return x * sigmoidf_(x) * 0.08838834764831845f;
    if (type == 1) return __builtin_amdgcn_logf(lbc + (1.f - lbc) * sigmoidf_(x)) * 0.6931471805599453f;
    if (type == 2) return x;
    return sigmoidf_(x);
}
__device__ __forceinline__ float lb_of(const float* lb, int c) { return 1.f / (1.f + __expf(lb[1024 + c] - lb[c])); }

namespace pg8 {
constexpr int BM = 256, BK = 64, HALF = 128, HTB = HALF * BK * 2, STAGE_BYTES = 8 * HTB, NXCD = 8, WGM = 8;
__host__ __device__ __forceinline__ int lds_byte(int r, int c) { const int st = (r >> 4) * 2 + (c >> 5), rr = r & 15, cc = c & 31, ob = rr * 64 + cc * 2; return st * 1024 + (ob ^ (((ob >> 9) & 1) << 5)); }
__host__ __device__ __forceinline__ void stage_rc(int b, int& R, int& C) { const int st = b / 1024, sb = b % 1024, swz = sb ^ (((sb >> 9) & 1) << 5); R = (st >> 1) * 16 + swz / 64; C = (st & 1) * 32 + (swz % 64) / 2; }
__host__ __device__ __forceinline__ int perm32(int rho) { const int n = rho >> 4, i = rho & 15; return 8 * (i >> 2) + 4 * n + (i & 3); }
struct Unit { int pm, pn; };
struct Gemm { const bf16_t* A; const bf16_t* Bt; int M, N, K, lda, agroup; };
struct StaticOrder {
    int nM, nN, nwg, G, c;
    __device__ void init(int M, int N, int G_, int c_) { nM = M / BM; nN = N / BM; nwg = nM * nN; G = G_; c = c_; }
    __device__ bool next(int i, Unit& u) const {
        const long L = (long)i * G + c; if (L >= nwg) return false;
        int wgid = (int)L; { const int q = nwg / NXCD, r = nwg % NXCD, xcd = wgid % NXCD, off = wgid / NXCD; wgid = (xcd < r ? xcd * (q + 1) : r * (q + 1) + (xcd - r) * q) + off; }
        const int nig = WGM * nN, gid = wgid / nig, fm = gid * WGM, gsz = (nM - fm) < WGM ? (nM - fm) : WGM;
        u.pm = fm + ((wgid % nig) % gsz); u.pn = (wgid % nig) / gsz; return true;
    }
};

template <class Epi>
__device__ __forceinline__ void gemm_phase(LAS unsigned char* lds, const Gemm g, const StaticOrder& S, const Epi& E) {
    int tid_ = threadIdx.x; asm volatile("" : "+v"(tid_));
    const int tid = tid_, wid = __builtin_amdgcn_readfirstlane(tid >> 6), lane = tid & 63, wr = wid >> 2, wc = wid & 3, fr = lane & 15, fq = lane >> 4;
    const int K = g.K, nt = K / BK, lda = g.lda;
    unsigned voffA[2], voffB[2];
#pragma unroll
    for (int i = 0; i < 2; ++i) { int R, C; stage_rc(tid * 16 + i * 8192, R, C); const int Rb = (R & ~31) + perm32(R & 31);
        voffA[i] = (unsigned)(R * lda + C) * 2u; voffB[i] = (unsigned)(Rb * K + C) * 2u; }
    const size_t kstep = (size_t)(BK * 2);
    const size_t hstepA = (size_t)HALF * lda * 2, hstepB = (size_t)HALF * K * 2;
    const size_t tstepA = 2 * hstepA, tstepB = 2 * hstepB;
    const unsigned ldsw = (unsigned)wid * 1024u;
    const int aoff = lds_byte(wr * 64 + fr, fq * 8), boff = lds_byte(wc * 32 + fr, fq * 8);
#define PG8_SA(b, h) (((b) * 2 + (h)) * HTB)
#define PG8_SB(b, h) ((4 + (b) * 2 + (h)) * HTB)
#define PG8_STAGE(bufoff, gbase, voff) do { _Pragma("unroll") for (int _i = 0; _i < 2; ++_i) \
        __builtin_amdgcn_global_load_lds((const unsigned*)((const char*)(gbase) + (voff)[_i]), (LAS unsigned*)(lds + (bufoff) + ldsw + _i * 8192), 16, 0, 0); } while (0)
#define PG8_LDA(dst, b, h) do { _Pragma("unroll") for (int m = 0; m < 4; ++m) _Pragma("unroll") for (int k = 0; k < 2; ++k) dst[m][k] = *(const LAS bf16x8*)(lds + PG8_SA(b, h) + aoff + m * 2048 + k * 1024); } while (0)
#define PG8_LDB(dst, b, h) do { _Pragma("unroll") for (int n = 0; n < 2; ++n) _Pragma("unroll") for (int k = 0; k < 2; ++k) dst[n][k] = *(const LAS bf16x8*)(lds + PG8_SB(b, h) + boff + n * 2048 + k * 1024); } while (0)
#define PG8_MMA(ai, bj, At, Bt) do { __builtin_amdgcn_s_setprio(1); _Pragma("unroll") for (int m = 0; m < 4; ++m) _Pragma("unroll") for (int n = 0; n < 2; ++n) _Pragma("unroll") for (int k = 0; k < 2; ++k) \
        acc[ai][bj][m][n] = __builtin_amdgcn_mfma_f32_16x16x32_bf16(Bt[n][k], At[m][k], acc[ai][bj][m][n], 0, 0, 0); __builtin_amdgcn_s_setprio(0); } while (0)
#define PG8_WAIT_V(n) asm volatile("s_waitcnt vmcnt(" #n ")" ::: "memory")
#define PG8_WAIT_L(n) asm volatile("s_waitcnt lgkmcnt(" #n ")" ::: "memory")
#define PG8_BAR __builtin_amdgcn_s_barrier()
#define PG8_SCHED __builtin_amdgcn_sched_barrier(0)
    Unit cur, nxt; int ui = 0;
    if (!S.next(0, cur)) return;
    f32x4 acc[2][2][4][2];
#pragma unroll
    for (int a = 0; a < 2; ++a)
#pragma unroll
        for (int b = 0; b < 2; ++b)
#pragma unroll
            for (int m = 0; m < 4; ++m)
#pragma unroll
                for (int n = 0; n < 2; ++n) acc[a][b][m][n] = (f32x4){0.f, 0.f, 0.f, 0.f};
    bf16x8 At[4][2], B0[2][2], B1[2][2];
    const char* cA = (const char*)g.A + (size_t)cur.pm * tstepA + (size_t)cur.pn * g.agroup * 2; const char* cB = (const char*)g.Bt + (size_t)cur.pn * tstepB;
    PG8_STAGE(PG8_SB(0, 0), cB, voffB); PG8_STAGE(PG8_SA(0, 0), cA, voffA); PG8_STAGE(PG8_SB(0, 1), cB + hstepB, voffB); PG8_STAGE(PG8_SA(0, 1), cA + hstepA, voffA);
    if (wr == 1) PG8_BAR;
    PG8_WAIT_V(4); PG8_BAR;
    PG8_STAGE(PG8_SB(1, 0), cB + kstep, voffB); PG8_STAGE(PG8_SA(1, 0), cA + kstep, voffA); PG8_STAGE(PG8_SB(1, 1), cB + hstepB + kstep, voffB);
    PG8_WAIT_V(6); PG8_BAR;
    for (;;) {
        const bool has_next = S.next(ui + 1, nxt);
        const char* nA = has_next ? (const char*)g.A + (size_t)nxt.pm * tstepA + (size_t)nxt.pn * g.agroup * 2 : cA; const char* nB = has_next ? (const char*)g.Bt + (size_t)nxt.pn * tstepB : cB;
        for (int t = 0; t < nt; t += 2) {
            const bool last = (t == nt - 2);
            const char* a1 = cA + (size_t)(t + 1) * kstep;
            const char* a2 = last ? nA : cA + (size_t)(t + 2) * kstep; const char* b2 = last ? nB : cB + (size_t)(t + 2) * kstep;
            const char* a3 = a2 + kstep; const char* b3 = b2 + kstep;
            PG8_LDB(B0, 0, 0); PG8_SCHED; PG8_LDA(At, 0, 0); PG8_STAGE(PG8_SA(1, 1), a1 + hstepA, voffA);
            PG8_WAIT_L(8); PG8_BAR; PG8_WAIT_L(0); PG8_MMA(0, 0, At, B0); PG8_BAR; PG8_SCHED;
            PG8_LDB(B1, 0, 1); PG8_STAGE(PG8_SB(0, 0), b2, voffB);
            PG8_BAR; PG8_WAIT_L(0); PG8_MMA(0, 1, At, B1); PG8_BAR;
            PG8_LDA(At, 0, 1); PG8_STAGE(PG8_SA(0, 0), a2, voffA);
            PG8_BAR; PG8_WAIT_L(0); PG8_MMA(1, 0, At, B0); PG8_BAR; PG8_SCHED;
            PG8_STAGE(PG8_SB(0, 1), b2 + hstepB, voffB);
            PG8_WAIT_V(6); PG8_BAR; PG8_MMA(1, 1, At, B1); PG8_BAR;
            PG8_LDB(B0, 1, 0); PG8_SCHED; PG8_LDA(At, 1, 0); PG8_STAGE(PG8_SA(0, 1), a2 + hstepA, voffA);
            PG8_WAIT_L(8); PG8_BAR; PG8_WAIT_L(0); PG8_MMA(0, 0, At, B0); PG8_BAR; PG8_SCHED;
            PG8_LDB(B1, 1, 1); PG8_STAGE(PG8_SB(1, 0), b3, voffB);
            PG8_BAR; PG8_WAIT_L(0); PG8_MMA(0, 1, At, B1); PG8_BAR;
            PG8_LDA(At, 1, 1); PG8_STAGE(PG8_SA(1, 0), a3, voffA);
            PG8_BAR; PG8_WAIT_L(0); PG8_MMA(1, 0, At, B0); PG8_BAR; PG8_SCHED;
            PG8_STAGE(PG8_SB(1, 1), b3 + hstepB, voffB);
            PG8_WAIT_V(6); PG8_BAR; PG8_MMA(1, 1, At, B1); PG8_BAR;
        }
        if constexpr (!Epi::AFTER_DRAIN) E(acc, cur, wr, wc, fr, fq);
        if (!has_next) break;
#pragma unroll
        for (int a = 0; a < 2; ++a)
#pragma unroll
            for (int b = 0; b < 2; ++b)
#pragma unroll
                for (int m = 0; m < 4; ++m)
#pragma unroll
                    for (int n = 0; n < 2; ++n) acc[a][b][m][n] = (f32x4){0.f, 0.f, 0.f, 0.f};
        cur = nxt; cA = nA; cB = nB; ++ui;
    }
    PG8_WAIT_V(0);
    if (wr == 0) PG8_BAR;
    PG8_BAR;
    if constexpr (Epi::AFTER_DRAIN) E.fused(acc, cur, wr, wc, fr, fq, lds);
#undef PG8_SA
#undef PG8_SB
#undef PG8_STAGE
#undef PG8_LDA
#undef PG8_LDB
#undef PG8_MMA
#undef PG8_WAIT_V
#undef PG8_WAIT_L
#undef PG8_BAR
#undef PG8_SCHED
}
}

struct EpiIn {
    static constexpr bool AFTER_DRAIN = false;
    bf16_t *Q, *V, *OG; bf16_t* G; const float* lb;
    __device__ __forceinline__ void operator()(const f32x4 (&acc)[2][2][4][2], const pg8::Unit& u, int wr, int wc, int fr, int fq) const {
        const int type = u.pn >> 2;
        const int row0 = u.pm * 256 + wr * 64 + fr, col0 = (u.pn & 3) * 256 + wc * 32 + 8 * fq;
        if (type == 1) {
            f32x4 lbv[2][2];
#pragma unroll
            for (int bj = 0; bj < 2; ++bj) { lbv[bj][0] = *(const f32x4*)(lb + col0 + bj * 128); lbv[bj][1] = *(const f32x4*)(lb + col0 + bj * 128 + 4); }
#pragma unroll
            for (int ai = 0; ai < 2; ++ai)
#pragma unroll
                for (int m = 0; m < 4; ++m) { bf16_t* rowp = G + (size_t)(row0 + ai * 128 + m * 16) * 1024 + col0;
#pragma unroll
                    for (int bj = 0; bj < 2; ++bj) { f32x4 o0, o1; const f32x4 l0 = lbv[bj][0], l1 = lbv[bj][1];
#pragma unroll
                        for (int e = 0; e < 4; ++e) { o0[e] = ein_elem(1, acc[ai][bj][m][0][e], l0[e]); o1[e] = ein_elem(1, acc[ai][bj][m][1][e], l1[e]); }
                        u32x4 w; w.x = cvt_pk_f16(o0[0], o0[1]); w.y = cvt_pk_f16(o0[2], o0[3]); w.z = cvt_pk_f16(o1[0], o1[1]); w.w = cvt_pk_f16(o1[2], o1[3]);
                        *(u32x4*)(rowp + bj * 128) = w; }
                    asm volatile("" ::: "memory"); }
        } else {
            bf16_t* base = Q + (size_t)(type == 0 ? 0 : type - 1) * (ACT_B / 2);
            if (type == 0) store_bf16<0>(acc, base, row0, col0);
            else if (type == 2) store_bf16<2>(acc, base, row0, col0);
            else store_bf16<3>(acc, base, row0, col0);
        }
    }
    template <int TYPE> __device__ __forceinline__ void store_bf16(const f32x4 (&acc)[2][2][4][2], bf16_t* base, int row0, int col0) const {
#pragma unroll
        for (int ai = 0; ai < 2; ++ai)
#pragma unroll
            for (int m = 0; m < 4; ++m) { bf16_t* rowp = base + (size_t)(row0 + ai * 128 + m * 16) * 1024 + col0;
#pragma unroll
                for (int bj = 0; bj < 2; ++bj) { f32x4 o0, o1;
#pragma unroll
                    for (int e = 0; e < 4; ++e) { o0[e] = ein_elem(TYPE, acc[ai][bj][m][0][e], 0.f); o1[e] = ein_elem(TYPE, acc[ai][bj][m][1][e], 0.f); }
                    u32x4 w; w.x = cvt_pk_bf16(o0[0], o0[1]); w.y = cvt_pk_bf16(o0[2], o0[3]); w.z = cvt_pk_bf16(o1[0], o1[1]); w.w = cvt_pk_bf16(o1[2], o1[3]);
                    *(u32x4*)(rowp + bj * 128) = w; }
                asm volatile("" ::: "memory"); }
    }
};
template <bool IN16, bool OUT32> struct EpiRes {
    static constexpr bool AFTER_DRAIN = false;
    const float* Xin32; const bf16_t* Xin16; float* Xout32; bf16_t* Xb; const float* scale; float* part;
    __device__ __forceinline__ void operator()(const f32x4 (&acc)[2][2][4][2], const pg8::Unit& u, int wr, int wc, int fr, int fq) const {
        const int row0 = u.pm * 256 + wr * 64 + fr, col0 = u.pn * 256 + wc * 32 + 8 * fq;
        constexpr int NB = 2;
        f32x4 sc[2][2];
#pragma unroll
        for (int bj = 0; bj < 2; ++bj) { sc[bj][0] = scale ? *(const f32x4*)(scale + col0 + bj * 128) : (f32x4){1.f, 1.f, 1.f, 1.f}; sc[bj][1] = scale ? *(const f32x4*)(scale + col0 + bj * 128 + 4) : (f32x4){1.f, 1.f, 1.f, 1.f}; }
        constexpr int AIB = 2 / NB;
#pragma unroll
        for (int bt = 0; bt < NB; ++bt) {
            f32x4 xr[AIB][4][2][IN16 ? 1 : 2];
#pragma unroll
            for (int a2 = 0; a2 < AIB; ++a2)
#pragma unroll
                for (int m = 0; m < 4; ++m) { const int ai = bt * AIB + a2; const size_t off = (size_t)(row0 + ai * 128 + m * 16) * 1024 + col0;
#pragma unroll
                    for (int bj = 0; bj < 2; ++bj) {
                        if (IN16) xr[a2][m][bj][0] = __builtin_bit_cast(f32x4, *(const u32x4*)(Xin16 + off + bj * 128));
                        else { xr[a2][m][bj][0] = *(const f32x4*)(Xin32 + off + bj * 128); xr[a2][m][bj][IN16 ? 0 : 1] = *(const f32x4*)(Xin32 + off + bj * 128 + 4); } } }
#pragma unroll
            for (int a2 = 0; a2 < AIB; ++a2)
#pragma unroll
                for (int m = 0; m < 4; ++m) { const int ai = bt * AIB + a2; const int row = row0 + ai * 128 + m * 16; const size_t off = (size_t)row * 1024 + col0; float ss = 0.f;
#pragma unroll
                    for (int bj = 0; bj < 2; ++bj) {
                        const f32x4 a0 = acc[ai][bj][m][0] * sc[bj][0], a1 = acc[ai][bj][m][1] * sc[bj][1];
                        f32x4 x0, x1;
                        if (IN16) { const u32x4 w = __builtin_bit_cast(u32x4, xr[a2][m][bj][0]); x0 = (f32x4){bflo(w.x), bfhi(w.x), bflo(w.y), bfhi(w.y)}; x1 = (f32x4){bflo(w.z), bfhi(w.z), bflo(w.w), bfhi(w.w)}; }
                        else { x0 = xr[a2][m][bj][0]; x1 = xr[a2][m][bj][IN16 ? 0 : 1]; }
                        x0 = x0 + a0; x1 = x1 + a1;
                        if (OUT32) { *(f32x4*)(Xout32 + off + bj * 128) = x0; *(f32x4*)(Xout32 + off + bj * 128 + 4) = x1; }
                        if (Xb) { u32x4 w; w.x = cvt_pk_bf16(x0[0], x0[1]); w.y = cvt_pk_bf16(x0[2], x0[3]); w.z = cvt_pk_bf16(x1[0], x1[1]); w.w = cvt_pk_bf16(x1[2], x1[3]); *(u32x4*)(Xb + off + bj * 128) = w; }
                        ss += x0[0] * x0[0] + x0[1] * x0[1] + x0[2] * x0[2] + x0[3] * x0[3] + x1[0] * x1[0] + x1[1] * x1[1] + x1[2] * x1[2] + x1[3] * x1[3]; }
                    ss += __shfl_xor(ss, 16); ss += __shfl_xor(ss, 32);
                    if (fq == 0 && part) part[(size_t)row * 16 + u.pn * 4 + wc] = ss; }
            asm volatile("" ::: "memory"); }
    }
};
struct EpiFinal {
    static constexpr bool AFTER_DRAIN = true;
    const bf16_t* Xin16; float* Y; const float* gfin; float* part; unsigned* cnt;
    __device__ __forceinline__ void fused(f32x4 (&acc)[2][2][4][2], const pg8::Unit& u, int wr, int wc, int fr, int fq, LAS unsigned char* lds) const {
        const int row0 = u.pm * 256 + wr * 64 + fr, col0 = u.pn * 256 + wc * 32 + 8 * fq;
        u32x4 xr[2][4][2];
#pragma unroll
        for (int ai = 0; ai < 2; ++ai)
#pragma unroll
            for (int m = 0; m < 4; ++m) { const size_t off = (size_t)(row0 + ai * 128 + m * 16) * 1024 + col0;
#pragma unroll
                for (int bj = 0; bj < 2; ++bj) xr[ai][m][bj] = *(const u32x4*)(Xin16 + off + bj * 128); }
#pragma unroll
        for (int ai = 0; ai < 2; ++ai) {
#pragma unroll
            for (int m = 0; m < 4; ++m) { const int row = row0 + ai * 128 + m * 16; float ss = 0.f;
#pragma unroll
                for (int bj = 0; bj < 2; ++bj) { const u32x4 w = xr[ai][m][bj];
                    const f32x4 x0 = (f32x4){bflo(w.x), bfhi(w.x), bflo(w.y), bfhi(w.y)} + acc[ai][bj][m][0], x1 = (f32x4){bflo(w.z), bfhi(w.z), bflo(w.w), bfhi(w.w)} + acc[ai][bj][m][1];
                    acc[ai][bj][m][0] = x0; acc[ai][bj][m][1] = x1;
                    ss += x0[0] * x0[0] + x0[1] * x0[1] + x0[2] * x0[2] + x0[3] * x0[3] + x1[0] * x1[0] + x1[1] * x1[1] + x1[2] * x1[2] + x1[3] * x1[3]; }
                ss += __shfl_xor(ss, 16); ss += __shfl_xor(ss, 32);
                if (fq == 0) __hip_atomic_store(part + (size_t)row * 16 + u.pn * 4 + wc, ss, __ATOMIC_RELAXED, __HIP_MEMORY_SCOPE_AGENT); }
            asm volatile("" ::: "memory"); }
        asm volatile("s_waitcnt vmcnt(0)" ::: "memory");
        __syncthreads();
        if (threadIdx.x == 0) {
            __hip_atomic_fetch_add(cnt + u.pm, 1u, __ATOMIC_RELAXED, __HIP_MEMORY_SCOPE_AGENT);
            unsigned sp = 0;
            while (__hip_atomic_load(cnt + u.pm, __ATOMIC_RELAXED, __HIP_MEMORY_SCOPE_AGENT) < 4u) { __builtin_amdgcn_s_sleep(1); if (++sp > (1u << 20)) break; }
        }
        __syncthreads();
        LAS float* rsl = (LAS float*)lds;
        if (threadIdx.x < 256) { const float* pr = part + (size_t)(u.pm * 256 + threadIdx.x) * 16; float sq = 0.f;
#pragma unroll
            for (int i = 0; i < 16; ++i) sq += __hip_atomic_load(pr + i, __ATOMIC_RELAXED, __HIP_MEMORY_SCOPE_AGENT);
            rsl[threadIdx.x] = rsqrtf(sq * (1.f / 1024.f) + EPS); }
        __syncthreads();
#pragma unroll
        for (int ai = 0; ai < 2; ++ai)
#pragma unroll
            for (int m = 0; m < 4; ++m) { const int rl = ai * 128 + wr * 64 + m * 16 + fr; const float rs = rsl[rl]; float* yp = Y + (size_t)(u.pm * 256 + rl) * 1024 + col0;
#pragma unroll
                for (int bj = 0; bj < 2; ++bj) { const f32x4 g0 = *(const f32x4*)(gfin + col0 + bj * 128), g1 = *(const f32x4*)(gfin + col0 + bj * 128 + 4);
                    __builtin_nontemporal_store(acc[ai][bj][m][0] * rs * g0, (f32x4*)(yp + bj * 128)); __builtin_nontemporal_store(acc[ai][bj][m][1] * rs * g1, (f32x4*)(yp + bj * 128 + 4)); } }
        __syncthreads();
    }
};
struct EpiNull { float* sink; static constexpr bool AFTER_DRAIN = false;
    __device__ __forceinline__ void operator()(const f32x4 (&acc)[2][2][4][2], const pg8::Unit& u, int wr, int wc, int fr, int fq) const {
        f32x4 t = (f32x4){0.f, 0.f, 0.f, 0.f};
#pragma unroll
        for (int a = 0; a < 2; ++a)
#pragma unroll
            for (int b = 0; b < 2; ++b)
#pragma unroll
                for (int m = 0; m < 4; ++m)
#pragma unroll
                    for (int n = 0; n < 2; ++n) t = t + acc[a][b][m][n];
        if (t[0] + t[1] + t[2] + t[3] == 12345.678f) sink[0] = 1.f; } };
struct SNull { float* sink; __device__ __forceinline__ void rowpart(int, int, float) const {}
    __device__ __forceinline__ float operator()(int r, int c, f32x4 v) const { if (v[0] + v[1] + v[2] + v[3] == 12345.678f) sink[0] = 1.f; return 0.f; } };
struct EpiUp {
    static constexpr bool AFTER_DRAIN = false;
    bf16_t* H; const float* part;
    __device__ __forceinline__ void operator()(const f32x4 (&acc)[2][2][4][2], const pg8::Unit& u, int wr, int wc, int fr, int fq) const {
        const int row0 = u.pm * 256 + wr * 64 + fr, col0 = u.pn * 256 + wc * 32 + 8 * fq;
        f32x4 pv[2][4]; float rs[2][4];
#pragma unroll
        for (int ai = 0; ai < 2; ++ai)
#pragma unroll
            for (int m = 0; m < 4; ++m) pv[ai][m] = *(const f32x4*)(part + (size_t)(row0 + ai * 128 + m * 16) * 16 + fq * 4);
#pragma unroll
        for (int ai = 0; ai < 2; ++ai)
#pragma unroll
            for (int m = 0; m < 4; ++m) { float sq = (pv[ai][m][0] + pv[ai][m][1]) + (pv[ai][m][2] + pv[ai][m][3]); sq += __shfl_xor(sq, 16); sq += __shfl_xor(sq, 32); rs[ai][m] = rsqrtf(sq * (1.f / 1024.f) + EPS); }
#pragma unroll
        for (int ai = 0; ai < 2; ++ai)
#pragma unroll
            for (int m = 0; m < 4; ++m) { const int row = row0 + ai * 128 + m * 16; const float r = rs[ai][m]; bf16_t* rowp = H + (size_t)row * 4096 + col0;
#pragma unroll
                for (int bj = 0; bj < 2; ++bj) { f32x4 o0, o1;
#pragma unroll
                    for (int e = 0; e < 4; ++e) { float a = fmaxf(acc[ai][bj][m][0][e] * r, 0.f), b2 = fmaxf(acc[ai][bj][m][1][e] * r, 0.f); o0[e] = a * a; o1[e] = b2 * b2; }
                    u32x4 w; w.x = cvt_pk_bf16(o0[0], o0[1]); w.y = cvt_pk_bf16(o0[2], o0[3]); w.z = cvt_pk_bf16(o1[0], o1[1]); w.w = cvt_pk_bf16(o1[2], o1[3]);
                    *(u32x4*)(rowp + bj * 128) = w; } }
    }
};

template <int NCT, class F>
__device__ __forceinline__ void sample_gemm(LAS unsigned char* lds, const bf16_t* A, int lda, int agroup, const bf16_t* Bt, int K, const F& f) {
    constexpr int CT = NCT * 16;
    const int tid = threadIdx.x, wid = tid >> 6, lane = tid & 63, fr = lane & 15, fq = lane >> 4;
    LAS float* red = (LAS float*)lds;
    for (int blk = blockIdx.x; blk < 256; blk += gridDim.x) {
        const int rb = blk & 3, cb = blk >> 2, r0 = rb * 32, c0 = cb * CT;
        const int Kw = K >> 3, kb = wid * Kw;
        const bf16_t* Ab = A + (size_t)(c0 >> 8) * agroup;
        f32x4 acc[2][NCT];
#pragma unroll
        for (int i = 0; i < 2; ++i)
#pragma unroll
            for (int j = 0; j < NCT; ++j) acc[i][j] = (f32x4){0.f, 0.f, 0.f, 0.f};
        constexpr int UN = NCT == 1 ? 8 : 2;
        for (int k = kb; k < kb + Kw; k += 32 * UN) {
            bf16x8 af[UN][2], bfr[UN][NCT];
#pragma unroll
            for (int uu = 0; uu < UN; ++uu) { const int ku = k + 32 * uu; const bool ok = ku < kb + Kw;
#pragma unroll
                for (int i = 0; i < 2; ++i) af[uu][i] = ok ? *(const bf16x8*)(Ab + (size_t)(r0 + i * 16 + fr) * lda + ku + fq * 8) : (bf16x8){0, 0, 0, 0, 0, 0, 0, 0};
#pragma unroll
                for (int j = 0; j < NCT; ++j) bfr[uu][j] = ok ? *(const bf16x8*)(Bt + (size_t)(c0 + j * 16 + fr) * K + ku + fq * 8) : (bf16x8){0, 0, 0, 0, 0, 0, 0, 0}; }
#pragma unroll
            for (int uu = 0; uu < UN; ++uu)
#pragma unroll
                for (int i = 0; i < 2; ++i)
#pragma unroll
                    for (int j = 0; j < NCT; ++j) acc[i][j] = __builtin_amdgcn_mfma_f32_16x16x32_bf16(bfr[uu][j], af[uu][i], acc[i][j], 0, 0, 0);
        }
#pragma unroll
        for (int i = 0; i < 2; ++i)
#pragma unroll
            for (int j = 0; j < NCT; ++j) *(LAS f32x4*)(red + ((size_t)wid * 32 + i * 16 + fr) * CT + j * 16 + fq * 4) = acc[i][j];
        __syncthreads();
        constexpr int NG = 32 * CT / 4;
        for (int i = tid; i < NG; i += 512) { const int row = i / (CT / 4), cgp = i % (CT / 4);
            f32x4 s = (f32x4){0.f, 0.f, 0.f, 0.f};
#pragma unroll
            for (int w = 0; w < 8; ++w) s = s + *(const LAS f32x4*)(red + ((size_t)w * 32 + row) * CT + cgp * 4);
            float ss = f(r0 + row, c0 + cgp * 4, s);
#pragma unroll
            for (int o = 1; o < CT / 4; o <<= 1) ss += __shfl_xor(ss, o);
            if (cgp == 0) f.rowpart(r0 + row, cb, ss); }
        __syncthreads();
    }
}
struct SIn { bf16_t *Q, *V, *OG; bf16_t* G; const float* lb;
    __device__ __forceinline__ void rowpart(int, int, float) const {}
    __device__ __forceinline__ float operator()(int r, int c, f32x4 v) const { const int type = c >> 10, cc = c & 1023; const size_t off = (size_t)(TP + r) * 1024 + cc;
        if (type == 1) { f32x4 o;
#pragma unroll
            for (int e = 0; e < 4; ++e) o[e] = ein_elem(1, v[e], lb[cc + e]);
            u32x2 w; w.x = cvt_pk_f16(o[0], o[1]); w.y = cvt_pk_f16(o[2], o[3]); *(u32x2*)(G + off) = w; }
        else { bf16_t* base = Q + (size_t)(type == 0 ? 0 : type - 1) * (ACT_B / 2); f32x4 o;
            if (type == 0) {
#pragma unroll
                for (int e = 0; e < 4; ++e) o[e] = ein_elem(0, v[e], 0.f); }
            else if (type == 2) o = v;
            else {
#pragma unroll
                for (int e = 0; e < 4; ++e) o[e] = ein_elem(3, v[e], 0.f); }
            u32x2 w; w.x = cvt_pk_bf16(o[0], o[1]); w.y = cvt_pk_bf16(o[2], o[3]); *(u32x2*)(base + off) = w; } return 0.f; } };
struct SRes { const float* Xin; float* Xout; bf16_t* Xb; const float* scale; float* parts;
    __device__ __forceinline__ void rowpart(int r, int cb, float ss) const { if (parts) parts[r * 64 + cb] = ss; }
    __device__ __forceinline__ float operator()(int r, int c, f32x4 v) const { const size_t off = (size_t)r * 1024 + c;
        f32x4 x = *(const f32x4*)(Xin + off); if (scale) v = v * *(const f32x4*)(scale + c); x = x + v; *(f32x4*)(Xout + off) = x;
        if (Xb) { u32x2 w; w.x = cvt_pk_bf16(x[0], x[1]); w.y = cvt_pk_bf16(x[2], x[3]); *(u32x2*)(Xb + off) = w; }
        return x[0] * x[0] + x[1] * x[1] + x[2] * x[2] + x[3] * x[3]; } };
struct SUp { bf16_t* H; const float* parts;
    __device__ __forceinline__ void rowpart(int, int, float) const {}
    __device__ __forceinline__ float operator()(int r, int c, f32x4 v) const { f32x4 t = (f32x4){0.f, 0.f, 0.f, 0.f};
#pragma unroll
        for (int i = 0; i < 16; ++i) t = t + *(const f32x4*)(parts + r * 64 + i * 4);
        const float rs = rsqrtf(((t[0] + t[1]) + (t[2] + t[3])) * (1.f / 1024.f) + EPS); f32x4 o;
#pragma unroll
        for (int e = 0; e < 4; ++e) { float a = fmaxf(v[e] * rs, 0.f); o[e] = a * a; }
        u32x2 w; w.x = cvt_pk_bf16(o[0], o[1]); w.y = cvt_pk_bf16(o[2], o[3]); *(u32x2*)(H + (size_t)r * 4096 + c) = w; return 0.f; } };

struct TJob { const float* src; bf16_t* dst; const float* gain; int N, ldd, k0, n0; };
__device__ __forceinline__ bool prep_job(const Params& p, int it, TJob& j) {
    unsigned char* ws = p.ws;
    constexpr int T_IN = 1024, T_OUT = 256, T_UP = 1024, T_DN = 1024, T_P = 64;
    constexpr int NT = T_IN + T_OUT + 2 * T_UP + 2 * T_DN + T_P;
    if (it >= NT) return false;
    int r = it; j.gain = nullptr;
    if (r < T_IN) { j.src = p.hgrn_w_in; j.N = 4096; j.dst = (bf16_t*)(ws + WS_WIN); j.ldd = 1024; j.k0 = (r >> 6) * 64; j.n0 = (r & 63) * 64; return true; } r -= T_IN;
    if (r < T_OUT) { j.src = p.hgrn_w_out; j.N = 1024; j.dst = (bf16_t*)(ws + WS_WOUT); j.ldd = 1024; j.k0 = (r >> 4) * 64; j.n0 = (r & 15) * 64; return true; } r -= T_OUT;
    if (r < T_UP) { j.src = p.mlp_up; j.N = 4096; j.dst = (bf16_t*)(ws + WS_WUP0); j.ldd = 1024; j.k0 = (r >> 6) * 64; j.n0 = (r & 63) * 64; j.gain = p.mlp_norm; return true; } r -= T_UP;
    if (r < T_UP) { j.src = p.mlp_up + (size_t)1024 * 4096; j.N = 4096; j.dst = (bf16_t*)(ws + WS_WUP1); j.ldd = 1024; j.k0 = (r >> 6) * 64; j.n0 = (r & 63) * 64; j.gain = p.mlp_norm + 1024; return true; } r -= T_UP;
    if (r < T_DN) { j.src = p.mlp_down; j.N = 1024; j.dst = (bf16_t*)(ws + WS_WDN0); j.ldd = 4096; j.k0 = (r >> 4) * 64; j.n0 = (r & 15) * 64; return true; } r -= T_DN;
    if (r < T_DN) { j.src = p.mlp_down + (size_t)4096 * 1024; j.N = 1024; j.dst = (bf16_t*)(ws + WS_WDN1); j.ldd = 4096; j.k0 = (r >> 4) * 64; j.n0 = (r & 15) * 64; return true; } r -= T_DN;
    { const int g = r >> 4, rr = r & 15; j.src = p.pool_w + (size_t)g * 65536; j.N = 256; j.dst = (bf16_t*)(ws + WS_WP) + (size_t)g * 65536; j.ldd = 256; j.k0 = (rr >> 2) * 64; j.n0 = (rr & 3) * 64; }
    return true;
}
__device__ __forceinline__ void phase_prep(const Params& p, LAS unsigned char* lds) {
    LAS float* tiles = (LAS float*)lds;
    unsigned char* ws = p.ws;
    constexpr int NT = 1024 + 256 + 2 * 1024 + 2 * 1024 + 64;
    { const int tid = threadIdx.x, i = tid >> 4, j4 = (tid & 15) * 4, n = tid >> 3, k8 = (tid & 7) * 8;
#pragma unroll 1
      for (int it0 = blockIdx.x; it0 < NT; it0 += 2 * gridDim.x) {
          TJob j[2]; bool ok[2]; f32x4 v[2][2];
#pragma unroll
          for (int q = 0; q < 2; ++q) { ok[q] = prep_job(p, it0 + q * gridDim.x, j[q]);
              if (ok[q]) {
#pragma unroll
                  for (int hh = 0; hh < 2; ++hh) v[q][hh] = __builtin_nontemporal_load((const f32x4*)(j[q].src + (size_t)(j[q].k0 + i + 32 * hh) * j[q].N + j[q].n0 + j4)); } }
#pragma unroll
          for (int q = 0; q < 2; ++q) if (ok[q]) {
#pragma unroll
              for (int hh = 0; hh < 2; ++hh)
#pragma unroll
                  for (int e = 0; e < 4; ++e) tiles[q * 4160 + (j4 + e) * 65 + i + 32 * hh] = v[q][hh][e]; }
          __syncthreads();
#pragma unroll
          for (int q = 0; q < 2; ++q) if (ok[q]) { float o[8];
#pragma unroll
              for (int e = 0; e < 8; ++e) { o[e] = tiles[q * 4160 + n * 65 + k8 + e]; if (j[q].gain) o[e] *= j[q].gain[j[q].k0 + k8 + e]; }
              u32x4 w; w.x = cvt_pk_bf16(o[0], o[1]); w.y = cvt_pk_bf16(o[2], o[3]); w.z = cvt_pk_bf16(o[4], o[5]); w.w = cvt_pk_bf16(o[6], o[7]);
              *(u32x4*)(j[q].dst + (size_t)(j[q].n0 + n) * j[q].ldd + j[q].k0 + k8) = w; }
          __syncthreads();
      } }
    const int tid = threadIdx.x, wid = tid >> 6, lane = tid & 63;
    bf16_t* U = (bf16_t*)(ws + WS_R2);
    for (int row0 = blockIdx.x * 8 + wid; row0 < MP; row0 += gridDim.x * 32) {
        f32x4 v[4][4];
#pragma unroll
        for (int rr = 0; rr < 4; ++rr) { const int row = row0 + rr * gridDim.x * 8; if (row < MP) { const float* src = row < TP ? p.x_prompt + (size_t)row * 1024 : p.x_sample + (size_t)(row - TP) * 1024;
#pragma unroll
            for (int j = 0; j < 4; ++j) v[rr][j] = *(const f32x4*)(src + lane * 4 + 256 * j); } }
#pragma unroll
        for (int rr = 0; rr < 4; ++rr) { const int row = row0 + rr * gridDim.x * 8; if (row < MP) { float sacc = 0.f;
#pragma unroll
            for (int j = 0; j < 4; ++j) sacc += v[rr][j][0] * v[rr][j][0] + v[rr][j][1] * v[rr][j][1] + v[rr][j][2] * v[rr][j][2] + v[rr][j][3] * v[rr][j][3];
            const float rs = rsqrtf(wave_sum(sacc) * (1.f / 1024.f) + EPS);
#pragma unroll
            for (int j = 0; j < 4; ++j) { const f32x4 g = *(const f32x4*)(p.hgrn_norm + lane * 4 + 256 * j);
                u32x2 w; w.x = cvt_pk_bf16(v[rr][j][0] * rs * g[0], v[rr][j][1] * rs * g[1]); w.y = cvt_pk_bf16(v[rr][j][2] * rs * g[2], v[rr][j][3] * rs * g[3]);
                *(u32x2*)(U + (size_t)row * 1024 + lane * 4 + 256 * j) = w; } } }
    }
    if (blockIdx.x < 2) { const int c = blockIdx.x * 512 + tid; ((float*)(ws + WS_LB))[c] = lb_of(p.hgrn_lb, c); }
}

__device__ __forceinline__ bf16x8 lds_frag(const LAS bf16_t* p) { return *(const LAS bf16x8*)p; }
__device__ __forceinline__ void rec_prompt(const Params& p, LAS unsigned char* lds, int b, int h, int seg) {
    const int tid = threadIdx.x, wid = tid >> 6, lane = tid & 63, fr = lane & 15, fq = lane >> 4;
    LAS bf16_t* QT = (LAS bf16_t*)(lds + 0);
    LAS bf16_t* KT = (LAS bf16_t*)(lds + 17408);
    LAS bf16_t* KH = (LAS bf16_t*)(lds + 34816);
    LAS bf16_t* VT = (LAS bf16_t*)(lds + 53248);
    LAS bf16_t* SB = (LAS bf16_t*)(lds + 71680);
    LAS bf16_t* AM = (LAS bf16_t*)(lds + 106496);
    LAS float* TOT = (LAS float*)(lds + 115712);
    LAS float* DD = (LAS float*)(lds + 119808);
    LAS float* SSQ = (LAS float*)(lds + 120320);
    const unsigned char* ws = p.ws;
    const size_t gbase = (size_t)b * SEQ * 1024 + h * 128;
    const bf16_t* Qg = (const bf16_t*)(ws + WS_Q) + gbase; const bf16_t* Vg = (const bf16_t*)(ws + WS_V) + gbase; const bf16_t* OGg = (const bf16_t*)(ws + WS_OG) + gbase;
    const bf16_t* Gg = (const bf16_t*)(ws + WS_G) + gbase;
    bf16_t* Og = (bf16_t*)(p.ws + WS_R2) + gbase;
    bf16_t* QCg = (bf16_t*)(p.ws + WS_R2) + gbase;
    float* OLg = p.out + gbase;
    f32x2 Gseg = (f32x2){0.f, 0.f};
    f32x4 Sacc[8];
#pragma unroll
    for (int i = 0; i < 8; ++i) Sacc[i] = (f32x4){0.f, 0.f, 0.f, 0.f};
    const int d2 = (tid & 63) * 2, part = tid >> 6;
    unsigned gr[8], qr[8], vr[8];
#define REC_LOAD(c) do { const unsigned o_ = (unsigned)(((c) * 64 + part * 8) * 1024 + d2); \
        _Pragma("unroll") for (int i = 0; i < 8; ++i) { gr[i] = *(const unsigned*)(Gg + o_ + (unsigned)i * 1024u); qr[i] = *(const unsigned*)(Qg + o_ + (unsigned)i * 1024u); vr[i] = *(const unsigned*)(Vg + o_ + (unsigned)i * 1024u); } } while (0)
    REC_LOAD(seg * 8);
    const int tb = wid & 3, vh = wid >> 2;
    for (int cc = 0; cc < 8; ++cc) {
        const int c = seg * 8 + cc;
#pragma unroll
        for (int vb = 0; vb < 8; ++vb) { u32x2 w; w.x = cvt_pk_bf16(Sacc[vb][0], Sacc[vb][1]); w.y = cvt_pk_bf16(Sacc[vb][2], Sacc[vb][3]);
            *(LAS u32x2*)(SB + (vb * 16 + fr) * 136 + wid * 16 + fq * 4) = w; }
        f32x2 cs[8];
        { f32x2 run = (f32x2){0.f, 0.f};
#pragma unroll
          for (int i = 0; i < 8; ++i) { run = run + h2_to_f2(gr[i]); cs[i] = run; }
          *(LAS f32x2*)(TOT + part * 128 + d2) = run; }
        __syncthreads();
        { f32x2 off = (f32x2){0.f, 0.f}, Gl = (f32x2){0.f, 0.f};
#pragma unroll
          for (int pp = 0; pp < 8; ++pp) { const f32x2 tv = *(const LAS f32x2*)(TOT + pp * 128 + d2); Gl = Gl + tv; if (pp < part) off = off + tv; }
          const float eGl0 = __expf(Gl[0]), eGl1 = __expf(Gl[1]), eGs0 = __expf(Gseg[0]), eGs1 = __expf(Gseg[1]);
          float kh0[8], kh1[8];
#pragma unroll
          for (int i = 0; i < 8; ++i) { const int t = part * 8 + i; const f32x2 G = off + cs[i];
              const float e0 = __expf(G[0]), e1 = __expf(G[1]), ei0 = __builtin_amdgcn_rcpf(e0), ei1 = __builtin_amdgcn_rcpf(e1);
              const f32x2 gv = h2_to_f2(gr[i]); const float k0 = 1.f - __expf(gv[0]), k1 = 1.f - __expf(gv[1]);
              const float q0 = bflo(qr[i]) * e0, q1 = bfhi(qr[i]) * e1;
              *(LAS unsigned*)(QT + t * 136 + d2) = cvt_pk_bf16(q0, q1); *(LAS unsigned*)(KT + t * 136 + d2) = cvt_pk_bf16(k0 * ei0, k1 * ei1);
              kh0[i] = k0 * eGl0 * ei0; kh1[i] = k1 * eGl1 * ei1;
              if (seg > 0) *(unsigned*)(QCg + (unsigned)((c * 64 + t) * 1024 + d2)) = cvt_pk_bf16(q0 * eGs0, q1 * eGs1); }
          Gseg = Gseg + Gl;
          u32x4 w0, w1; w0.x = cvt_pk_bf16(kh0[0], kh0[1]); w0.y = cvt_pk_bf16(kh0[2], kh0[3]); w0.z = cvt_pk_bf16(kh0[4], kh0[5]); w0.w = cvt_pk_bf16(kh0[6], kh0[7]);
          w1.x = cvt_pk_bf16(kh1[0], kh1[1]); w1.y = cvt_pk_bf16(kh1[2], kh1[3]); w1.z = cvt_pk_bf16(kh1[4], kh1[5]); w1.w = cvt_pk_bf16(kh1[6], kh1[7]);
          *(LAS u32x4*)(KH + d2 * 72 + part * 8) = w0; *(LAS u32x4*)(KH + (d2 + 1) * 72 + part * 8) = w1;
          u32x4 v0, v1;
          v0.x = (vr[0] & 0xffffu) | (vr[1] << 16); v0.y = (vr[2] & 0xffffu) | (vr[3] << 16); v0.z = (vr[4] & 0xffffu) | (vr[5] << 16); v0.w = (vr[6] & 0xffffu) | (vr[7] << 16);
          v1.x = (vr[0] >> 16) | (vr[1] & 0xffff0000u); v1.y = (vr[2] >> 16) | (vr[3] & 0xffff0000u); v1.z = (vr[4] >> 16) | (vr[5] & 0xffff0000u); v1.w = (vr[6] >> 16) | (vr[7] & 0xffff0000u);
          *(LAS u32x4*)(VT + d2 * 72 + part * 8) = v0; *(LAS u32x4*)(VT + (d2 + 1) * 72 + part * 8) = v1;
          if (part == 0) *(LAS f32x2*)(DD + d2) = (f32x2){eGl0, eGl1}; }
        if (cc + 1 < 8) REC_LOAD(c + 1);
        __syncthreads();
        { const int sb = wid >> 1;
#pragma unroll
          for (int ti = 0; ti < 2; ++ti) { const int tbb = (wid & 1) * 2 + ti; f32x4 a = (f32x4){0.f, 0.f, 0.f, 0.f};
              if (sb <= tbb) {
#pragma unroll
                  for (int kk = 0; kk < 4; ++kk) a = __builtin_amdgcn_mfma_f32_16x16x32_bf16(lds_frag(KT + (sb * 16 + fr) * 136 + kk * 32 + fq * 8), lds_frag(QT + (tbb * 16 + fr) * 136 + kk * 32 + fq * 8), a, 0, 0, 0);
                  const int t = tbb * 16 + fr, s0 = sb * 16 + fq * 4;
#pragma unroll
                  for (int j = 0; j < 4; ++j) if (s0 + j > t) a[j] = 0.f; }
              u32x2 w; w.x = cvt_pk_bf16(a[0], a[1]); w.y = cvt_pk_bf16(a[2], a[3]);
              *(LAS u32x2*)(AM + (tbb * 16 + fr) * 72 + sb * 16 + fq * 4) = w; } }
        { const f32x4 dd = *(const LAS f32x4*)(DD + wid * 16 + fq * 4);
          const bf16x8 a0 = lds_frag(KH + (wid * 16 + fr) * 72 + fq * 8), a1 = lds_frag(KH + (wid * 16 + fr) * 72 + 32 + fq * 8);
#pragma unroll
          for (int vb = 0; vb < 8; ++vb) { f32x4 a = Sacc[vb] * dd;
              a = __builtin_amdgcn_mfma_f32_16x16x32_bf16(a0, lds_frag(VT + (vb * 16 + fr) * 72 + fq * 8), a, 0, 0, 0);
              a = __builtin_amdgcn_mfma_f32_16x16x32_bf16(a1, lds_frag(VT + (vb * 16 + fr) * 72 + 32 + fq * 8), a, 0, 0, 0);
              Sacc[vb] = a; } }
        __syncthreads();
        f32x4 oacc[4]; u32x2 ogv[4];
        const size_t tok = (size_t)c * 64 + tb * 16 + fr;
        if (seg == 0) {
#pragma unroll
        for (int vi = 0; vi < 4; ++vi) ogv[vi] = *(const u32x2*)(OGg + tok * 1024 + (vh * 4 + vi) * 16 + fq * 4); }
        { bf16x8 qf[4], af[2];
#pragma unroll
          for (int kk = 0; kk < 4; ++kk) qf[kk] = lds_frag(QT + (tb * 16 + fr) * 136 + kk * 32 + fq * 8);
#pragma unroll
          for (int kk = 0; kk < 2; ++kk) af[kk] = lds_frag(AM + (tb * 16 + fr) * 72 + kk * 32 + fq * 8);
#pragma unroll
          for (int vi = 0; vi < 4; ++vi) { const int vb = vh * 4 + vi; f32x4 a = (f32x4){0.f, 0.f, 0.f, 0.f};
#pragma unroll
              for (int kk = 0; kk < 4; ++kk) a = __builtin_amdgcn_mfma_f32_16x16x32_bf16(lds_frag(SB + (vb * 16 + fr) * 136 + kk * 32 + fq * 8), qf[kk], a, 0, 0, 0);
#pragma unroll
              for (int kk = 0; kk < 2; ++kk) a = __builtin_amdgcn_mfma_f32_16x16x32_bf16(lds_frag(VT + (vb * 16 + fr) * 72 + kk * 32 + fq * 8), af[kk], a, 0, 0, 0);
              oacc[vi] = a; } }
        if (seg == 0) {
        { float ss = 0.f;
#pragma unroll
          for (int vi = 0; vi < 4; ++vi) ss += oacc[vi][0] * oacc[vi][0] + oacc[vi][1] * oacc[vi][1] + oacc[vi][2] * oacc[vi][2] + oacc[vi][3] * oacc[vi][3];
          ss += __shfl_xor(ss, 16); ss += __shfl_xor(ss, 32);
          if (fq == 0) SSQ[vh * 64 + tb * 16 + fr] = ss; }
        __syncthreads();
        { const float tot = SSQ[tb * 16 + fr] + SSQ[64 + tb * 16 + fr]; const float rs = rsqrtf(tot * (1.f / 128.f) + EPS);
#pragma unroll
          for (int vi = 0; vi < 4; ++vi) { const f32x4 o = oacc[vi] * rs * *(const f32x4*)(p.hgrn_onorm + h * 128 + (vh * 4 + vi) * 16 + fq * 4);
              u32x2 w; w.x = cvt_pk_bf16(o[0] * bflo(ogv[vi].x), o[1] * bfhi(ogv[vi].x)); w.y = cvt_pk_bf16(o[2] * bflo(ogv[vi].y), o[3] * bfhi(ogv[vi].y));
              *(u32x2*)(Og + tok * 1024 + (vh * 4 + vi) * 16 + fq * 4) = w; } }
        } else {
#pragma unroll
          for (int vi = 0; vi < 4; ++vi) *(f32x4*)(OLg + tok * 1024 + (vh * 4 + vi) * 16 + fq * 4) = oacc[vi];
          __syncthreads();
        }
    }
#undef REC_LOAD
    float* So = seg == 3 ? p.out + O_HP + (size_t)(b * 8 + h) * 16384 : (float*)(p.ws + WS_LSEG) + ((size_t)(b * 8 + h) * 3 + seg) * 16384;
    if (part == 0) *(f32x2*)((float*)(p.ws + WS_DSEG) + ((size_t)(b * 8 + h) * 4 + seg) * 128 + d2) = (f32x2){__expf(Gseg[0]), __expf(Gseg[1])};
#pragma unroll
    for (int vb = 0; vb < 8; ++vb)
#pragma unroll
        for (int j = 0; j < 4; ++j) So[(size_t)(wid * 16 + fq * 4 + j) * 128 + vb * 16 + fr] = Sacc[vb][j];
    __syncthreads();
}
__device__ __forceinline__ void rec_sample(const Params& p, LAS unsigned char* lds, int item) {
    const int tid = threadIdx.x, b = item >> 3, h = item & 7;
    LAS float* qs = (LAS float*)lds; LAS float* fs = qs + 128; LAS float* ks = qs + 256; LAS float* vs = qs + 384; LAS float* red = qs + 512;
    LAS float* sq = qs + 512 + 2048;
    const unsigned char* ws = p.ws;
    const size_t roff = (size_t)(TP + b) * 1024 + h * 128;
    if (tid < 128) { qs[tid] = bf2f(((const bf16_t*)(ws + WS_Q))[roff + tid]); const float f = __expf((float)((const _Float16*)(ws + WS_G))[roff + tid]); fs[tid] = f; ks[tid] = 1.f - f;
        vs[tid] = bf2f(((const bf16_t*)(ws + WS_V))[roff + tid]); }
    __syncthreads();
    const int v4 = (tid & 31) * 4, dg = tid >> 5;
    const float* Sin = p.state_hgrn + (size_t)item * 16384; float* Sout = p.out + O_HS + (size_t)item * 16384;
    const f32x4 vv = *(const LAS f32x4*)(vs + v4);
    f32x4 o = (f32x4){0.f, 0.f, 0.f, 0.f};
    f32x4 sv[8];
#pragma unroll
    for (int i = 0; i < 8; ++i) sv[i] = *(const f32x4*)(Sin + (size_t)(dg * 8 + i) * 128 + v4);
#pragma unroll
    for (int i = 0; i < 8; ++i) { const int dd = dg * 8 + i; const f32x4 sn = sv[i] * fs[dd] + vv * ks[dd]; *(f32x4*)(Sout + (size_t)dd * 128 + v4) = sn; o = o + sn * qs[dd]; }
    *(LAS f32x4*)(red + dg * 128 + v4) = o;
    __syncthreads();
    float ov = 0.f;
    if (tid < 128) {
#pragma unroll
        for (int i = 0; i < 16; ++i) ov += red[i * 128 + tid];
        const float s = wave_sum(ov * ov); if ((tid & 63) == 0) sq[tid >> 6] = s; }
    __syncthreads();
    if (tid < 128) { const float rs = rsqrtf((sq[0] + sq[1]) * (1.f / 128.f) + EPS);
        const float og = bf2f(((const bf16_t*)(ws + WS_OG))[roff + tid]);
        ((bf16_t*)(p.ws + WS_R2))[roff + tid] = f2bf(ov * rs * p.hgrn_onorm[h * 128 + tid] * og); }
    __syncthreads();
}

__device__ __forceinline__ void rec_sample_list(const Params& p, LAS unsigned char* lds, int first, int stride, int count, size_t obase = WS_R2) {
    const int tid = threadIdx.x;
    LAS float* qs = (LAS float*)lds; LAS float* fs = qs + 128; LAS float* ks = qs + 256; LAS float* vs = qs + 384; LAS float* red = qs + 512;
    LAS float* sq = qs + 512 + 2048;
    const unsigned char* ws = p.ws;
    const int v4 = (tid & 31) * 4, dg = tid >> 5;
    f32x4 svA[8], svB[8]; float lqA = 0.f, lgA = 0.f, lvA = 0.f, loA = 0.f, lqB = 0.f, lgB = 0.f, lvB = 0.f, loB = 0.f;
#define RS_ISSUE(item_, sv, lq, lg, lv, lo) do { const int it_ = (item_); const size_t ro_ = (size_t)(TP + (it_ >> 3)) * 1024 + (it_ & 7) * 128; \
        if (tid < 128) { lq = bf2f(((const bf16_t*)(ws + WS_Q))[ro_ + tid]); lg = (float)((const _Float16*)(ws + WS_G))[ro_ + tid]; lv = bf2f(((const bf16_t*)(ws + WS_V))[ro_ + tid]); lo = bf2f(((const bf16_t*)(ws + WS_OG))[ro_ + tid]); } \
        const float* Sin_ = p.state_hgrn + (size_t)it_ * 16384; \
        _Pragma("unroll") for (int i = 0; i < 8; ++i) sv[i] = __builtin_nontemporal_load((const f32x4*)(Sin_ + (size_t)(dg * 8 + i) * 128 + v4)); } while (0)
#define RS_ITEM(j_, sv, lq, lg, lv, lo) do { \
        const int item = first + (j_) * stride, b = item >> 3, h = item & 7; \
        const size_t roff = (size_t)(TP + b) * 1024 + h * 128; \
        const float og = lo; \
        if (tid < 128) { const float f = __expf(lg); qs[tid] = lq; fs[tid] = f; ks[tid] = 1.f - f; vs[tid] = lv; } \
        __syncthreads(); \
        float* Sout = p.out + O_HS + (size_t)item * 16384; \
        const f32x4 vv = *(const LAS f32x4*)(vs + v4); \
        f32x4 o = (f32x4){0.f, 0.f, 0.f, 0.f}; \
        _Pragma("unroll") for (int i = 0; i < 8; ++i) { const int dd = dg * 8 + i; const f32x4 sn = sv[i] * fs[dd] + vv * ks[dd]; __builtin_nontemporal_store(sn, (f32x4*)(Sout + (size_t)dd * 128 + v4)); o = o + sn * qs[dd]; } \
        if ((j_) + 2 < count) RS_ISSUE(first + ((j_) + 2) * stride, sv, lq, lg, lv, lo); \
        *(LAS f32x4*)(red + dg * 128 + v4) = o; \
        __syncthreads(); \
        float ov = 0.f; \
        if (tid < 128) { \
            _Pragma("unroll") for (int i = 0; i < 16; ++i) ov += red[i * 128 + tid]; \
            const float s2 = wave_sum(ov * ov); if ((tid & 63) == 0) sq[tid >> 6] = s2; } \
        __syncthreads(); \
        if (tid < 128) { const float rs = rsqrtf((sq[0] + sq[1]) * (1.f / 128.f) + EPS); \
            ((bf16_t*)(p.ws + obase))[roff + tid] = f2bf(ov * rs * p.hgrn_onorm[h * 128 + tid] * og); } \
        __syncthreads(); } while (0)
    if (count > 0) RS_ISSUE(first, svA, lqA, lgA, lvA, loA);
    if (count > 1) RS_ISSUE(first + stride, svB, lqB, lgB, lvB, loB);
    for (int j = 0; j < count; j += 2) {
        RS_ITEM(j, svA, lqA, lgA, lvA, loA);
        if (j + 1 < count) RS_ITEM(j + 1, svB, lqB, lgB, lvB, loB);
    }
#undef RS_ITEM
#undef RS_ISSUE
}
__device__ __forceinline__ void rec_fix(const Params& p, LAS unsigned char* lds, int b, int h, int seg) {
    const int tid = threadIdx.x, wid = tid >> 6, lane = tid & 63, fr = lane & 15, fq = lane >> 4;
    LAS bf16_t* QT = (LAS bf16_t*)(lds + 0);
    LAS bf16_t* SB = (LAS bf16_t*)(lds + 71680);
    LAS float* SSQ = (LAS float*)(lds + 118272);
    const unsigned char* ws = p.ws;
    const int bh = b * 8 + h;
    const size_t gbase = (size_t)b * SEQ * 1024 + h * 128;
    const bf16_t* OGg = (const bf16_t*)(ws + WS_OG) + gbase; const bf16_t* QCg = (const bf16_t*)(ws + WS_R2) + gbase;
    const float* OLg = p.out + gbase; bf16_t* Og = (bf16_t*)(p.ws + WS_R2) + gbase;
    const float* Ls = (const float*)(ws + WS_LSEG) + (size_t)bh * 3 * 16384; const float* Ds = (const float*)(ws + WS_DSEG) + (size_t)bh * 4 * 128;
    { f32x4 S[8];
#pragma unroll
      for (int i = 0; i < 8; ++i) S[i] = (f32x4){0.f, 0.f, 0.f, 0.f};
      f32x4 Lr[3][8]; float Dr[3][8];
#pragma unroll
      for (int sp = 0; sp < 3; ++sp)
#pragma unroll
          for (int i = 0; i < 8; ++i) { const int e4 = (tid + 512 * i) * 4, dd = e4 >> 7;
              if (sp < seg) { Lr[sp][i] = *(const f32x4*)(Ls + (size_t)sp * 16384 + e4); Dr[sp][i] = Ds[sp * 128 + dd]; } else { Lr[sp][i] = (f32x4){0.f, 0.f, 0.f, 0.f}; Dr[sp][i] = 1.f; } }
#pragma unroll
      for (int sp = 0; sp < 3; ++sp)
#pragma unroll
          for (int i = 0; i < 8; ++i) S[i] = S[i] * Dr[sp][i] + Lr[sp][i];
#pragma unroll
      for (int i = 0; i < 8; ++i) { const int e4 = (tid + 512 * i) * 4, dd = e4 >> 7, v0 = e4 & 127;
#pragma unroll
          for (int j = 0; j < 4; ++j) SB[(v0 + j) * 136 + dd] = f2bf(S[i][j]);
          if (seg == 3) { float* So = p.out + O_HP + (size_t)bh * 16384 + e4; *(f32x4*)So = S[i] * Ds[3 * 128 + dd] + *(const f32x4*)So; } } }
    const int qrow0 = tid >> 4, qc8 = (tid & 15) * 8;
    const int tb = wid & 3, vh = wid >> 2;
    const f32x4 onv[4] = { *(const f32x4*)(p.hgrn_onorm + h * 128 + (vh * 4 + 0) * 16 + fq * 4), *(const f32x4*)(p.hgrn_onorm + h * 128 + (vh * 4 + 1) * 16 + fq * 4),
                           *(const f32x4*)(p.hgrn_onorm + h * 128 + (vh * 4 + 2) * 16 + fq * 4), *(const f32x4*)(p.hgrn_onorm + h * 128 + (vh * 4 + 3) * 16 + fq * 4) };
    u32x4 nq[2];
#pragma unroll
    for (int i = 0; i < 2; ++i) nq[i] = *(const u32x4*)(QCg + ((size_t)seg * 512 + qrow0 + 32 * i) * 1024 + qc8);
    f32x4 nol[4]; u32x2 nog[4];
    { const size_t tokf = (size_t)seg * 512 + tb * 16 + fr;
#pragma unroll
      for (int vi = 0; vi < 4; ++vi) { nol[vi] = *(const f32x4*)(OLg + tokf * 1024 + (vh * 4 + vi) * 16 + fq * 4); nog[vi] = *(const u32x2*)(OGg + tokf * 1024 + (vh * 4 + vi) * 16 + fq * 4); } }
    for (int cc = 0; cc < 8; ++cc) {
        const size_t t0 = (size_t)seg * 512 + cc * 64;
#pragma unroll
        for (int i = 0; i < 2; ++i) *(LAS u32x4*)(QT + (qrow0 + 32 * i) * 136 + qc8) = nq[i];
        __syncthreads();
        if (cc + 1 < 8) {
#pragma unroll
            for (int i = 0; i < 2; ++i) nq[i] = *(const u32x4*)(QCg + (t0 + 64 + qrow0 + 32 * i) * 1024 + qc8); }
        const size_t tok = t0 + tb * 16 + fr;
        f32x4 oacc[4]; u32x2 ogv[4];
#pragma unroll
        for (int vi = 0; vi < 4; ++vi) { oacc[vi] = nol[vi]; ogv[vi] = nog[vi]; }
        if (cc + 1 < 8) {
#pragma unroll
            for (int vi = 0; vi < 4; ++vi) { nol[vi] = *(const f32x4*)(OLg + (tok + 64) * 1024 + (vh * 4 + vi) * 16 + fq * 4); nog[vi] = *(const u32x2*)(OGg + (tok + 64) * 1024 + (vh * 4 + vi) * 16 + fq * 4); } }
        { bf16x8 qf[4];
#pragma unroll
          for (int kk = 0; kk < 4; ++kk) qf[kk] = lds_frag(QT + (tb * 16 + fr) * 136 + kk * 32 + fq * 8);
#pragma unroll
          for (int vi = 0; vi < 4; ++vi) { const int vb = vh * 4 + vi; f32x4 a = oacc[vi];
#pragma unroll
              for (int kk = 0; kk < 4; ++kk) a = __builtin_amdgcn_mfma_f32_16x16x32_bf16(lds_frag(SB + (vb * 16 + fr) * 136 + kk * 32 + fq * 8), qf[kk], a, 0, 0, 0);
              oacc[vi] = a; } }
        { float ss = 0.f;
#pragma unroll
          for (int vi = 0; vi < 4; ++vi) ss += oacc[vi][0] * oacc[vi][0] + oacc[vi][1] * oacc[vi][1] + oacc[vi][2] * oacc[vi][2] + oacc[vi][3] * oacc[vi][3];
          ss += __shfl_xor(ss, 16); ss += __shfl_xor(ss, 32);
          if (fq == 0) SSQ[vh * 64 + tb * 16 + fr] = ss; }
        __syncthreads();
        { const float tot = SSQ[tb * 16 + fr] + SSQ[64 + tb * 16 + fr]; const float rs = rsqrtf(tot * (1.f / 128.f) + EPS);
#pragma unroll
          for (int vi = 0; vi < 4; ++vi) { const f32x4 o = oacc[vi] * rs * onv[vi];
              u32x2 w; w.x = cvt_pk_bf16(o[0] * bflo(ogv[vi].x), o[1] * bfhi(ogv[vi].x)); w.y = cvt_pk_bf16(o[2] * bflo(ogv[vi].y), o[3] * bfhi(ogv[vi].y));
              *(u32x2*)(Og + tok * 1024 + (vh * 4 + vi) * 16 + fq * 4) = w; } }
    }
    __syncthreads();
}

__device__ __forceinline__ float* part_slot(unsigned char* ws, int k) { return (float*)(ws + WS_PART + (size_t)k * PART_SLOT); }
__device__ __forceinline__ float row_ssq16(const float* slot, size_t row) {
    const f32x4* pp = (const f32x4*)(slot + row * 16); const f32x4 t = (pp[0] + pp[1]) + (pp[2] + pp[3]); return (t[0] + t[1]) + (t[2] + t[3]); }
__device__ __forceinline__ float row_ssq64(const float* slot, int r) {
    const f32x4* pp = (const f32x4*)(slot + (size_t)TP * 16 + (size_t)r * 64); f32x4 t = pp[0];
#pragma unroll
    for (int i = 1; i < 16; ++i) t = t + pp[i];
    return (t[0] + t[1]) + (t[2] + t[3]); }
__device__ __forceinline__ void phase_pool(const Params& p, LAS unsigned char* lds) {
    const int tid = threadIdx.x, c = tid * 2, gi = c >> 8, w = 2 << gi;
    LAS f32x2* ring = (LAS f32x2*)lds;
    const float* slot = part_slot(p.ws, 1);
    bf16_t* Z = (bf16_t*)(p.ws + WS_R2);
    const bf16_t* XBs = (const bf16_t*)(p.ws + WS_XB);
    const f32x2 gp = *(const f32x2*)(p.pool_norm + c);
    for (int unit = blockIdx.x; unit < 256; unit += gridDim.x) {
        const int b = unit >> 5, t0 = (unit & 31) * 64;
#pragma unroll
        for (int i = 0; i < 16; ++i) ring[i * 512 + tid] = (f32x2){0.f, 0.f};
        f32x2 sum = (f32x2){0.f, 0.f};
        LAS float* rsl = (LAS float*)(lds + 65536);
        __syncthreads();
        if (tid < 80) { const int t = t0 - 16 + tid; rsl[tid] = t >= 0 ? rsqrtf(row_ssq16(slot, (size_t)b * SEQ + t) * (1.f / 1024.f) + EPS) : 0.f; }
        __syncthreads();
        for (int tt = -16; tt < 64; tt += 16) {
            unsigned xw[16];
#pragma unroll
            for (int i = 0; i < 16; ++i) { const int t = t0 + tt + i; xw[i] = t >= 0 ? *(const unsigned*)(XBs + ((size_t)b * SEQ + t) * 1024 + c) : 0u; }
#pragma unroll
            for (int i = 0; i < 16; ++i) { const int t = t0 + tt + i; const float rs = rsl[tt + 16 + i];
                const f32x2 u = (f32x2){bflo(xw[i]), bfhi(xw[i])} * rs * gp;
                const f32x2 old = ring[((t - w) & 15) * 512 + tid];
                ring[(t & 15) * 512 + tid] = u; sum = sum + u - old;
                if (tt + i >= 0) { const float cnt = (float)min(w, t + 1); const f32x2 z = sum / cnt - u; const size_t row = (size_t)b * SEQ + t;
                    *(unsigned*)(Z + row * 1024 + c) = cvt_pk_bf16(z[0], z[1]);
                    if (t >= SEQ - 15) *(f32x2*)(p.out + O_PP + ((size_t)b * 15 + (t - (SEQ - 15))) * 1024 + c) = u; } }
        }
    }
    for (int sb = blockIdx.x; sb < TS; sb += gridDim.x) {
        const size_t row = (size_t)TP + sb;
        const float rs = rsqrtf(row_ssq64(slot, sb) * (1.f / 1024.f) + EPS);
        const f32x2 u = *(const f32x2*)(p.out + row * 1024 + c) * rs * gp;
        const float* hist = p.state_pool + (size_t)sb * 15 * 1024 + c;
        float* ho = p.out + O_PS + (size_t)sb * 15 * 1024 + c;
        f32x2 sum = u;
#pragma unroll
        for (int j = 0; j < 15; ++j) { const f32x2 hv = *(const f32x2*)(hist + (size_t)j * 1024); if (j >= 16 - w) sum = sum + hv; if (j >= 1) *(f32x2*)(ho + (size_t)(j - 1) * 1024) = hv; }
        *(f32x2*)(ho + (size_t)14 * 1024) = u;
        const f32x2 z = sum / (float)w - u;
        *(unsigned*)(Z + row * 1024 + c) = cvt_pk_bf16(z[0], z[1]);
    }
}

__device__ __forceinline__ void phase_final(const Params& p) {
    const int tid = threadIdx.x, wid = tid >> 6, lane = tid & 63;
    const float* slot = part_slot(p.ws, 3);
    const int r = blockIdx.x * 8 + wid;
    if (r < TS) {
        float* xr = p.out + O_YS + (size_t)r * 1024;
        const float rs = rsqrtf(wave_sum(slot[(size_t)TP * 16 + (size_t)r * 64 + lane]) * (1.f / 1024.f) + EPS);
#pragma unroll
        for (int j = 0; j < 4; ++j) { const f32x4 v = *(const f32x4*)(xr + lane * 4 + 256 * j); const f32x4 g = *(const f32x4*)(p.final_norm + lane * 4 + 256 * j); *(f32x4*)(xr + lane * 4 + 256 * j) = v * rs * g; }
    }
}

#define XB_TMO      128
#define XB_XCNT(j)  (256  + 64 * (j))
#define XB_XSUB(j)  (1280 + 64 * (j))
#define XB_XGEN(j)  (2304 + 64 * (j))
#define XB_TOP      3328
#define XB_TOPGEN   3392
#define XCD_BAR_WORDS 3456
#define XB_SPIN_CAP (1u << 18)
__device__ __forceinline__ unsigned xb_ld(unsigned* p)              { return __hip_atomic_load(p, __ATOMIC_RELAXED, __HIP_MEMORY_SCOPE_AGENT); }
__device__ __forceinline__ unsigned xb_add(unsigned* p, unsigned v) { return __hip_atomic_fetch_add(p, v, __ATOMIC_RELAXED, __HIP_MEMORY_SCOPE_AGENT); }
__device__ __forceinline__ unsigned xb_xcc_id() { return (unsigned)__builtin_amdgcn_s_getreg((3 << 11) | 20) & 0xFu; }
#define XB_SPIN(cond, bar) do { unsigned _sp = 0; while (cond) { __builtin_amdgcn_s_sleep(1); \
    if ((++_sp & 255u) == 0u) { if (xb_ld(&(bar)[XB_TMO])) break; if (_sp > XB_SPIN_CAP) { atomicAdd(&(bar)[XB_TMO], 1u); break; } } } } while (0)
struct XcdBarrier { unsigned* bar; unsigned x; volatile LAS unsigned* st; };
__device__ __forceinline__ XcdBarrier xcd_barrier_post(unsigned* bar, volatile LAS unsigned* st) {
    XcdBarrier b; b.bar = bar; b.x = xb_xcc_id(); b.st = st;
    if (threadIdx.x == 0) (void)xb_add(&bar[XB_XCNT(b.x)], 1u);
    return b;
}
__device__ __forceinline__ void xcd_barrier_complete(unsigned* bar, unsigned x, unsigned& nloc, unsigned& nx) {
    const unsigned G = gridDim.x * gridDim.y * gridDim.z;
    unsigned sum, cnt, mine, sp = 0u;
    for (;;) {
        sum = 0u; cnt = 0u; mine = 0u;
#pragma unroll
        for (unsigned j = 0; j < 16; ++j) { const unsigned c = xb_ld(&bar[XB_XCNT(j)]); sum += c; cnt += (c > 0u) ? 1u : 0u; mine = (j == x) ? c : mine; }
        if (sum == G) break;
        __builtin_amdgcn_s_sleep(1);
        if ((++sp & 255u) == 0u) { if (xb_ld(&bar[XB_TMO])) break; if (sp > XB_SPIN_CAP) { atomicAdd(&bar[XB_TMO], 1u); break; } }
    }
    nloc = mine > 0u ? mine : 1u; nx = cnt > 0u ? cnt : 1u;
}
__device__ __forceinline__ void xcd_barrier(const XcdBarrier& b) {
    asm volatile("s_waitcnt vmcnt(0)" ::: "memory");
    __syncthreads();
    if (threadIdx.x == 0) {
        unsigned* bar = b.bar;
        __builtin_amdgcn_s_waitcnt(0);
        unsigned nloc = b.st[0], nx = b.st[1];
        if (nloc == 0u) { xcd_barrier_complete(bar, b.x, nloc, nx); b.st[0] = nloc; b.st[1] = nx; }
        const unsigned old = xb_add(&bar[XB_XSUB(b.x)], 1u);
        const unsigned gen = old / nloc;
        if (old + 1u == (gen + 1u) * nloc) {
            __builtin_amdgcn_fence(__ATOMIC_RELEASE, "agent");
            asm volatile("s_waitcnt vmcnt(0)" ::: "memory");
            const unsigned og = xb_add(&bar[XB_TOP], 1u);
            const unsigned tg = og / nx;
            if (og + 1u == (tg + 1u) * nx) xb_add(&bar[XB_TOPGEN], 1u);
            else XB_SPIN(xb_ld(&bar[XB_TOPGEN]) == tg, bar);
            __builtin_amdgcn_fence(__ATOMIC_ACQUIRE, "agent");
            xb_add(&bar[XB_XGEN(b.x)], 1u);
            asm volatile("s_waitcnt vmcnt(0)" ::: "memory");
        } else {
            XB_SPIN(xb_ld(&bar[XB_XGEN(b.x)]) == gen, bar);
            __builtin_amdgcn_fence(__ATOMIC_ACQUIRE, "agent");
            asm volatile("s_waitcnt vmcnt(0)" ::: "memory");
        }
    }
    __syncthreads();
}
#define PH_ON(n) ((PHMASK & (1 << (n))) && p.ph_lo <= (n) && (n) < p.ph_hi)
#define PH_SYNC(n) do { if (p.ph_lo < (n) && (n) < p.ph_hi) { xcd_barrier(xb); } } while (0)
__device__ __forceinline__ void ph_in(const Params& p, LAS unsigned char* lds) {
    unsigned char* ws = p.ws; pg8::StaticOrder S;
    EpiIn E{(bf16_t*)(ws + WS_Q), (bf16_t*)(ws + WS_V), (bf16_t*)(ws + WS_OG), (bf16_t*)(ws + WS_G), (const float*)(ws + WS_LB)};
    pg8::Gemm g{(const bf16_t*)(ws + WS_R2), (const bf16_t*)(ws + WS_WIN), TP, 4096, 1024, 1024, 0};
    S.init(g.M, g.N, gridDim.x, blockIdx.x); pg8::gemm_phase(lds, g, S, E);
    SIn F{E.Q, E.V, E.OG, E.G, (const float*)(ws + WS_LB)};
    sample_gemm<4>(lds, (const bf16_t*)(ws + WS_R2) + (size_t)TP * 1024, 1024, 0, (const bf16_t*)(ws + WS_WIN), 1024, F);
}
__device__ __forceinline__ void ph_rec1(const Params& p, LAS unsigned char* lds) {
    for (int it = blockIdx.x; it < 256; it += gridDim.x) { const int seg = it & 3, bh = it >> 2; rec_prompt(p, lds, bh >> 3, bh & 7, seg); }
}
__device__ __forceinline__ void ph_rec2(const Params& p, LAS unsigned char* lds) {
    for (int it = blockIdx.x; it < 256; it += gridDim.x) { const int seg = it & 3, bh = it >> 2; if (seg > 0) rec_fix(p, lds, bh >> 3, bh & 7, seg); }
    if (gridDim.x == 256) {
        const int seg = blockIdx.x & 3, bh = blockIdx.x >> 2;
        if (seg == 0) rec_sample_list(p, lds, bh * 10, 1, 10);
        else { const int k = bh * 3 + (seg - 1); rec_sample_list(p, lds, 640 + k, 192, 2); }
    } else rec_sample_list(p, lds, blockIdx.x, gridDim.x, (TS * 8 - (int)blockIdx.x + (int)gridDim.x - 1) / (int)gridDim.x);
}
__device__ __forceinline__ void ph_out(const Params& p, LAS unsigned char* lds, bool dummy = false) {
    unsigned char* ws = p.ws; pg8::StaticOrder S; float* slot = dummy ? (float*)nullptr : part_slot(ws, 0);
    EpiRes<false, false> E{p.x_prompt, nullptr, nullptr, (bf16_t*)(ws + WS_XB), nullptr, slot};
    pg8::Gemm g{(const bf16_t*)(ws + WS_R2), (const bf16_t*)(ws + WS_WOUT), TP, 1024, 1024, 1024, 0};
    S.init(g.M, g.N, gridDim.x, blockIdx.x); pg8::gemm_phase(lds, g, S, E);
    SRes F{p.x_sample, p.out + O_YS, (bf16_t*)(ws + WS_XB) + (size_t)TP * 1024, nullptr, dummy ? (float*)nullptr : slot + (size_t)TP * 16};
    sample_gemm<1>(lds, (const bf16_t*)(ws + WS_R2) + (size_t)TP * 1024, 1024, 0, (const bf16_t*)(ws + WS_WOUT), 1024, F);
}
__device__ __forceinline__ void ph_up(const Params& p, LAS unsigned char* lds, int L) {
    unsigned char* ws = p.ws; pg8::StaticOrder S; float* sq = part_slot(ws, L ? 2 : 0);
    const bf16_t* W = (const bf16_t*)(ws + (L ? WS_WUP1 : WS_WUP0));
    EpiUp E{(bf16_t*)(ws + WS_H), sq};
    pg8::Gemm g{(const bf16_t*)(ws + WS_XB), W, TP, 4096, 1024, 1024, 0};
    S.init(g.M, g.N, gridDim.x, blockIdx.x); pg8::gemm_phase(lds, g, S, E);
    SUp F{(bf16_t*)(ws + WS_H) + (size_t)TP * 4096, sq + (size_t)TP * 16};
    sample_gemm<4>(lds, (const bf16_t*)(ws + WS_XB) + (size_t)TP * 1024, 1024, 0, W, 1024, F);
}
__device__ __forceinline__ void ph_down(const Params& p, LAS unsigned char* lds, int L) {
    unsigned char* ws = p.ws; pg8::StaticOrder S; float* sq = part_slot(ws, L ? 3 : 1);
    const bf16_t* W = (const bf16_t*)(ws + (L ? WS_WDN1 : WS_WDN0));
    pg8::Gemm g{(const bf16_t*)(ws + WS_H), W, TP, 1024, 4096, 4096, 0};
    S.init(g.M, g.N, gridDim.x, blockIdx.x);
    if (L == 0) { EpiRes<true, false> E{nullptr, (const bf16_t*)(ws + WS_XB), nullptr, (bf16_t*)(ws + WS_XB), nullptr, sq}; pg8::gemm_phase(lds, g, S, E); }
    else { EpiFinal E{(const bf16_t*)(ws + WS_XB), p.out, p.final_norm, sq, (unsigned*)(ws + WS_BAR) + XCD_BAR_WORDS}; pg8::gemm_phase(lds, g, S, E); }
    SRes F{p.out + O_YS, p.out + O_YS, nullptr, nullptr, sq + (size_t)TP * 16};
    sample_gemm<1>(lds, (const bf16_t*)(ws + WS_H) + (size_t)TP * 4096, 4096, 0, W, 4096, F);
}
__device__ __forceinline__ void ph_poolg(const Params& p, LAS unsigned char* lds) {
    unsigned char* ws = p.ws; pg8::StaticOrder S; float* sq = part_slot(ws, 2);
    EpiRes<true, false> E{nullptr, (const bf16_t*)(ws + WS_XB), nullptr, (bf16_t*)(ws + WS_XB), p.pool_scale, sq};
    pg8::Gemm g{(const bf16_t*)(ws + WS_R2), (const bf16_t*)(ws + WS_WP), TP, 1024, 256, 1024, 256};
    S.init(g.M, g.N, gridDim.x, blockIdx.x); pg8::gemm_phase(lds, g, S, E);
    SRes F{p.out + O_YS, p.out + O_YS, (bf16_t*)(ws + WS_XB) + (size_t)TP * 1024, p.pool_scale, sq + (size_t)TP * 16};
    sample_gemm<1>(lds, (const bf16_t*)(ws + WS_R2) + (size_t)TP * 1024, 1024, 256, (const bf16_t*)(ws + WS_WP), 256, F);
}
__global__ void __launch_bounds__(512, 2) mega(Params p) {
    extern __shared__ __attribute__((aligned(16))) unsigned char shm[];
    LAS unsigned char* lds = (LAS unsigned char*)shm;
    volatile LAS unsigned* xst = (volatile LAS unsigned*)(lds + 151552);
    if (threadIdx.x == 0) { xst[0] = 0u; xst[1] = 0u; }
    __syncthreads();
    const XcdBarrier xb = xcd_barrier_post((unsigned*)(p.ws + WS_BAR), xst);
    if (p.ph_hi > 4096) cg::this_grid().sync();
    phase_prep(p, lds);
    if (DUP_PHASE == 0) { xcd_barrier(xb); phase_prep(p, lds); }
    if (DUP_PHASE == 20) { for (int i = 0; i < 20; ++i) xcd_barrier(xb); }
    xcd_barrier(xb); ph_in(p, lds);
    if (DUP_PHASE == 1) { xcd_barrier(xb); ph_in(p, lds); }
    xcd_barrier(xb); ph_rec1(p, lds);
    if (DUP_PHASE == 2) { xcd_barrier(xb); ph_rec1(p, lds); }
    xcd_barrier(xb); ph_rec2(p, lds);
    xcd_barrier(xb); ph_out(p, lds);
    if (DUP_PHASE == 3) { xcd_barrier(xb); ph_out(p, lds); }
    xcd_barrier(xb); ph_up(p, lds, 0);
    if (DUP_PHASE == 4) { xcd_barrier(xb); ph_up(p, lds, 0); }
    xcd_barrier(xb); ph_down(p, lds, 0);
    xcd_barrier(xb); phase_pool(p, lds);
    if (DUP_PHASE == 6) { xcd_barrier(xb); phase_pool(p, lds); }
    xcd_barrier(xb); ph_poolg(p, lds);
    xcd_barrier(xb); ph_up(p, lds, 1);
    xcd_barrier(xb); ph_down(p, lds, 1);
    if (DUP_PHASE == 9) { xcd_barrier(xb); ph_down(p, lds, 1); }
    xcd_barrier(xb);
    phase_final(p);
}

extern "C" void kernel_launch(void* const* d_in, const int* in_sizes, int n_in, void* d_out, int out_size, void* d_ws, size_t ws_size, hipStream_t stream) {
    static int grid = 0;
    if (grid == 0) {
        int dev = 0, cus = 0, per_cu = 0;
        hipGetDevice(&dev);
        hipDeviceGetAttribute(&cus, hipDeviceAttributeMultiprocessorCount, dev);
        if (hipFuncSetAttribute((const void*)mega, hipFuncAttributeMaxDynamicSharedMemorySize, LDS_BYTES) != hipSuccess) fprintf(stderr, "kernel_launch: hipFuncSetAttribute failed\n");
        if (hipOccupancyMaxActiveBlocksPerMultiprocessor(&per_cu, (const void*)mega, 512, LDS_BYTES) != hipSuccess || per_cu < 1) { fprintf(stderr, "kernel_launch: occupancy query gave %d\n", per_cu); per_cu = 1; }
        (void)hipGetLastError();
        grid = cus * per_cu;
        if (ws_size < WS_END3) fprintf(stderr, "kernel_launch: workspace too small: %zu < %zu\n", ws_size, (size_t)WS_END3);
        fprintf(stderr, "kernel_launch: grid %d (cus %d x %d), ws %zu\n", grid, cus, per_cu, ws_size);
    }
    Params p{};
    const float** pp = (const float**)&p;
    for (int i = 0; i < 16; ++i) pp[i] = (const float*)d_in[i];
    p.out = (float*)d_out; p.ws = (unsigned char*)d_ws;
    (void)hipMemsetAsync((unsigned char*)d_ws + WS_BAR, 0, 16384, stream);
    p.ph_lo = 0; p.ph_hi = NPHASE;
    void* args[] = {&p};
    hipError_t e = hipLaunchCooperativeKernel((const void*)mega, dim3(grid), dim3(512), args, LDS_BYTES, stream);
    if (e != hipSuccess) fprintf(stderr, "cooperative launch failed: %s (grid %d)\n", hipGetErrorString(e), grid);
}
```

```cpp
#include <hip/hip_runtime.h>
#include <hip/hip_cooperative_groups.h>
#include <cstdio>
namespace cg = cooperative_groups;

#define LAS __attribute__((address_space(3)))
typedef unsigned short bf16_t;
typedef short bf16x8 __attribute__((ext_vector_type(8)));
typedef float f32x4 __attribute__((ext_vector_type(4)));
typedef float f32x2 __attribute__((ext_vector_type(2)));
typedef unsigned u32x4 __attribute__((ext_vector_type(4)));
typedef unsigned u32x2 __attribute__((ext_vector_type(2)));

#ifndef PHMASK
#define PHMASK 0x7ff
#endif
#ifndef DUP_PHASE
#define DUP_PHASE -1
#endif
#ifndef EXTRA_SYNCS
#define EXTRA_SYNCS 0
#endif
#ifndef MK_LAUNCHES
#define MK_LAUNCHES 1
#endif

constexpr int D = 1024, TP = 16384, TS = 128, MP = TP + TS, FF = 4096, SEQ = 2048;
constexpr float EPS = 1e-6f;
constexpr int NPHASE = 11;
constexpr int LDS_BYTES = 151552 + 16;

constexpr size_t WS_WIN = 0;
constexpr size_t WS_WOUT = WS_WIN + (size_t)4096 * 1024 * 2;
constexpr size_t WS_WUP0 = WS_WOUT + (size_t)1024 * 1024 * 2;
constexpr size_t WS_WDN0 = WS_WUP0 + (size_t)4096 * 1024 * 2;
constexpr size_t WS_WP = WS_WDN0 + (size_t)4096 * 1024 * 2;
constexpr size_t WS_WUP1 = WS_WP + (size_t)1024 * 256 * 2;
constexpr size_t WS_WDN1 = WS_WUP1 + (size_t)4096 * 1024 * 2;
constexpr size_t WS_SSQ = WS_WDN1 + (size_t)4096 * 1024 * 2;
constexpr size_t WS_LB = WS_SSQ + 264192;
constexpr size_t WS_BAR = WS_SSQ + 268288;
constexpr size_t WS_R2 = WS_SSQ + 284672;
constexpr size_t ACT_B = (size_t)MP * 1024 * 2;
constexpr size_t WS_R1 = WS_R2 + ACT_B;
constexpr size_t WS_Q = WS_R1, WS_V = WS_R1 + ACT_B, WS_OG = WS_R1 + 2 * ACT_B, WS_G = WS_R1 + 3 * ACT_B;
constexpr size_t WS_H = WS_R1;
constexpr size_t WS_XB = WS_R1 + (size_t)MP * 4096 * 2;
constexpr size_t WS_END = WS_R1 + 5 * ACT_B;
constexpr size_t WS_PART = WS_END;
constexpr size_t PART_SLOT = (size_t)TP * 16 * 4 + (size_t)TS * 64 * 4;
constexpr size_t WS_END2 = WS_PART + 4 * PART_SLOT;
constexpr size_t WS_LSEG = WS_END2;
constexpr size_t WS_END3 = WS_LSEG + (size_t)64 * 3 * 16384 * 4;
constexpr size_t WS_DSEG = WS_SSQ;

constexpr size_t O_YP = 0, O_YS = 16777216, O_HP = 16908288, O_HS = 17956864, O_PP = 34734080, O_PS = 34856960;

struct Params {
    const float *x_prompt, *x_sample, *state_hgrn, *state_pool, *hgrn_norm, *hgrn_w_in, *hgrn_lb, *hgrn_onorm, *hgrn_w_out,
        *pool_norm, *pool_w, *pool_scale, *mlp_norm, *mlp_up, *mlp_down, *final_norm;
    float* out;
    unsigned char* ws;
    int ph_lo, ph_hi;
};

typedef __bf16 bf16x2_native __attribute__((ext_vector_type(2)));
__device__ __forceinline__ unsigned cvt_pk_bf16(float lo, float hi) { const f32x2 f = {lo, hi}; return __builtin_bit_cast(unsigned, __builtin_convertvector(f, bf16x2_native)); }
__device__ __forceinline__ float bf2f(bf16_t b) { return __uint_as_float(((unsigned)b) << 16); }
__device__ __forceinline__ float bflo(unsigned w) { return __uint_as_float(w << 16); }
__device__ __forceinline__ float bfhi(unsigned w) { return __uint_as_float(w & 0xffff0000u); }
__device__ __forceinline__ bf16_t f2bf(float f) { return (bf16_t)(cvt_pk_bf16(f, 0.f) & 0xffffu); }
typedef _Float16 half2_t __attribute__((ext_vector_type(2)));
__device__ __forceinline__ unsigned cvt_pk_f16(float a, float b) { half2_t h = {(_Float16)a, (_Float16)b}; return __builtin_bit_cast(unsigned, h); }
__device__ __forceinline__ f32x2 h2_to_f2(unsigned w) { const half2_t h = __builtin_bit_cast(half2_t, w); return (f32x2){(float)h[0], (float)h[1]}; }
__device__ __forceinline__ float sigmoidf_(float x) { return __builtin_amdgcn_rcpf(1.f + __expf(-x)); }
__device__ __forceinline__ float wave_sum(float v) {
#pragma unroll
    for (int o = 1; o < 64; o <<= 1) v += __shfl_xor(v, o);
    return v;
}
__device__ __forceinline__ float ein_elem(int type, float x, float lbc) {
    if (type == 0) return x * sigmoidf_(x) * 0.08838834764831845f;
    if (type == 1) return __builtin_amdgcn_logf(lbc + (1.f - lbc) * sigmoidf_(x)) * 0.6931471805599453f;
    if (type == 2) return x;
    return sigmoidf_(x);
}
__device__ __forceinline__ float lb_of(const float* lb, int c) { return 1.f / (1.f + __expf(lb[1024 + c] - lb[c])); }

namespace pg8 {
constexpr int BM = 256, BK = 64, HALF = 128, HTB = HALF * BK * 2, STAGE_BYTES = 8 * HTB, NXCD = 8, WGM = 4;
__host__ __device__ __forceinline__ int lds_byte(int r, int c) { const int st = (r >> 4) * 2 + (c >> 5), rr = r & 15, cc = c & 31, ob = rr * 64 + cc * 2; return st * 1024 + (ob ^ (((ob >> 9) & 1) << 5)); }
__host__ __device__ __forceinline__ void stage_rc(int b, int& R, int& C) { const int st = b / 1024, sb = b % 1024, swz = sb ^ (((sb >> 9) & 1) << 5); R = (st >> 1) * 16 + swz / 64; C = (st & 1) * 32 + (swz % 64) / 2; }
__host__ __device__ __forceinline__ int perm32(int rho) { const int n = rho >> 4, i = rho & 15; return 8 * (i >> 2) + 4 * n + (i & 3); }
struct Unit { int pm, pn; };
struct Gemm { const bf16_t* A; const bf16_t* Bt; int M, N, K, lda, agroup; };
struct StaticOrder {
    int nM, nN, nwg, G, c;
    __device__ void init(int M, int N, int G_, int c_) { nM = M / BM; nN = N / BM; nwg = nM * nN; G = G_; c = c_; }
    __device__ bool next(int i, Unit& u) const {
        const long L = (long)i * G + c; if (L >= nwg) return false;
        int wgid = (int)L; { const int q = nwg / NXCD, r = nwg % NXCD, xcd = wgid % NXCD, off = wgid / NXCD; wgid = (xcd < r ? xcd * (q + 1) : r * (q + 1) + (xcd - r) * q) + off; }
        const int nig = WGM * nN, gid = wgid / nig, fm = gid * WGM, gsz = (nM - fm) < WGM ? (nM - fm) : WGM;
        u.pm = fm + ((wgid % nig) % gsz); u.pn = (wgid % nig) / gsz; return true;
    }
};

template <class Epi>
__device__ __forceinline__ void gemm_phase(LAS unsigned char* lds, const Gemm g, const StaticOrder& S, const Epi& E) {
    int tid_ = threadIdx.x; asm volatile("" : "+v"(tid_));
    const int tid = tid_, wid = __builtin_amdgcn_readfirstlane(tid >> 6), lane = tid & 63, wr = wid >> 2, wc = wid & 3, fr = lane & 15, fq = lane >> 4;
    const int K = g.K, nt = K / BK, lda = g.lda;
    unsigned voffA[2], voffB[2];
#pragma unroll
    for (int i = 0; i < 2; ++i) { int R, C; stage_rc(tid * 16 + i * 8192, R, C); const int Rb = (R & ~31) + perm32(R & 31);
        voffA[i] = (unsigned)(R * lda + C) * 2u; voffB[i] = (unsigned)(Rb * K + C) * 2u; }
    const size_t kstep = (size_t)(BK * 2);
    const size_t hstepA = (size_t)HALF * lda * 2, hstepB = (size_t)HALF * K * 2;
    const size_t tstepA = 2 * hstepA, tstepB = 2 * hstepB;
    const unsigned ldsw = (unsigned)wid * 1024u;
    const int aoff = lds_byte(wr * 64 + fr, fq * 8), boff = lds_byte(wc * 32 + fr, fq * 8);
#define PG8_SA(b, h) (((b) * 2 + (h)) * HTB)
#define PG8_SB(b, h) ((4 + (b) * 2 + (h)) * HTB)
#define PG8_STAGE(bufoff, gbase, voff) do { _Pragma("unroll") for (int _i = 0; _i < 2; ++_i) \
        __builtin_amdgcn_global_load_lds((const unsigned*)((const char*)(gbase) + (voff)[_i]), (LAS unsigned*)(lds + (bufoff) + ldsw + _i * 8192), 16, 0, 0); } while (0)
#define PG8_LDA(dst, b, h) do { _Pragma("unroll") for (int m = 0; m < 4; ++m) _Pragma("unroll") for (int k = 0; k < 2; ++k) dst[m][k] = *(const LAS bf16x8*)(lds + PG8_SA(b, h) + aoff + m * 2048 + k * 1024); } while (0)
#define PG8_LDB(dst, b, h) do { _Pragma("unroll") for (int n = 0; n < 2; ++n) _Pragma("unroll") for (int k = 0; k < 2; ++k) dst[n][k] = *(const LAS bf16x8*)(lds + PG8_SB(b, h) + boff + n * 2048 + k * 1024); } while (0)
#define PG8_MMA(ai, bj, At, Bt) do { __builtin_amdgcn_s_setprio(1); _Pragma("unroll") for (int m = 0; m < 4; ++m) _Pragma("unroll") for (int n = 0; n < 2; ++n) _Pragma("unroll") for (int k = 0; k < 2; ++k) \
        acc[ai][bj][m][n] = __builtin_amdgcn_mfma_f32_16x16x32_bf16(Bt[n][k], At[m][k], acc[ai][bj][m][n], 0, 0, 0); __builtin_amdgcn_s_setprio(0); } while (0)
#define PG8_WAIT_V(n) asm volatile("s_waitcnt vmcnt(" #n ")" ::: "memory")
#define PG8_WAIT_L(n) asm volatile("s_waitcnt lgkmcnt(" #n ")" ::: "memory")
#define PG8_BAR __builtin_amdgcn_s_barrier()
#define PG8_SCHED __builtin_amdgcn_sched_barrier(0)
    Unit cur, nxt; int ui = 0;
    if (!S.next(0, cur)) return;
    f32x4 acc[2][2][4][2];
#pragma unroll
    for (int a = 0; a < 2; ++a)
#pragma unroll
        for (int b = 0; b < 2; ++b)
#pragma unroll
            for (int m = 0; m < 4; ++m)
#pragma unroll
                for (int n = 0; n < 2; ++n) acc[a][b][m][n] = (f32x4){0.f, 0.f, 0.f, 0.f};
    bf16x8 At[4][2], B0[2][2], B1[2][2];
    const char* cA = (const char*)g.A + (size_t)cur.pm * tstepA + (size_t)cur.pn * g.agroup * 2; const char* cB = (const char*)g.Bt + (size_t)cur.pn * tstepB;
    PG8_STAGE(PG8_SB(0, 0), cB, voffB); PG8_STAGE(PG8_SA(0, 0), cA, voffA); PG8_STAGE(PG8_SB(0, 1), cB + hstepB, voffB); PG8_STAGE(PG8_SA(0, 1), cA + hstepA, voffA);
    if (wr == 1) PG8_BAR;
    PG8_WAIT_V(4); PG8_BAR;
    PG8_STAGE(PG8_SB(1, 0), cB + kstep, voffB); PG8_STAGE(PG8_SA(1, 0), cA + kstep, voffA); PG8_STAGE(PG8_SB(1, 1), cB + hstepB + kstep, voffB);
    PG8_WAIT_V(6); PG8_BAR;
    for (;;) {
        const bool has_next = S.next(ui + 1, nxt);
        const char* nA = has_next ? (const char*)g.A + (size_t)nxt.pm * tstepA + (size_t)nxt.pn * g.agroup * 2 : cA; const char* nB = has_next ? (const char*)g.Bt + (size_t)nxt.pn * tstepB : cB;
        for (int t = 0; t < nt; t += 2) {
            const bool last = (t == nt - 2);
            const char* a1 = cA + (size_t)(t + 1) * kstep;
            const char* a2 = last ? nA : cA + (size_t)(t + 2) * kstep; const char* b2 = last ? nB : cB + (size_t)(t + 2) * kstep;
            const char* a3 = a2 + kstep; const char* b3 = b2 + kstep;
            PG8_LDB(B0, 0, 0); PG8_SCHED; PG8_LDA(At, 0, 0); PG8_STAGE(PG8_SA(1, 1), a1 + hstepA, voffA);
            PG8_WAIT_L(8); PG8_BAR; PG8_WAIT_L(0); PG8_MMA(0, 0, At, B0); PG8_BAR; PG8_SCHED;
            PG8_LDB(B1, 0, 1); PG8_STAGE(PG8_SB(0, 0), b2, voffB);
            PG8_BAR; PG8_WAIT_L(0); PG8_MMA(0, 1, At, B1); PG8_BAR;
            PG8_LDA(At, 0, 1); PG8_STAGE(PG8_SA(0, 0), a2, voffA);
            PG8_BAR; PG8_WAIT_L(0); PG8_MMA(1, 0, At, B0); PG8_BAR; PG8_SCHED;
            PG8_STAGE(PG8_SB(0, 1), b2 + hstepB, voffB);
            PG8_WAIT_V(6); PG8_BAR; PG8_MMA(1, 1, At, B1); PG8_BAR;
            PG8_LDB(B0, 1, 0); PG8_SCHED; PG8_LDA(At, 1, 0); PG8_STAGE(PG8_SA(0, 1), a2 + hstepA, voffA);
            PG8_WAIT_L(8); PG8_BAR; PG8_WAIT_L(0); PG8_MMA(0, 0, At, B0); PG8_BAR; PG8_SCHED;
            PG8_LDB(B1, 1, 1); PG8_STAGE(PG8_SB(1, 0), b3, voffB);
            PG8_BAR; PG8_WAIT_L(0); PG8_MMA(0, 1, At, B1); PG8_BAR;
            PG8_LDA(At, 1, 1); PG8_STAGE(PG8_SA(1, 0), a3, voffA);
            PG8_BAR; PG8_WAIT_L(0); PG8_MMA(1, 0, At, B0); PG8_BAR; PG8_SCHED;
            PG8_STAGE(PG8_SB(1, 1), b3 + hstepB, voffB);
            PG8_WAIT_V(6); PG8_BAR; PG8_MMA(1, 1, At, B1); PG8_BAR;
        }
        if constexpr (!Epi::AFTER_DRAIN) E(acc, cur, wr, wc, fr, fq);
        if (!has_next) break;
#pragma unroll
        for (int a = 0; a < 2; ++a)
#pragma unroll
            for (int b = 0; b < 2; ++b)
#pragma unroll
                for (int m = 0; m < 4; ++m)
#pragma unroll
                    for (int n = 0; n < 2; ++n) acc[a][b][m][n] = (f32x4){0.f, 0.f, 0.f, 0.f};
        cur = nxt; cA = nA; cB = nB; ++ui;
    }
    PG8_WAIT_V(0);
    if (wr == 0) PG8_BAR;
    PG8_BAR;
    if constexpr (Epi::AFTER_DRAIN) E.fused(acc, cur, wr, wc, fr, fq, lds);
#undef PG8_SA
#undef PG8_SB
#undef PG8_STAGE
#undef PG8_LDA
#undef PG8_LDB
#undef PG8_MMA
#undef PG8_WAIT_V
#undef PG8_WAIT_L
#undef PG8_BAR
#undef PG8_SCHED
}
}

struct EpiIn {
    static constexpr bool AFTER_DRAIN = false;
    bf16_t *Q, *V, *OG; bf16_t* G; const float* lb;
    __device__ __forceinline__ void operator()(const f32x4 (&acc)[2][2][4][2], const pg8::Unit& u, int wr, int wc, int fr, int fq) const {
        const int type = u.pn >> 2;
        const int row0 = u.pm * 256 + wr * 64 + fr, col0 = (u.pn & 3) * 256 + wc * 32 + 8 * fq;
        if (type == 1) {
            f32x4 lbv[2][2];
#pragma unroll
            for (int bj = 0; bj < 2; ++bj) { lbv[bj][0] = *(const f32x4*)(lb + col0 + bj * 128); lbv[bj][1] = *(const f32x4*)(lb + col0 + bj * 128 + 4); }
#pragma unroll
            for (int ai = 0; ai < 2; ++ai)
#pragma unroll
                for (int m = 0; m < 4; ++m) { bf16_t* rowp = G + (size_t)(row0 + ai * 128 + m * 16) * 1024 + col0;
#pragma unroll
                    for (int bj = 0; bj < 2; ++bj) { f32x4 o0, o1; const f32x4 l0 = lbv[bj][0], l1 = lbv[bj][1];
#pragma unroll
                        for (int e = 0; e < 4; ++e) { o0[e] = ein_elem(1, acc[ai][bj][m][0][e], l0[e]); o1[e] = ein_elem(1, acc[ai][bj][m][1][e], l1[e]); }
                        u32x4 w; w.x = cvt_pk_f16(o0[0], o0[1]); w.y = cvt_pk_f16(o0[2], o0[3]); w.z = cvt_pk_f16(o1[0], o1[1]); w.w = cvt_pk_f16(o1[2], o1[3]);
                        *(u32x4*)(rowp + bj * 128) = w; }
                    asm volatile("" ::: "memory"); }
        } else {
            bf16_t* base = Q + (size_t)(type == 0 ? 0 : type - 1) * (ACT_B / 2);
            if (type == 0) store_bf16<0>(acc, base, row0, col0);
            else if (type == 2) store_bf16<2>(acc, base, row0, col0);
            else store_bf16<3>(acc, base, row0, col0);
        }
    }
    template <int TYPE> __device__ __forceinline__ void store_bf16(const f32x4 (&acc)[2][2][4][2], bf16_t* base, int row0, int col0) const {
#pragma unroll
        for (int ai = 0; ai < 2; ++ai)
#pragma unroll
            for (int m = 0; m < 4; ++m) { bf16_t* rowp = base + (size_t)(row0 + ai * 128 + m * 16) * 1024 + col0;
#pragma unroll
                for (int bj = 0; bj < 2; ++bj) { f32x4 o0, o1;
#pragma unroll
                    for (int e = 0; e < 4; ++e) { o0[e] = ein_elem(TYPE, acc[ai][bj][m][0][e], 0.f); o1[e] = ein_elem(TYPE, acc[ai][bj][m][1][e], 0.f); }
                    u32x4 w; w.x = cvt_pk_bf16(o0[0], o0[1]); w.y = cvt_pk_bf16(o0[2], o0[3]); w.z = cvt_pk_bf16(o1[0], o1[1]); w.w = cvt_pk_bf16(o1[2], o1[3]);
                    *(u32x4*)(rowp + bj * 128) = w; }
                asm volatile("" ::: "memory"); }
    }
};
template <bool IN16, bool OUT32> struct EpiRes {
    static constexpr bool AFTER_DRAIN = false;
    const float* Xin32; const bf16_t* Xin16; float* Xout32; bf16_t* Xb; const float* scale; float* part;
    __device__ __forceinline__ void operator()(const f32x4 (&acc)[2][2][4][2], const pg8::Unit& u, int wr, int wc, int fr, int fq) const {
        const int row0 = u.pm * 256 + wr * 64 + fr, col0 = u.pn * 256 + wc * 32 + 8 * fq;
        constexpr int NB = 2;
        f32x4 sc[2][2];
#pragma unroll
        for (int bj = 0; bj < 2; ++bj) { sc[bj][0] = scale ? *(const f32x4*)(scale + col0 + bj * 128) : (f32x4){1.f, 1.f, 1.f, 1.f}; sc[bj][1] = scale ? *(const f32x4*)(scale + col0 + bj * 128 + 4) : (f32x4){1.f, 1.f, 1.f, 1.f}; }
        constexpr int AIB = 2 / NB;
#pragma unroll
        for (int bt = 0; bt < NB; ++bt) {
            f32x4 xr[AIB][4][2][IN16 ? 1 : 2];
#pragma unroll
            for (int a2 = 0; a2 < AIB; ++a2)
#pragma unroll
                for (int m = 0; m < 4; ++m) { const int ai = bt * AIB + a2; const size_t off = (size_t)(row0 + ai * 128 + m * 16) * 1024 + col0;
#pragma unroll
                    for (int bj = 0; bj < 2; ++bj) {
                        if (IN16) xr[a2][m][bj][0] = __builtin_bit_cast(f32x4, *(const u32x4*)(Xin16 + off + bj * 128));
                        else { xr[a2][m][bj][0] = *(const f32x4*)(Xin32 + off + bj * 128); xr[a2][m][bj][IN16 ? 0 : 1] = *(const f32x4*)(Xin32 + off + bj * 128 + 4); } } }
#pragma unroll
            for (int a2 = 0; a2 < AIB; ++a2)
#pragma unroll
                for (int m = 0; m < 4; ++m) { const int ai = bt * AIB + a2; const int row = row0 + ai * 128 + m * 16; const size_t off = (size_t)row * 1024 + col0; float ss = 0.f;
#pragma unroll
                    for (int bj = 0; bj < 2; ++bj) {
                        const f32x4 a0 = acc[ai][bj][m][0] * sc[bj][0], a1 = acc[ai][bj][m][1] * sc[bj][1];
                        f32x4 x0, x1;
                        if (IN16) { const u32x4 w = __builtin_bit_cast(u32x4, xr[a2][m][bj][0]); x0 = (f32x4){bflo(w.x), bfhi(w.x), bflo(w.y), bfhi(w.y)}; x1 = (f32x4){bflo(w.z), bfhi(w.z), bflo(w.w), bfhi(w.w)}; }
                        else { x0 = xr[a2][m][bj][0]; x1 = xr[a2][m][bj][IN16 ? 0 : 1]; }
                        x0 = x0 + a0; x1 = x1 + a1;
                        if (OUT32) { *(f32x4*)(Xout32 + off + bj * 128) = x0; *(f32x4*)(Xout32 + off + bj * 128 + 4) = x1; }
                        if (Xb) { u32x4 w; w.x = cvt_pk_bf16(x0[0], x0[1]); w.y = cvt_pk_bf16(x0[2], x0[3]); w.z = cvt_pk_bf16(x1[0], x1[1]); w.w = cvt_pk_bf16(x1[2], x1[3]); *(u32x4*)(Xb + off + bj * 128) = w; }
                        ss += x0[0] * x0[0] + x0[1] * x0[1] + x0[2] * x0[2] + x0[3] * x0[3] + x1[0] * x1[0] + x1[1] * x1[1] + x1[2] * x1[2] + x1[3] * x1[3]; }
                    ss += __shfl_xor(ss, 16); ss += __shfl_xor(ss, 32);
                    if (fq == 0 && part) part[(size_t)row * 16 + u.pn * 4 + wc] = ss; }
            asm volatile("" ::: "memory"); }
    }
};
struct EpiFinal {
    static constexpr bool AFTER_DRAIN = true;
    const bf16_t* Xin16; float* Y; const float* gfin; float* part; unsigned* cnt;
    __device__ __forceinline__ void fused(f32x4 (&acc)[2][2][4][2], const pg8::Unit& u, int wr, int wc, int fr, int fq, LAS unsigned char* lds) const {
        const int row0 = u.pm * 256 + wr * 64 + fr, col0 = u.pn * 256 + wc * 32 + 8 * fq;
        u32x4 xr[2][4][2];
#pragma unroll
        for (int ai = 0; ai < 2; ++ai)
#pragma unroll
            for (int m = 0; m < 4; ++m) { const size_t off = (size_t)(row0 + ai * 128 + m * 16) * 1024 + col0;
#pragma unroll
                for (int bj = 0; bj < 2; ++bj) xr[ai][m][bj] = *(const u32x4*)(Xin16 + off + bj * 128); }
#pragma unroll
        for (int ai = 0; ai < 2; ++ai) {
#pragma unroll
            for (int m = 0; m < 4; ++m) { const int row = row0 + ai * 128 + m * 16; float ss = 0.f;
#pragma unroll
                for (int bj = 0; bj < 2; ++bj) { const u32x4 w = xr[ai][m][bj];
                    const f32x4 x0 = (f32x4){bflo(w.x), bfhi(w.x), bflo(w.y), bfhi(w.y)} + acc[ai][bj][m][0], x1 = (f32x4){bflo(w.z), bfhi(w.z), bflo(w.w), bfhi(w.w)} + acc[ai][bj][m][1];
                    acc[ai][bj][m][0] = x0; acc[ai][bj][m][1] = x1;
                    ss += x0[0] * x0[0] + x0[1] * x0[1] + x0[2] * x0[2] + x0[3] * x0[3] + x1[0] * x1[0] + x1[1] * x1[1] + x1[2] * x1[2] + x1[3] * x1[3]; }
                ss += __shfl_xor(ss, 16); ss += __shfl_xor(ss, 32);
                if (fq == 0) __hip_atomic_store(part + (size_t)row * 16 + u.pn * 4 + wc, ss, __ATOMIC_RELAXED, __HIP_MEMORY_SCOPE_AGENT); }
            asm volatile("" ::: "memory"); }
        asm volatile("s_waitcnt vmcnt(0)" ::: "memory");
        __syncthreads();
        if (threadIdx.x == 0) {
            __hip_atomic_fetch_add(cnt + u.pm, 1u, __ATOMIC_RELAXED, __HIP_MEMORY_SCOPE_AGENT);
            unsigned sp = 0;
            while (__hip_atomic_load(cnt + u.pm, __ATOMIC_RELAXED, __HIP_MEMORY_SCOPE_AGENT) < 4u) { __builtin_amdgcn_s_sleep(1); if (++sp > (1u << 20)) break; }
        }
        __syncthreads();
        LAS float* rsl = (LAS float*)lds;
        if (threadIdx.x < 256) { const float* pr = part + (size_t)(u.pm * 256 + threadIdx.x) * 16; float sq = 0.f;
#pragma unroll
            for (int i = 0; i < 16; ++i) sq += __hip_atomic_load(pr + i, __ATOMIC_RELAXED, __HIP_MEMORY_SCOPE_AGENT);
            rsl[threadIdx.x] = rsqrtf(sq * (1.f / 1024.f) + EPS); }
        __syncthreads();
#pragma unroll
        for (int ai = 0; ai < 2; ++ai)
#pragma unroll
            for (int m = 0; m < 4; ++m) { const int rl = ai * 128 + wr * 64 + m * 16 + fr; const float rs = rsl[rl]; float* yp = Y + (size_t)(u.pm * 256 + rl) * 1024 + col0;
#pragma unroll
                for (int bj = 0; bj < 2; ++bj) { const f32x4 g0 = *(const f32x4*)(gfin + col0 + bj * 128), g1 = *(const f32x4*)(gfin + col0 + bj * 128 + 4);
                    __builtin_nontemporal_store(acc[ai][bj][m][0] * rs * g0, (f32x4*)(yp + bj * 128)); __builtin_nontemporal_store(acc[ai][bj][m][1] * rs * g1, (f32x4*)(yp + bj * 128 + 4)); } }
        __syncthreads();
    }
};
struct EpiNull { float* sink; static constexpr bool AFTER_DRAIN = false;
    __device__ __forceinline__ void operator()(const f32x4 (&acc)[2][2][4][2], const pg8::Unit& u, int wr, int wc, int fr, int fq) const {
        f32x4 t = (f32x4){0.f, 0.f, 0.f, 0.f};
#pragma unroll
        for (int a = 0; a < 2; ++a)
#pragma unroll
            for (int b = 0; b < 2; ++b)
#pragma unroll
                for (int m = 0; m < 4; ++m)
#pragma unroll
                    for (int n = 0; n < 2; ++n) t = t + acc[a][b][m][n];
        if (t[0] + t[1] + t[2] + t[3] == 12345.678f) sink[0] = 1.f; } };
struct SNull { float* sink; __device__ __forceinline__ void rowpart(int, int, float) const {}
    __device__ __forceinline__ float operator()(int r, int c, f32x4 v) const { if (v[0] + v[1] + v[2] + v[3] == 12345.678f) sink[0] = 1.f; return 0.f; } };
struct EpiUp {
    static constexpr bool AFTER_DRAIN = false;
    bf16_t* H; const float* part;
    __device__ __forceinline__ void operator()(const f32x4 (&acc)[2][2][4][2], const pg8::Unit& u, int wr, int wc, int fr, int fq) const {
        const int row0 = u.pm * 256 + wr * 64 + fr, col0 = u.pn * 256 + wc * 32 + 8 * fq;
        f32x4 pv[2][4]; float rs[2][4];
#pragma unroll
        for (int ai = 0; ai < 2; ++ai)
#pragma unroll
            for (int m = 0; m < 4; ++m) pv[ai][m] = *(const f32x4*)(part + (size_t)(row0 + ai * 128 + m * 16) * 16 + fq * 4);
#pragma unroll
        for (int ai = 0; ai < 2; ++ai)
#pragma unroll
            for (int m = 0; m < 4; ++m) { float sq = (pv[ai][m][0] + pv[ai][m][1]) + (pv[ai][m][2] + pv[ai][m][3]); sq += __shfl_xor(sq, 16); sq += __shfl_xor(sq, 32); rs[ai][m] = rsqrtf(sq * (1.f / 1024.f) + EPS); }
#pragma unroll
        for (int ai = 0; ai < 2; ++ai)
#pragma unroll
            for (int m = 0; m < 4; ++m) { const int row = row0 + ai * 128 + m * 16; const float r = rs[ai][m]; bf16_t* rowp = H + (size_t)row * 4096 + col0;
#pragma unroll
                for (int bj = 0; bj < 2; ++bj) { f32x4 o0, o1;
#pragma unroll
                    for (int e = 0; e < 4; ++e) { float a = fmaxf(acc[ai][bj][m][0][e] * r, 0.f), b2 = fmaxf(acc[ai][bj][m][1][e] * r, 0.f); o0[e] = a * a; o1[e] = b2 * b2; }
                    u32x4 w; w.x = cvt_pk_bf16(o0[0], o0[1]); w.y = cvt_pk_bf16(o0[2], o0[3]); w.z = cvt_pk_bf16(o1[0], o1[1]); w.w = cvt_pk_bf16(o1[2], o1[3]);
                    *(u32x4*)(rowp + bj * 128) = w; } }
    }
};

template <int NCT, class F>
__device__ __forceinline__ void sample_gemm(LAS unsigned char* lds, const bf16_t* A, int lda, int agroup, const bf16_t* Bt, int K, const F& f) {
    constexpr int CT = NCT * 16;
    const int tid = threadIdx.x, wid = tid >> 6, lane = tid & 63, fr = lane & 15, fq = lane >> 4;
    LAS float* red = (LAS float*)lds;
    for (int blk = blockIdx.x; blk < 256; blk += gridDim.x) {
        const int rb = blk & 3, cb = blk >> 2, r0 = rb * 32, c0 = cb * CT;
        const int Kw = K >> 3, kb = wid * Kw;
        const bf16_t* Ab = A + (size_t)(c0 >> 8) * agroup;
        f32x4 acc[2][NCT];
#pragma unroll
        for (int i = 0; i < 2; ++i)
#pragma unroll
            for (int j = 0; j < NCT; ++j) acc[i][j] = (f32x4){0.f, 0.f, 0.f, 0.f};
        constexpr int UN = NCT == 1 ? 8 : 2;
        for (int k = kb; k < kb + Kw; k += 32 * UN) {
            bf16x8 af[UN][2], bfr[UN][NCT];
#pragma unroll
            for (int uu = 0; uu < UN; ++uu) { const int ku = k + 32 * uu; const bool ok = ku < kb + Kw;
#pragma unroll
                for (int i = 0; i < 2; ++i) af[uu][i] = ok ? *(const bf16x8*)(Ab + (size_t)(r0 + i * 16 + fr) * lda + ku + fq * 8) : (bf16x8){0, 0, 0, 0, 0, 0, 0, 0};
#pragma unroll
                for (int j = 0; j < NCT; ++j) bfr[uu][j] = ok ? *(const bf16x8*)(Bt + (size_t)(c0 + j * 16 + fr) * K + ku + fq * 8) : (bf16x8){0, 0, 0, 0, 0, 0, 0, 0}; }
#pragma unroll
            for (int uu = 0; uu < UN; ++uu)
#pragma unroll
                for (int i = 0; i < 2; ++i)
#pragma unroll
                    for (int j = 0; j < NCT; ++j) acc[i][j] = __builtin_amdgcn_mfma_f32_16x16x32_bf16(bfr[uu][j], af[uu][i], acc[i][j], 0, 0, 0);
        }
#pragma unroll
        for (int i = 0; i < 2; ++i)
#pragma unroll
            for (int j = 0; j < NCT; ++j) *(LAS f32x4*)(red + ((size_t)wid * 32 + i * 16 + fr) * CT + j * 16 + fq * 4) = acc[i][j];
        __syncthreads();
        constexpr int NG = 32 * CT / 4;
        for (int i = tid; i < NG; i += 512) { const int row = i / (CT / 4), cgp = i % (CT / 4);
            f32x4 s = (f32x4){0.f, 0.f, 0.f, 0.f};
#pragma unroll
            for (int w = 0; w < 8; ++w) s = s + *(const LAS f32x4*)(red + ((size_t)w * 32 + row) * CT + cgp * 4);
            float ss = f(r0 + row, c0 + cgp * 4, s);
#pragma unroll
            for (int o = 1; o < CT / 4; o <<= 1) ss += __shfl_xor(ss, o);
            if (cgp == 0) f.rowpart(r0 + row, cb, ss); }
        __syncthreads();
    }
}
struct SIn { bf16_t *Q, *V, *OG; bf16_t* G; const float* lb;
    __device__ __forceinline__ void rowpart(int, int, float) const {}
    __device__ __forceinline__ float operator()(int r, int c, f32x4 v) const { const int type = c >> 10, cc = c & 1023; const size_t off = (size_t)(TP + r) * 1024 + cc;
        if (type == 1) { f32x4 o;
#pragma unroll
            for (int e = 0; e < 4; ++e) o[e] = ein_elem(1, v[e], lb[cc + e]);
            u32x2 w; w.x = cvt_pk_f16(o[0], o[1]); w.y = cvt_pk_f16(o[2], o[3]); *(u32x2*)(G + off) = w; }
        else { bf16_t* base = Q + (size_t)(type == 0 ? 0 : type - 1) * (ACT_B / 2); f32x4 o;
            if (type == 0) {
#pragma unroll
                for (int e = 0; e < 4; ++e) o[e] = ein_elem(0, v[e], 0.f); }
            else if (type == 2) o = v;
            else {
#pragma unroll
                for (int e = 0; e < 4; ++e) o[e] = ein_elem(3, v[e], 0.f); }
            u32x2 w; w.x = cvt_pk_bf16(o[0], o[1]); w.y = cvt_pk_bf16(o[2], o[3]); *(u32x2*)(base + off) = w; } return 0.f; } };
struct SRes { const float* Xin; float* Xout; bf16_t* Xb; const float* scale; float* parts;
    __device__ __forceinline__ void rowpart(int r, int cb, float ss) const { if (parts) parts[r * 64 + cb] = ss; }
    __device__ __forceinline__ float operator()(int r, int c, f32x4 v) const { const size_t off = (size_t)r * 1024 + c;
        f32x4 x = *(const f32x4*)(Xin + off); if (scale) v = v * *(const f32x4*)(scale + c); x = x + v; *(f32x4*)(Xout + off) = x;
        if (Xb) { u32x2 w; w.x = cvt_pk_bf16(x[0], x[1]); w.y = cvt_pk_bf16(x[2], x[3]); *(u32x2*)(Xb + off) = w; }
        return x[0] * x[0] + x[1] * x[1] + x[2] * x[2] + x[3] * x[3]; } };
struct SUp { bf16_t* H; const float* parts;
    __device__ __forceinline__ void rowpart(int, int, float) const {}
    __device__ __forceinline__ float operator()(int r, int c, f32x4 v) const { f32x4 t = (f32x4){0.f, 0.f, 0.f, 0.f};
#pragma unroll
        for (int i = 0; i < 16; ++i) t = t + *(const f32x4*)(parts + r * 64 + i * 4);
        const float rs = rsqrtf(((t[0] + t[1]) + (t[2] + t[3])) * (1.f / 1024.f) + EPS); f32x4 o;
#pragma unroll
        for (int e = 0; e < 4; ++e) { float a = fmaxf(v[e] * rs, 0.f); o[e] = a * a; }
        u32x2 w; w.x = cvt_pk_bf16(o[0], o[1]); w.y = cvt_pk_bf16(o[2], o[3]); *(u32x2*)(H + (size_t)r * 4096 + c) = w; return 0.f; } };

struct TJob { const float* src; bf16_t* dst; const float* gain; int N, ldd, k0, n0; };
__device__ __forceinline__ bool prep_job(const Params& p, int it, TJob& j) {
    unsigned char* ws = p.ws;
    constexpr int T_IN = 1024, T_OUT = 256, T_UP = 1024, T_DN = 1024, T_P = 64;
    constexpr int NT = T_IN + T_OUT + 2 * T_UP + 2 * T_DN + T_P;
    if (it >= NT) return false;
    int r = it; j.gain = nullptr;
    if (r < T_IN) { j.src = p.hgrn_w_in; j.N = 4096; j.dst = (bf16_t*)(ws + WS_WIN); j.ldd = 1024; j.k0 = (r >> 6) * 64; j.n0 = (r & 63) * 64; return true; } r -= T_IN;
    if (r < T_OUT) { j.src = p.hgrn_w_out; j.N = 1024; j.dst = (bf16_t*)(ws + WS_WOUT); j.ldd = 1024; j.k0 = (r >> 4) * 64; j.n0 = (r & 15) * 64; return true; } r -= T_OUT;
    if (r < T_UP) { j.src = p.mlp_up; j.N = 4096; j.dst = (bf16_t*)(ws + WS_WUP0); j.ldd = 1024; j.k0 = (r >> 6) * 64; j.n0 = (r & 63) * 64; j.gain = p.mlp_norm; return true; } r -= T_UP;
    if (r < T_UP) { j.src = p.mlp_up + (size_t)1024 * 4096; j.N = 4096; j.dst = (bf16_t*)(ws + WS_WUP1); j.ldd = 1024; j.k0 = (r >> 6) * 64; j.n0 = (r & 63) * 64; j.gain = p.mlp_norm + 1024; return true; } r -= T_UP;
    if (r < T_DN) { j.src = p.mlp_down; j.N = 1024; j.dst = (bf16_t*)(ws + WS_WDN0); j.ldd = 4096; j.k0 = (r >> 4) * 64; j.n0 = (r & 15) * 64; return true; } r -= T_DN;
    if (r < T_DN) { j.src = p.mlp_down + (size_t)4096 * 1024; j.N = 1024; j.dst = (bf16_t*)(ws + WS_WDN1); j.ldd = 4096; j.k0 = (r >> 4) * 64; j.n0 = (r & 15) * 64; return true; } r -= T_DN;
    { const int g = r >> 4, rr = r & 15; j.src = p.pool_w + (size_t)g * 65536; j.N = 256; j.dst = (bf16_t*)(ws + WS_WP) + (size_t)g * 65536; j.ldd = 256; j.k0 = (rr >> 2) * 64; j.n0 = (rr & 3) * 64; }
    return true;
}
__device__ __forceinline__ void phase_prep(const Params& p, LAS unsigned char* lds) {
    LAS float* tiles = (LAS float*)lds;
    unsigned char* ws = p.ws;
    constexpr int NT = 1024 + 256 + 2 * 1024 + 2 * 1024 + 64;
    { const int tid = threadIdx.x, i = tid >> 4, j4 = (tid & 15) * 4, n = tid >> 3, k8 = (tid & 7) * 8;
#pragma unroll 1
      for (int it0 = blockIdx.x; it0 < NT; it0 += 2 * gridDim.x) {
          TJob j[2]; bool ok[2]; f32x4 v[2][2];
#pragma unroll
          for (int q = 0; q < 2; ++q) { ok[q] = prep_job(p, it0 + q * gridDim.x, j[q]);
              if (ok[q]) {
#pragma unroll
                  for (int hh = 0; hh < 2; ++hh) v[q][hh] = __builtin_nontemporal_load((const f32x4*)(j[q].src + (size_t)(j[q].k0 + i + 32 * hh) * j[q].N + j[q].n0 + j4)); } }
#pragma unroll
          for (int q = 0; q < 2; ++q) if (ok[q]) {
#pragma unroll
              for (int hh = 0; hh < 2; ++hh)
#pragma unroll
                  for (int e = 0; e < 4; ++e) tiles[q * 4160 + (j4 + e) * 65 + i + 32 * hh] = v[q][hh][e]; }
          __syncthreads();
#pragma unroll
          for (int q = 0; q < 2; ++q) if (ok[q]) { float o[8];
#pragma unroll
              for (int e = 0; e < 8; ++e) { o[e] = tiles[q * 4160 + n * 65 + k8 + e]; if (j[q].gain) o[e] *= j[q].gain[j[q].k0 + k8 + e]; }
              u32x4 w; w.x = cvt_pk_bf16(o[0], o[1]); w.y = cvt_pk_bf16(o[2], o[3]); w.z = cvt_pk_bf16(o[4], o[5]); w.w = cvt_pk_bf16(o[6], o[7]);
              *(u32x4*)(j[q].dst + (size_t)(j[q].n0 + n) * j[q].ldd + j[q].k0 + k8) = w; }
          __syncthreads();
      } }
    const int tid = threadIdx.x, wid = tid >> 6, lane = tid & 63;
    bf16_t* U = (bf16_t*)(ws + WS_R2);
    for (int row0 = blockIdx.x * 8 + wid; row0 < MP; row0 += gridDim.x * 32) {
        f32x4 v[4][4];
#pragma unroll
        for (int rr = 0; rr < 4; ++rr) { const int row = row0 + rr * gridDim.x * 8; if (row < MP) { const float* src = row < TP ? p.x_prompt + (size_t)row * 1024 : p.x_sample + (size_t)(row - TP) * 1024;
#pragma unroll
            for (int j = 0; j < 4; ++j) v[rr][j] = *(const f32x4*)(src + lane * 4 + 256 * j); } }
#pragma unroll
        for (int rr = 0; rr < 4; ++rr) { const int row = row0 + rr * gridDim.x * 8; if (row < MP) { float sacc = 0.f;
#pragma unroll
            for (int j = 0; j < 4; ++j) sacc += v[rr][j][0] * v[rr][j][0] + v[rr][j][1] * v[rr][j][1] + v[rr][j][2] * v[rr][j][2] + v[rr][j][3] * v[rr][j][3];
            const float rs = rsqrtf(wave_sum(sacc) * (1.f / 1024.f) + EPS);
#pragma unroll
            for (int j = 0; j < 4; ++j) { const f32x4 g = *(const f32x4*)(p.hgrn_norm + lane * 4 + 256 * j);
                u32x2 w; w.x = cvt_pk_bf16(v[rr][j][0] * rs * g[0], v[rr][j][1] * rs * g[1]); w.y = cvt_pk_bf16(v[rr][j][2] * rs * g[2], v[rr][j][3] * rs * g[3]);
                *(u32x2*)(U + (size_t)row * 1024 + lane * 4 + 256 * j) = w; } } }
    }
    if (blockIdx.x < 2) { const int c = blockIdx.x * 512 + tid; ((float*)(ws + WS_LB))[c] = lb_of(p.hgrn_lb, c); }
}

__device__ __forceinline__ bf16x8 lds_frag(const LAS bf16_t* p) { return *(const LAS bf16x8*)p; }
__device__ __forceinline__ void rec_prompt(const Params& p, LAS unsigned char* lds, int b, int h, int seg) {
    const int tid = threadIdx.x, wid = tid >> 6, lane = tid & 63, fr = lane & 15, fq = lane >> 4;
    LAS bf16_t* QT = (LAS bf16_t*)(lds + 0);
    LAS bf16_t* KT = (LAS bf16_t*)(lds + 17408);
    LAS bf16_t* KH = (LAS bf16_t*)(lds + 34816);
    LAS bf16_t* VT = (LAS bf16_t*)(lds + 53248);
    LAS bf16_t* SB = (LAS bf16_t*)(lds + 71680);
    LAS bf16_t* AM = (LAS bf16_t*)(lds + 106496);
    LAS float* TOT = (LAS float*)(lds + 115712);
    LAS float* DD = (LAS float*)(lds + 119808);
    LAS float* SSQ = (LAS float*)(lds + 120320);
    const unsigned char* ws = p.ws;
    const size_t gbase = (size_t)b * SEQ * 1024 + h * 128;
    const bf16_t* Qg = (const bf16_t*)(ws + WS_Q) + gbase; const bf16_t* Vg = (const bf16_t*)(ws + WS_V) + gbase; const bf16_t* OGg = (const bf16_t*)(ws + WS_OG) + gbase;
    const bf16_t* Gg = (const bf16_t*)(ws + WS_G) + gbase;
    bf16_t* Og = (bf16_t*)(p.ws + WS_R2) + gbase;
    bf16_t* QCg = (bf16_t*)(p.ws + WS_R2) + gbase;
    float* OLg = p.out + gbase;
    f32x2 Gseg = (f32x2){0.f, 0.f};
    f32x4 Sacc[8];
#pragma unroll
    for (int i = 0; i < 8; ++i) Sacc[i] = (f32x4){0.f, 0.f, 0.f, 0.f};
    const int d2 = (tid & 63) * 2, part = tid >> 6;
    unsigned gr[8], qr[8], vr[8];
#define REC_LOAD(c) do { const unsigned o_ = (unsigned)(((c) * 64 + part * 8) * 1024 + d2); \
        _Pragma("unroll") for (int i = 0; i < 8; ++i) { gr[i] = *(const unsigned*)(Gg + o_ + (unsigned)i * 1024u); qr[i] = *(const unsigned*)(Qg + o_ + (unsigned)i * 1024u); vr[i] = *(const unsigned*)(Vg + o_ + (unsigned)i * 1024u); } } while (0)
    REC_LOAD(seg * 8);
    const int tb = wid & 3, vh = wid >> 2;
    for (int cc = 0; cc < 8; ++cc) {
        const int c = seg * 8 + cc;
#pragma unroll
        for (int vb = 0; vb < 8; ++vb) { u32x2 w; w.x = cvt_pk_bf16(Sacc[vb][0], Sacc[vb][1]); w.y = cvt_pk_bf16(Sacc[vb][2], Sacc[vb][3]);
            *(LAS u32x2*)(SB + (vb * 16 + fr) * 136 + wid * 16 + fq * 4) = w; }
        f32x2 cs[8];
        { f32x2 run = (f32x2){0.f, 0.f};
#pragma unroll
          for (int i = 0; i < 8; ++i) { run = run + h2_to_f2(gr[i]); cs[i] = run; }
          *(LAS f32x2*)(TOT + part * 128 + d2) = run; }
        __syncthreads();
        { f32x2 off = (f32x2){0.f, 0.f}, Gl = (f32x2){0.f, 0.f};
#pragma unroll
          for (int pp = 0; pp < 8; ++pp) { const f32x2 tv = *(const LAS f32x2*)(TOT + pp * 128 + d2); Gl = Gl + tv; if (pp < part) off = off + tv; }
          const float eGl0 = __expf(Gl[0]), eGl1 = __expf(Gl[1]), eGs0 = __expf(Gseg[0]), eGs1 = __expf(Gseg[1]);
          float kh0[8], kh1[8];
#pragma unroll
          for (int i = 0; i < 8; ++i) { const int t = part * 8 + i; const f32x2 G = off + cs[i];
              const float e0 = __expf(G[0]), e1 = __expf(G[1]), ei0 = __builtin_amdgcn_rcpf(e0), ei1 = __builtin_amdgcn_rcpf(e1);
              const f32x2 gv = h2_to_f2(gr[i]); const float k0 = 1.f - __expf(gv[0]), k1 = 1.f - __expf(gv[1]);
              const float q0 = bflo(qr[i]) * e0, q1 = bfhi(qr[i]) * e1;
              *(LAS unsigned*)(QT + t * 136 + d2) = cvt_pk_bf16(q0, q1); *(LAS unsigned*)(KT + t * 136 + d2) = cvt_pk_bf16(k0 * ei0, k1 * ei1);
              kh0[i] = k0 * eGl0 * ei0; kh1[i] = k1 * eGl1 * ei1;
              if (seg > 0) *(unsigned*)(QCg + (unsigned)((c * 64 + t) * 1024 + d2)) = cvt_pk_bf16(q0 * eGs0, q1 * eGs1); }
          Gseg = Gseg + Gl;
          u32x4 w0, w1; w0.x = cvt_pk_bf16(kh0[0], kh0[1]); w0.y = cvt_pk_bf16(kh0[2], kh0[3]); w0.z = cvt_pk_bf16(kh0[4], kh0[5]); w0.w = cvt_pk_bf16(kh0[6], kh0[7]);
          w1.x = cvt_pk_bf16(kh1[0], kh1[1]); w1.y = cvt_pk_bf16(kh1[2], kh1[3]); w1.z = cvt_pk_bf16(kh1[4], kh1[5]); w1.w = cvt_pk_bf16(kh1[6], kh1[7]);
          *(LAS u32x4*)(KH + d2 * 72 + part * 8) = w0; *(LAS u32x4*)(KH + (d2 + 1) * 72 + part * 8) = w1;
          u32x4 v0, v1;
          v0.x = (vr[0] & 0xffffu) | (vr[1] << 16); v0.y = (vr[2] & 0xffffu) | (vr[3] << 16); v0.z = (vr[4] & 0xffffu) | (vr[5] << 16); v0.w = (vr[6] & 0xffffu) | (vr[7] << 16);
          v1.x = (vr[0] >> 16) | (vr[1] & 0xffff0000u); v1.y = (vr[2] >> 16) | (vr[3] & 0xffff0000u); v1.z = (vr[4] >> 16) | (vr[5] & 0xffff0000u); v1.w = (vr[6] >> 16) | (vr[7] & 0xffff0000u);
          *(LAS u32x4*)(VT + d2 * 72 + part * 8) = v0; *(LAS u32x4*)(VT + (d2 + 1) * 72 + part * 8) = v1;
          if (part == 0) *(LAS f32x2*)(DD + d2) = (f32x2){eGl0, eGl1}; }
        if (cc + 1 < 8) REC_LOAD(c + 1);
        __syncthreads();
        { const int sb = wid >> 1;
#pragma unroll
          for (int ti = 0; ti < 2; ++ti) { const int tbb = (wid & 1) * 2 + ti; f32x4 a = (f32x4){0.f, 0.f, 0.f, 0.f};
              if (sb <= tbb) {
#pragma unroll
                  for (int kk = 0; kk < 4; ++kk) a = __builtin_amdgcn_mfma_f32_16x16x32_bf16(lds_frag(KT + (sb * 16 + fr) * 136 + kk * 32 + fq * 8), lds_frag(QT + (tbb * 16 + fr) * 136 + kk * 32 + fq * 8), a, 0, 0, 0);
                  const int t = tbb * 16 + fr, s0 = sb * 16 + fq * 4;
#pragma unroll
                  for (int j = 0; j < 4; ++j) if (s0 + j > t) a[j] = 0.f; }
              u32x2 w; w.x = cvt_pk_bf16(a[0], a[1]); w.y = cvt_pk_bf16(a[2], a[3]);
              *(LAS u32x2*)(AM + (tbb * 16 + fr) * 72 + sb * 16 + fq * 4) = w; } }
        { const f32x4 dd = *(const LAS f32x4*)(DD + wid * 16 + fq * 4);
          const bf16x8 a0 = lds_frag(KH + (wid * 16 + fr) * 72 + fq * 8), a1 = lds_frag(KH + (wid * 16 + fr) * 72 + 32 + fq * 8);
#pragma unroll
          for (int vb = 0; vb < 8; ++vb) { f32x4 a = Sacc[vb] * dd;
              a = __builtin_amdgcn_mfma_f32_16x16x32_bf16(a0, lds_frag(VT + (vb * 16 + fr) * 72 + fq * 8), a, 0, 0, 0);
              a = __builtin_amdgcn_mfma_f32_16x16x32_bf16(a1, lds_frag(VT + (vb * 16 + fr) * 72 + 32 + fq * 8), a, 0, 0, 0);
              Sacc[vb] = a; } }
        __syncthreads();
        f32x4 oacc[4]; u32x2 ogv[4];
        const size_t tok = (size_t)c * 64 + tb * 16 + fr;
        if (seg == 0) {
#pragma unroll
        for (int vi = 0; vi < 4; ++vi) ogv[vi] = *(const u32x2*)(OGg + tok * 1024 + (vh * 4 + vi) * 16 + fq * 4); }
        { bf16x8 qf[4], af[2];
#pragma unroll
          for (int kk = 0; kk < 4; ++kk) qf[kk] = lds_frag(QT + (tb * 16 + fr) * 136 + kk * 32 + fq * 8);
#pragma unroll
          for (int kk = 0; kk < 2; ++kk) af[kk] = lds_frag(AM + (tb * 16 + fr) * 72 + kk * 32 + fq * 8);
#pragma unroll
          for (int vi = 0; vi < 4; ++vi) { const int vb = vh * 4 + vi; f32x4 a = (f32x4){0.f, 0.f, 0.f, 0.f};
#pragma unroll
              for (int kk = 0; kk < 4; ++kk) a = __builtin_amdgcn_mfma_f32_16x16x32_bf16(lds_frag(SB + (vb * 16 + fr) * 136 + kk * 32 + fq * 8), qf[kk], a, 0, 0, 0);
#pragma unroll
              for (int kk = 0; kk < 2; ++kk) a = __builtin_amdgcn_mfma_f32_16x16x32_bf16(lds_frag(VT + (vb * 16 + fr) * 72 + kk * 32 + fq * 8), af[kk], a, 0, 0, 0);
              oacc[vi] = a; } }
        if (seg == 0) {
        { float ss = 0.f;
#pragma unroll
          for (int vi = 0; vi < 4; ++vi) ss += oacc[vi][0] * oacc[vi][0] + oacc[vi][1] * oacc[vi][1] + oacc[vi][2] * oacc[vi][2] + oacc[vi][3] * oacc[vi][3];
          ss += __shfl_xor(ss, 16); ss += __shfl_xor(ss, 32);
          if (fq == 0) SSQ[vh * 64 + tb * 16 + fr] = ss; }
        __syncthreads();
        { const float tot = SSQ[tb * 16 + fr] + SSQ[64 + tb * 16 + fr]; const float rs = rsqrtf(tot * (1.f / 128.f) + EPS);
#pragma unroll
          for (int vi = 0; vi < 4; ++vi) { const f32x4 o = oacc[vi] * rs * *(const f32x4*)(p.hgrn_onorm + h * 128 + (vh * 4 + vi) * 16 + fq * 4);
              u32x2 w; w.x = cvt_pk_bf16(o[0] * bflo(ogv[vi].x), o[1] * bfhi(ogv[vi].x)); w.y = cvt_pk_bf16(o[2] * bflo(ogv[vi].y), o[3] * bfhi(ogv[vi].y));
              *(u32x2*)(Og + tok * 1024 + (vh * 4 + vi) * 16 + fq * 4) = w; } }
        } else {
#pragma unroll
          for (int vi = 0; vi < 4; ++vi) *(f32x4*)(OLg + tok * 1024 + (vh * 4 + vi) * 16 + fq * 4) = oacc[vi];
          __syncthreads();
        }
    }
#undef REC_LOAD
    float* So = seg == 3 ? p.out + O_HP + (size_t)(b * 8 + h) * 16384 : (float*)(p.ws + WS_LSEG) + ((size_t)(b * 8 + h) * 3 + seg) * 16384;
    if (part == 0) *(f32x2*)((float*)(p.ws + WS_DSEG) + ((size_t)(b * 8 + h) * 4 + seg) * 128 + d2) = (f32x2){__expf(Gseg[0]), __expf(Gseg[1])};
#pragma unroll
    for (int vb = 0; vb < 8; ++vb)
#pragma unroll
        for (int j = 0; j < 4; ++j) So[(size_t)(wid * 16 + fq * 4 + j) * 128 + vb * 16 + fr] = Sacc[vb][j];
    __syncthreads();
}
__device__ __forceinline__ void rec_sample(const Params& p, LAS unsigned char* lds, int item) {
    const int tid = threadIdx.x, b = item >> 3, h = item & 7;
    LAS float* qs = (LAS float*)lds; LAS float* fs = qs + 128; LAS float* ks = qs + 256; LAS float* vs = qs + 384; LAS float* red = qs + 512;
    LAS float* sq = qs + 512 + 2048;
    const unsigned char* ws = p.ws;
    const size_t roff = (size_t)(TP + b) * 1024 + h * 128;
    if (tid < 128) { qs[tid] = bf2f(((const bf16_t*)(ws + WS_Q))[roff + tid]); const float f = __expf((float)((const _Float16*)(ws + WS_G))[roff + tid]); fs[tid] = f; ks[tid] = 1.f - f;
        vs[tid] = bf2f(((const bf16_t*)(ws + WS_V))[roff + tid]); }
    __syncthreads();
    const int v4 = (tid & 31) * 4, dg = tid >> 5;
    const float* Sin = p.state_hgrn + (size_t)item * 16384; float* Sout = p.out + O_HS + (size_t)item * 16384;
    const f32x4 vv = *(const LAS f32x4*)(vs + v4);
    f32x4 o = (f32x4){0.f, 0.f, 0.f, 0.f};
    f32x4 sv[8];
#pragma unroll
    for (int i = 0; i < 8; ++i) sv[i] = *(const f32x4*)(Sin + (size_t)(dg * 8 + i) * 128 + v4);
#pragma unroll
    for (int i = 0; i < 8; ++i) { const int dd = dg * 8 + i; const f32x4 sn = sv[i] * fs[dd] + vv * ks[dd]; *(f32x4*)(Sout + (size_t)dd * 128 + v4) = sn; o = o + sn * qs[dd]; }
    *(LAS f32x4*)(red + dg * 128 + v4) = o;
    __syncthreads();
    float ov = 0.f;
    if (tid < 128) {
#pragma unroll
        for (int i = 0; i < 16; ++i) ov += red[i * 128 + tid];
        const float s = wave_sum(ov * ov); if ((tid & 63) == 0) sq[tid >> 6] = s; }
    __syncthreads();
    if (tid < 128) { const float rs = rsqrtf((sq[0] + sq[1]) * (1.f / 128.f) + EPS);
        const float og = bf2f(((const bf16_t*)(ws + WS_OG))[roff + tid]);
        ((bf16_t*)(p.ws + WS_R2))[roff + tid] = f2bf(ov * rs * p.hgrn_onorm[h * 128 + tid] * og); }
    __syncthreads();
}

__device__ __forceinline__ void rec_sample_list(const Params& p, LAS unsigned char* lds, int first, int stride, int count, size_t obase = WS_R2) {
    const int tid = threadIdx.x;
    LAS float* qs = (LAS float*)lds; LAS float* fs = qs + 128; LAS float* ks = qs + 256; LAS float* vs = qs + 384; LAS float* red = qs + 512;
    LAS float* sq = qs + 512 + 2048;
    const unsigned char* ws = p.ws;
    const int v4 = (tid & 31) * 4, dg = tid >> 5;
    f32x4 svA[8], svB[8]; float lqA = 0.f, lgA = 0.f, lvA = 0.f, loA = 0.f, lqB = 0.f, lgB = 0.f, lvB = 0.f, loB = 0.f;
#define RS_ISSUE(item_, sv, lq, lg, lv, lo) do { const int it_ = (item_); const size_t ro_ = (size_t)(TP + (it_ >> 3)) * 1024 + (it_ & 7) * 128; \
        if (tid < 128) { lq = bf2f(((const bf16_t*)(ws + WS_Q))[ro_ + tid]); lg = (float)((const _Float16*)(ws + WS_G))[ro_ + tid]; lv = bf2f(((const bf16_t*)(ws + WS_V))[ro_ + tid]); lo = bf2f(((const bf16_t*)(ws + WS_OG))[ro_ + tid]); } \
        const float* Sin_ = p.state_hgrn + (size_t)it_ * 16384; \
        _Pragma("unroll") for (int i = 0; i < 8; ++i) sv[i] = __builtin_nontemporal_load((const f32x4*)(Sin_ + (size_t)(dg * 8 + i) * 128 + v4)); } while (0)
#define RS_ITEM(j_, sv, lq, lg, lv, lo) do { \
        const int item = first + (j_) * stride, b = item >> 3, h = item & 7; \
        const size_t roff = (size_t)(TP + b) * 1024 + h * 128; \
        const float og = lo; \
        if (tid < 128) { const float f = __expf(lg); qs[tid] = lq; fs[tid] = f; ks[tid] = 1.f - f; vs[tid] = lv; } \
        __syncthreads(); \
        float* Sout = p.out + O_HS + (size_t)item * 16384; \
        const f32x4 vv = *(const LAS f32x4*)(vs + v4); \
        f32x4 o = (f32x4){0.f, 0.f, 0.f, 0.f}; \
        _Pragma("unroll") for (int i = 0; i < 8; ++i) { const int dd = dg * 8 + i; const f32x4 sn = sv[i] * fs[dd] + vv * ks[dd]; __builtin_nontemporal_store(sn, (f32x4*)(Sout + (size_t)dd * 128 + v4)); o = o + sn * qs[dd]; } \
        if ((j_) + 2 < count) RS_ISSUE(first + ((j_) + 2) * stride, sv, lq, lg, lv, lo); \
        *(LAS f32x4*)(red + dg * 128 + v4) = o; \
        __syncthreads(); \
        float ov = 0.f; \
        if (tid < 128) { \
            _Pragma("unroll") for (int i = 0; i < 16; ++i) ov += red[i * 128 + tid]; \
            const float s2 = wave_sum(ov * ov); if ((tid & 63) == 0) sq[tid >> 6] = s2; } \
        __syncthreads(); \
        if (tid < 128) { const float rs = rsqrtf((sq[0] + sq[1]) * (1.f / 128.f) + EPS); \
            ((bf16_t*)(p.ws + obase))[roff + tid] = f2bf(ov * rs * p.hgrn_onorm[h * 128 + tid] * og); } \
        __syncthreads(); } while (0)
    if (count > 0) RS_ISSUE(first, svA, lqA, lgA, lvA, loA);
    if (count > 1) RS_ISSUE(first + stride, svB, lqB, lgB, lvB, loB);
    for (int j = 0; j < count; j += 2) {
        RS_ITEM(j, svA, lqA, lgA, lvA, loA);
        if (j + 1 < count) RS_ITEM(j + 1, svB, lqB, lgB, lvB, loB);
    }
#undef RS_ITEM
#undef RS_ISSUE
}
__device__ __forceinline__ void rec_fix(const Params& p, LAS unsigned char* lds, int b, int h, int seg) {
    const int tid = threadIdx.x, wid = tid >> 6, lane = tid & 63, fr = lane & 15, fq = lane >> 4;
    LAS bf16_t* QT = (LAS bf16_t*)(lds + 0);
    LAS bf16_t* SB = (LAS bf16_t*)(lds + 71680);
    LAS float* SSQ = (LAS float*)(lds + 118272);
    const unsigned char* ws = p.ws;
    const int bh = b * 8 + h;
    const size_t gbase = (size_t)b * SEQ * 1024 + h * 128;
    const bf16_t* OGg = (const bf16_t*)(ws + WS_OG) + gbase; const bf16_t* QCg = (const bf16_t*)(ws + WS_R2) + gbase;
    const float* OLg = p.out + gbase; bf16_t* Og = (bf16_t*)(p.ws + WS_R2) + gbase;
    const float* Ls = (const float*)(ws + WS_LSEG) + (size_t)bh * 3 * 16384; const float* Ds = (const float*)(ws + WS_DSEG) + (size_t)bh * 4 * 128;
    { f32x4 S[8];
#pragma unroll
      for (int i = 0; i < 8; ++i) S[i] = (f32x4){0.f, 0.f, 0.f, 0.f};
      f32x4 Lr[3][8]; float Dr[3][8];
#pragma unroll
      for (int sp = 0; sp < 3; ++sp)
#pragma unroll
          for (int i = 0; i < 8; ++i) { const int e4 = (tid + 512 * i) * 4, dd = e4 >> 7;
              if (sp < seg) { Lr[sp][i] = *(const f32x4*)(Ls + (size_t)sp * 16384 + e4); Dr[sp][i] = Ds[sp * 128 + dd]; } else { Lr[sp][i] = (f32x4){0.f, 0.f, 0.f, 0.f}; Dr[sp][i] = 1.f; } }
#pragma unroll
      for (int sp = 0; sp < 3; ++sp)
#pragma unroll
          for (int i = 0; i < 8; ++i) S[i] = S[i] * Dr[sp][i] + Lr[sp][i];
#pragma unroll
      for (int i = 0; i < 8; ++i) { const int e4 = (tid + 512 * i) * 4, dd = e4 >> 7, v0 = e4 & 127;
#pragma unroll
          for (int j = 0; j < 4; ++j) SB[(v0 + j) * 136 + dd] = f2bf(S[i][j]);
          if (seg == 3) { float* So = p.out + O_HP + (size_t)bh * 16384 + e4; *(f32x4*)So = S[i] * Ds[3 * 128 + dd] + *(const f32x4*)So; } } }
    const int qrow0 = tid >> 4, qc8 = (tid & 15) * 8;
    const int tb = wid & 3, vh = wid >> 2;
    const f32x4 onv[4] = { *(const f32x4*)(p.hgrn_onorm + h * 128 + (vh * 4 + 0) * 16 + fq * 4), *(const f32x4*)(p.hgrn_onorm + h * 128 + (vh * 4 + 1) * 16 + fq * 4),
                           *(const f32x4*)(p.hgrn_onorm + h * 128 + (vh * 4 + 2) * 16 + fq * 4), *(const f32x4*)(p.hgrn_onorm + h * 128 + (vh * 4 + 3) * 16 + fq * 4) };
    u32x4 nq[2];
#pragma unroll
    for (int i = 0; i < 2; ++i) nq[i] = *(const u32x4*)(QCg + ((size_t)seg * 512 + qrow0 + 32 * i) * 1024 + qc8);
    f32x4 nol[4]; u32x2 nog[4];
    { const size_t tokf = (size_t)seg * 512 + tb * 16 + fr;
#pragma unroll
      for (int vi = 0; vi < 4; ++vi) { nol[vi] = *(const f32x4*)(OLg + tokf * 1024 + (vh * 4 + vi) * 16 + fq * 4); nog[vi] = *(const u32x2*)(OGg + tokf * 1024 + (vh * 4 + vi) * 16 + fq * 4); } }
    for (int cc = 0; cc < 8; ++cc) {
        const size_t t0 = (size_t)seg * 512 + cc * 64;
#pragma unroll
        for (int i = 0; i < 2; ++i) *(LAS u32x4*)(QT + (qrow0 + 32 * i) * 136 + qc8) = nq[i];
        __syncthreads();
        if (cc + 1 < 8) {
#pragma unroll
            for (int i = 0; i < 2; ++i) nq[i] = *(const u32x4*)(QCg + (t0 + 64 + qrow0 + 32 * i) * 1024 + qc8); }
        const size_t tok = t0 + tb * 16 + fr;
        f32x4 oacc[4]; u32x2 ogv[4];
#pragma unroll
        for (int vi = 0; vi < 4; ++vi) { oacc[vi] = nol[vi]; ogv[vi] = nog[vi]; }
        if (cc + 1 < 8) {
#pragma unroll
            for (int vi = 0; vi < 4; ++vi) { nol[vi] = *(const f32x4*)(OLg + (tok + 64) * 1024 + (vh * 4 + vi) * 16 + fq * 4); nog[vi] = *(const u32x2*)(OGg + (tok + 64) * 1024 + (vh * 4 + vi) * 16 + fq * 4); } }
        { bf16x8 qf[4];
#pragma unroll
          for (int kk = 0; kk < 4; ++kk) qf[kk] = lds_frag(QT + (tb * 16 + fr) * 136 + kk * 32 + fq * 8);
#pragma unroll
          for (int vi = 0; vi < 4; ++vi) { const int vb = vh * 4 + vi; f32x4 a = oacc[vi];
#pragma unroll
              for (int kk = 0; kk < 4; ++kk) a = __builtin_amdgcn_mfma_f32_16x16x32_bf16(lds_frag(SB + (vb * 16 + fr) * 136 + kk * 32 + fq * 8), qf[kk], a, 0, 0, 0);
              oacc[vi] = a; } }
        { float ss = 0.f;
#pragma unroll
          for (int vi = 0; vi < 4; ++vi) ss += oacc[vi][0] * oacc[vi][0] + oacc[vi][1] * oacc[vi][1] + oacc[vi][2] * oacc[vi][2] + oacc[vi][3] * oacc[vi][3];
          ss += __shfl_xor(ss, 16); ss += __shfl_xor(ss, 32);
          if (fq == 0) SSQ[vh * 64 + tb * 16 + fr] = ss; }
        __syncthreads();
        { const float tot = SSQ[tb * 16 + fr] + SSQ[64 + tb * 16 + fr]; const float rs = rsqrtf(tot * (1.f / 128.f) + EPS);
#pragma unroll
          for (int vi = 0; vi < 4; ++vi) { const f32x4 o = oacc[vi] * rs * onv[vi];
              u32x2 w; w.x = cvt_pk_bf16(o[0] * bflo(ogv[vi].x), o[1] * bfhi(ogv[vi].x)); w.y = cvt_pk_bf16(o[2] * bflo(ogv[vi].y), o[3] * bfhi(ogv[vi].y));
              *(u32x2*)(Og + tok * 1024 + (vh * 4 + vi) * 16 + fq * 4) = w; } }
    }
    __syncthreads();
}

__device__ __forceinline__ float* part_slot(unsigned char* ws, int k) { return (float*)(ws + WS_PART + (size_t)k * PART_SLOT); }
__device__ __forceinline__ float row_ssq16(const float* slot, size_t row) {
    const f32x4* pp = (const f32x4*)(slot + row * 16); const f32x4 t = (pp[0] + pp[1]) + (pp[2] + pp[3]); return (t[0] + t[1]) + (t[2] + t[3]); }
__device__ __forceinline__ float row_ssq64(const float* slot, int r) {
    const f32x4* pp = (const f32x4*)(slot + (size_t)TP * 16 + (size_t)r * 64); f32x4 t = pp[0];
#pragma unroll
    for (int i = 1; i < 16; ++i) t = t + pp[i];
    return (t[0] + t[1]) + (t[2] + t[3]); }
__device__ __forceinline__ void phase_pool(const Params& p, LAS unsigned char* lds) {
    const int tid = threadIdx.x, c = tid * 2, gi = c >> 8, w = 2 << gi;
    LAS f32x2* ring = (LAS f32x2*)lds;
    const float* slot = part_slot(p.ws, 1);
    bf16_t* Z = (bf16_t*)(p.ws + WS_R2);
    const bf16_t* XBs = (const bf16_t*)(p.ws + WS_XB);
    const f32x2 gp = *(const f32x2*)(p.pool_norm + c);
    for (int unit = blockIdx.x; unit < 256; unit += gridDim.x) {
        const int b = unit >> 5, t0 = (unit & 31) * 64;
#pragma unroll
        for (int i = 0; i < 16; ++i) ring[i * 512 + tid] = (f32x2){0.f, 0.f};
        f32x2 sum = (f32x2){0.f, 0.f};
        LAS float* rsl = (LAS float*)(lds + 65536);
        __syncthreads();
        if (tid < 80) { const int t = t0 - 16 + tid; rsl[tid] = t >= 0 ? rsqrtf(row_ssq16(slot, (size_t)b * SEQ + t) * (1.f / 1024.f) + EPS) : 0.f; }
        __syncthreads();
        for (int tt = -16; tt < 64; tt += 16) {
            unsigned xw[16];
#pragma unroll
            for (int i = 0; i < 16; ++i) { const int t = t0 + tt + i; xw[i] = t >= 0 ? *(const unsigned*)(XBs + ((size_t)b * SEQ + t) * 1024 + c) : 0u; }
#pragma unroll
            for (int i = 0; i < 16; ++i) { const int t = t0 + tt + i; const float rs = rsl[tt + 16 + i];
                const f32x2 u = (f32x2){bflo(xw[i]), bfhi(xw[i])} * rs * gp;
                const f32x2 old = ring[((t - w) & 15) * 512 + tid];
                ring[(t & 15) * 512 + tid] = u; sum = sum + u - old;
                if (tt + i >= 0) { const float cnt = (float)min(w, t + 1); const f32x2 z = sum / cnt - u; const size_t row = (size_t)b * SEQ + t;
                    *(unsigned*)(Z + row * 1024 + c) = cvt_pk_bf16(z[0], z[1]);
                    if (t >= SEQ - 15) *(f32x2*)(p.out + O_PP + ((size_t)b * 15 + (t - (SEQ - 15))) * 1024 + c) = u; } }
        }
    }
    for (int sb = blockIdx.x; sb < TS; sb += gridDim.x) {
        const size_t row = (size_t)TP + sb;
        const float rs = rsqrtf(row_ssq64(slot, sb) * (1.f / 1024.f) + EPS);
        const f32x2 u = *(const f32x2*)(p.out + row * 1024 + c) * rs * gp;
        const float* hist = p.state_pool + (size_t)sb * 15 * 1024 + c;
        float* ho = p.out + O_PS + (size_t)sb * 15 * 1024 + c;
        f32x2 sum = u;
#pragma unroll
        for (int j = 0; j < 15; ++j) { const f32x2 hv = *(const f32x2*)(hist + (size_t)j * 1024); if (j >= 16 - w) sum = sum + hv; if (j >= 1) *(f32x2*)(ho + (size_t)(j - 1) * 1024) = hv; }
        *(f32x2*)(ho + (size_t)14 * 1024) = u;
        const f32x2 z = sum / (float)w - u;
        *(unsigned*)(Z + row * 1024 + c) = cvt_pk_bf16(z[0], z[1]);
    }
}

__device__ __forceinline__ void phase_final(const Params& p) {
    const int tid = threadIdx.x, wid = tid >> 6, lane = tid & 63;
    const float* slot = part_slot(p.ws, 3);
    const int r = blockIdx.x * 8 + wid;
    if (r < TS) {
        float* xr = p.out + O_YS + (size_t)r * 1024;
        const float rs = rsqrtf(wave_sum(slot[(size_t)TP * 16 + (size_t)r * 64 + lane]) * (1.f / 1024.f) + EPS);
#pragma unroll
        for (int j = 0; j < 4; ++j) { const f32x4 v = *(const f32x4*)(xr + lane * 4 + 256 * j); const f32x4 g = *(const f32x4*)(p.final_norm + lane * 4 + 256 * j); *(f32x4*)(xr + lane * 4 + 256 * j) = v * rs * g; }
    }
}

#define XB_TMO      128
#define XB_XCNT(j)  (256  + 64 * (j))
#define XB_XSUB(j)  (1280 + 64 * (j))
#define XB_XGEN(j)  (2304 + 64 * (j))
#define XB_TOP      3328
#define XB_TOPGEN   3392
#define XCD_BAR_WORDS 3456
#define XB_SPIN_CAP (1u << 18)
__device__ __forceinline__ unsigned xb_ld(unsigned* p)              { return __hip_atomic_load(p, __ATOMIC_RELAXED, __HIP_MEMORY_SCOPE_AGENT); }
__device__ __forceinline__ unsigned xb_add(unsigned* p, unsigned v) { return __hip_atomic_fetch_add(p, v, __ATOMIC_RELAXED, __HIP_MEMORY_SCOPE_AGENT); }
__device__ __forceinline__ unsigned xb_xcc_id() { return (unsigned)__builtin_amdgcn_s_getreg((3 << 11) | 20) & 0xFu; }
#define XB_SPIN(cond, bar) do { unsigned _sp = 0; while (cond) { __builtin_amdgcn_s_sleep(1); \
    if ((++_sp & 255u) == 0u) { if (xb_ld(&(bar)[XB_TMO])) break; if (_sp > XB_SPIN_CAP) { atomicAdd(&(bar)[XB_TMO], 1u); break; } } } } while (0)
struct XcdBarrier { unsigned* bar; unsigned x; volatile LAS unsigned* st; };
__device__ __forceinline__ XcdBarrier xcd_barrier_post(unsigned* bar, volatile LAS unsigned* st) {
    XcdBarrier b; b.bar = bar; b.x = xb_xcc_id(); b.st = st;
    if (threadIdx.x == 0) (void)xb_add(&bar[XB_XCNT(b.x)], 1u);
    return b;
}
__device__ __forceinline__ void xcd_barrier_complete(unsigned* bar, unsigned x, unsigned& nloc, unsigned& nx) {
    const unsigned G = gridDim.x * gridDim.y * gridDim.z;
    unsigned sum, cnt, mine, sp = 0u;
    for (;;) {
        sum = 0u; cnt = 0u; mine = 0u;
#pragma unroll
        for (unsigned j = 0; j < 16; ++j) { const unsigned c = xb_ld(&bar[XB_XCNT(j)]); sum += c; cnt += (c > 0u) ? 1u : 0u; mine = (j == x) ? c : mine; }
        if (sum == G) break;
        __builtin_amdgcn_s_sleep(1);
        if ((++sp & 255u) == 0u) { if (xb_ld(&bar[XB_TMO])) break; if (sp > XB_SPIN_CAP) { atomicAdd(&bar[XB_TMO], 1u); break; } }
    }
    nloc = mine > 0u ? mine : 1u; nx = cnt > 0u ? cnt : 1u;
}
__device__ __forceinline__ void xcd_barrier(const XcdBarrier& b) {
    asm volatile("s_waitcnt vmcnt(0)" ::: "memory");
    __syncthreads();
    if (threadIdx.x == 0) {
        unsigned* bar = b.bar;
        __builtin_amdgcn_s_waitcnt(0);
        unsigned nloc = b.st[0], nx = b.st[1];
        if (nloc == 0u) { xcd_barrier_complete(bar, b.x, nloc, nx); b.st[0] = nloc; b.st[1] = nx; }
        const unsigned old = xb_add(&bar[XB_XSUB(b.x)], 1u);
        const unsigned gen = old / nloc;
        if (old + 1u == (gen + 1u) * nloc) {
            __builtin_amdgcn_fence(__ATOMIC_RELEASE, "agent");
            asm volatile("s_waitcnt vmcnt(0)" ::: "memory");
            const unsigned og = xb_add(&bar[XB_TOP], 1u);
            const unsigned tg = og / nx;
            if (og + 1u == (tg + 1u) * nx) xb_add(&bar[XB_TOPGEN], 1u);
            else XB_SPIN(xb_ld(&bar[XB_TOPGEN]) == tg, bar);
            __builtin_amdgcn_fence(__ATOMIC_ACQUIRE, "agent");
            xb_add(&bar[XB_XGEN(b.x)], 1u);
            asm volatile("s_waitcnt vmcnt(0)" ::: "memory");
        } else {
            XB_SPIN(xb_ld(&bar[XB_XGEN(b.x)]) == gen, bar);
            __builtin_amdgcn_fence(__ATOMIC_ACQUIRE, "agent");
            asm volatile("s_waitcnt vmcnt(0)" ::: "memory");
        }
    }
    __syncthreads();
}
#define PH_ON(n) ((PHMASK & (1 << (n))) && p.ph_lo <= (n) && (n) < p.ph_hi)
#define PH_SYNC(n) do { if (p.ph_lo < (n) && (n) < p.ph_hi) { xcd_barrier(xb); } } while (0)
__device__ __forceinline__ void ph_in(const Params& p, LAS unsigned char* lds) {
    unsigned char* ws = p.ws; pg8::StaticOrder S;
    EpiIn E{(bf16_t*)(ws + WS_Q), (bf16_t*)(ws + WS_V), (bf16_t*)(ws + WS_OG), (bf16_t*)(ws + WS_G), (const float*)(ws + WS_LB)};
    pg8::Gemm g{(const bf16_t*)(ws + WS_R2), (const bf16_t*)(ws + WS_WIN), TP, 4096, 1024, 1024, 0};
    S.init(g.M, g.N, gridDim.x, blockIdx.x); pg8::gemm_phase(lds, g, S, E);
    SIn F{E.Q, E.V, E.OG, E.G, (const float*)(ws + WS_LB)};
    sample_gemm<4>(lds, (const bf16_t*)(ws + WS_R2) + (size_t)TP * 1024, 1024, 0, (const bf16_t*)(ws + WS_WIN), 1024, F);
}
__device__ __forceinline__ void ph_rec1(const Params& p, LAS unsigned char* lds) {
    for (int it = blockIdx.x; it < 256; it += gridDim.x) { const int seg = it & 3, bh = it >> 2; rec_prompt(p, lds, bh >> 3, bh & 7, seg); }
}
__device__ __forceinline__ void ph_rec2(const Params& p, LAS unsigned char* lds) {
    for (int it = blockIdx.x; it < 256; it += gridDim.x) { const int seg = it & 3, bh = it >> 2; if (seg > 0) rec_fix(p, lds, bh >> 3, bh & 7, seg); }
    if (gridDim.x == 256) {
        const int seg = blockIdx.x & 3, bh = blockIdx.x >> 2;
        if (seg == 0) rec_sample_list(p, lds, bh * 10, 1, 10);
        else { const int k = bh * 3 + (seg - 1); rec_sample_list(p, lds, 640 + k, 192, 2); }
    } else rec_sample_list(p, lds, blockIdx.x, gridDim.x, (TS * 8 - (int)blockIdx.x + (int)gridDim.x - 1) / (int)gridDim.x);
}
__device__ __forceinline__ void ph_out(const Params& p, LAS unsigned char* lds, bool dummy = false) {
    unsigned char* ws = p.ws; pg8::StaticOrder S; float* slot = dummy ? (float*)nullptr : part_slot(ws, 0);
    EpiRes<false, false> E{p.x_prompt, nullptr, nullptr, (bf16_t*)(ws + WS_XB), nullptr, slot};
    pg8::Gemm g{(const bf16_t*)(ws + WS_R2), (const bf16_t*)(ws + WS_WOUT), TP, 1024, 1024, 1024, 0};
    S.init(g.M, g.N, gridDim.x, blockIdx.x); pg8::gemm_phase(lds, g, S, E);
    SRes F{p.x_sample, p.out + O_YS, (bf16_t*)(ws + WS_XB) + (size_t)TP * 1024, nullptr, dummy ? (float*)nullptr : slot + (size_t)TP * 16};
    sample_gemm<1>(lds, (const bf16_t*)(ws + WS_R2) + (size_t)TP * 1024, 1024, 0, (const bf16_t*)(ws + WS_WOUT), 1024, F);
}
__device__ __forceinline__ void ph_up(const Params& p, LAS unsigned char* lds, int L) {
    unsigned char* ws = p.ws; pg8::StaticOrder S; float* sq = part_slot(ws, L ? 2 : 0);
    const bf16_t* W = (const bf16_t*)(ws + (L ? WS_WUP1 : WS_WUP0));
    EpiUp E{(bf16_t*)(ws + WS_H), sq};
    pg8::Gemm g{(const bf16_t*)(ws + WS_XB), W, TP, 4096, 1024, 1024, 0};
    S.init(g.M, g.N, gridDim.x, blockIdx.x); pg8::gemm_phase(lds, g, S, E);
    SUp F{(bf16_t*)(ws + WS_H) + (size_t)TP * 4096, sq + (size_t)TP * 16};
    sample_gemm<4>(lds, (const bf16_t*)(ws + WS_XB) + (size_t)TP * 1024, 1024, 0, W, 1024, F);
}
__device__ __forceinline__ void ph_down(const Params& p, LAS unsigned char* lds, int L) {
    unsigned char* ws = p.ws; pg8::StaticOrder S; float* sq = part_slot(ws, L ? 3 : 1);
    const bf16_t* W = (const bf16_t*)(ws + (L ? WS_WDN1 : WS_WDN0));
    pg8::Gemm g{(const bf16_t*)(ws + WS_H), W, TP, 1024, 4096, 4096, 0};
    S.init(g.M, g.N, gridDim.x, blockIdx.x);
    if (L == 0) { EpiRes<true, false> E{nullptr, (const bf16_t*)(ws + WS_XB), nullptr, (bf16_t*)(ws + WS_XB), nullptr, sq}; pg8::gemm_phase(lds, g, S, E); }
    else { EpiFinal E{(const bf16_t*)(ws + WS_XB), p.out, p.final_norm, sq, (unsigned*)(ws + WS_BAR) + XCD_BAR_WORDS}; pg8::gemm_phase(lds, g, S, E); }
    SRes F{p.out + O_YS, p.out + O_YS, nullptr, nullptr, sq + (size_t)TP * 16};
    sample_gemm<1>(lds, (const bf16_t*)(ws + WS_H) + (size_t)TP * 4096, 4096, 0, W, 4096, F);
}
__device__ __forceinline__ void ph_poolg(const Params& p, LAS unsigned char* lds) {
    unsigned char* ws = p.ws; pg8::StaticOrder S; float* sq = part_slot(ws, 2);
    EpiRes<true, false> E{nullptr, (const bf16_t*)(ws + WS_XB), nullptr, (bf16_t*)(ws + WS_XB), p.pool_scale, sq};
    pg8::Gemm g{(const bf16_t*)(ws + WS_R2), (const bf16_t*)(ws + WS_WP), TP, 1024, 256, 1024, 256};
    S.init(g.M, g.N, gridDim.x, blockIdx.x); pg8::gemm_phase(lds, g, S, E);
    SRes F{p.out + O_YS, p.out + O_YS, (bf16_t*)(ws + WS_XB) + (size_t)TP * 1024, p.pool_scale, sq + (size_t)TP * 16};
    sample_gemm<1>(lds, (const bf16_t*)(ws + WS_R2) + (size_t)TP * 1024, 1024, 256, (const bf16_t*)(ws + WS_WP), 256, F);
}
__global__ void __launch_bounds__(512, 2) mega(Params p) {
    extern __shared__ __attribute__((aligned(16))) unsigned char shm[];
    LAS unsigned char* lds = (LAS unsigned char*)shm;
    volatile LAS unsigned* xst = (volatile LAS unsigned*)(lds + 151552);
    if (threadIdx.x == 0) { xst[0] = 0u; xst[1] = 0u; }
    __syncthreads();
    const XcdBarrier xb = xcd_barrier_post((unsigned*)(p.ws + WS_BAR), xst);
    if (p.ph_hi > 4096) cg::this_grid().sync();
    phase_prep(p, lds);
    if (DUP_PHASE == 0) { xcd_barrier(xb); phase_prep(p, lds); }
    if (DUP_PHASE == 20) { for (int i = 0; i < 20; ++i) xcd_barrier(xb); }
    xcd_barrier(xb); ph_in(p, lds);
    if (DUP_PHASE == 1) { xcd_barrier(xb); ph_in(p, lds); }
    xcd_barrier(xb); ph_rec1(p, lds);
    if (DUP_PHASE == 2) { xcd_barrier(xb); ph_rec1(p, lds); }
    xcd_barrier(xb); ph_rec2(p, lds);
    xcd_barrier(xb); ph_out(p, lds);
    if (DUP_PHASE == 3) { xcd_barrier(xb); ph_out(p, lds); }
    xcd_barrier(xb); ph_up(p, lds, 0);
    if (DUP_PHASE == 4) { xcd_barrier(xb); ph_up(p, lds, 0); }
    xcd_barrier(xb); ph_down(p, lds, 0);
    xcd_barrier(xb); phase_pool(p, lds);
    if (DUP_PHASE == 6) { xcd_barrier(xb); phase_pool(p, lds); }
    xcd_barrier(xb); ph_poolg(p, lds);
    xcd_barrier(xb); ph_up(p, lds, 1);
    xcd_barrier(xb); ph_down(p, lds, 1);
    if (DUP_PHASE == 9) { xcd_barrier(xb); ph_down(p, lds, 1); }
    xcd_barrier(xb);
    phase_final(p);
}

extern "C" void kernel_launch(void* const* d_in, const int* in_sizes, int n_in, void* d_out, int out_size, void* d_ws, size_t ws_size, hipStream_t stream) {
    static int grid = 0;
    if (grid == 0) {
        int dev = 0, cus = 0, per_cu = 0;
        hipGetDevice(&dev);
        hipDeviceGetAttribute(&cus, hipDeviceAttributeMultiprocessorCount, dev);
        if (hipFuncSetAttribute((const void*)mega, hipFuncAttributeMaxDynamicSharedMemorySize, LDS_BYTES) != hipSuccess) fprintf(stderr, "kernel_launch: hipFuncSetAttribute failed\n");
        if (hipOccupancyMaxActiveBlocksPerMultiprocessor(&per_cu, (const void*)mega, 512, LDS_BYTES) != hipSuccess || per_cu < 1) { fprintf(stderr, "kernel_launch: occupancy query gave %d\n", per_cu); per_cu = 1; }
        (void)hipGetLastError();
        grid = cus * per_cu;
        if (ws_size < WS_END3) fprintf(stderr, "kernel_launch: workspace too small: %zu < %zu\n", ws_size, (size_t)WS_END3);
        fprintf(stderr, "kernel_launch: grid %d (cus %d x %d), ws %zu\n", grid, cus, per_cu, ws_size);
    }
    Params p{};
    const float** pp = (const float**)&p;
    for (int i = 0; i < 16; ++i) pp[i] = (const float*)d_in[i];
    p.out = (float*)d_out; p.ws = (unsigned char*)d_ws;
    (void)hipMemsetAsync((unsigned char*)d_ws + WS_BAR, 0, 16384, stream);
    p.ph_lo = 0; p.ph_hi = NPHASE;
    void* args[] = {&p};
    hipError_t e = hipLaunchCooperativeKernel((const void*)mega, dim3(grid), dim3(512), args, LDS_BYTES, stream);
    if (e != hipSuccess) fprintf(stderr, "cooperative launch failed: %s (grid %d)\n", hipGetErrorString(e), grid);
}
```

```cpp
#include <hip/hip_runtime.h>
#include <hip/hip_cooperative_groups.h>
#include <cstdio>
namespace cg = cooperative_groups;

#define LAS __attribute__((address_space(3)))
typedef unsigned short bf16_t;
typedef short bf16x8 __attribute__((ext_vector_type(8)));
typedef float f32x4 __attribute__((ext_vector_type(4)));
typedef float f32x2 __attribute__((ext_vector_type(2)));
typedef unsigned u32x4 __attribute__((ext_vector_type(4)));
typedef unsigned u32x2 __attribute__((ext_vector_type(2)));

#ifndef PHMASK
#define PHMASK 0x7ff
#endif
#ifndef DUP_PHASE
#define DUP_PHASE -1
#endif
#ifndef EXTRA_SYNCS
#define EXTRA_SYNCS 0
#endif
#ifndef MK_LAUNCHES
#define MK_LAUNCHES 1
#endif

constexpr int D = 1024, TP = 16384, TS = 128, MP = TP + TS, FF = 4096, SEQ = 2048;
constexpr float EPS = 1e-6f;
constexpr int NPHASE = 11;
constexpr int LDS_BYTES = 151552 + 16;

constexpr size_t WS_WIN = 0;
constexpr size_t WS_WOUT = WS_WIN + (size_t)4096 * 1024 * 2;
constexpr size_t WS_WUP0 = WS_WOUT + (size_t)1024 * 1024 * 2;
constexpr size_t WS_WDN0 = WS_WUP0 + (size_t)4096 * 1024 * 2;
constexpr size_t WS_WP = WS_WDN0 + (size_t)4096 * 1024 * 2;
constexpr size_t WS_WUP1 = WS_WP + (size_t)1024 * 256 * 2;
constexpr size_t WS_WDN1 = WS_WUP1 + (size_t)4096 * 1024 * 2;
constexpr size_t WS_SSQ = WS_WDN1 + (size_t)4096 * 1024 * 2;
constexpr size_t WS_LB = WS_SSQ + 264192;
constexpr size_t WS_BAR = WS_SSQ + 268288;
constexpr size_t WS_R2 = WS_SSQ + 284672;
constexpr size_t ACT_B = (size_t)MP * 1024 * 2;
constexpr size_t WS_R1 = WS_R2 + ACT_B;
constexpr size_t WS_Q = WS_R1, WS_V = WS_R1 + ACT_B, WS_OG = WS_R1 + 2 * ACT_B, WS_G = WS_R1 + 3 * ACT_B;
constexpr size_t WS_H = WS_R1;
constexpr size_t WS_XB = WS_R1 + (size_t)MP * 4096 * 2;
constexpr size_t WS_END = WS_R1 + 5 * ACT_B;
constexpr size_t WS_PART = WS_END;
constexpr size_t PART_SLOT = (size_t)TP * 16 * 4 + (size_t)TS * 64 * 4;
constexpr size_t WS_END2 = WS_PART + 4 * PART_SLOT;
constexpr size_t WS_LSEG = WS_END2;
constexpr size_t WS_END3 = WS_LSEG + (size_t)64 * 3 * 16384 * 4;
constexpr size_t WS_DSEG = WS_SSQ;

constexpr size_t O_YP = 0, O_YS = 16777216, O_HP = 16908288, O_HS = 17956864, O_PP = 34734080, O_PS = 34856960;

struct Params {
    const float *x_prompt, *x_sample, *state_hgrn, *state_pool, *hgrn_norm, *hgrn_w_in, *hgrn_lb, *hgrn_onorm, *hgrn_w_out,
        *pool_norm, *pool_w, *pool_scale, *mlp_norm, *mlp_up, *mlp_down, *final_norm;
    float* out;
    unsigned char* ws;
    int ph_lo, ph_hi;
};

typedef __bf16 bf16x2_native __attribute__((ext_vector_type(2)));
__device__ __forceinline__ unsigned cvt_pk_bf16(float lo, float hi) { const f32x2 f = {lo, hi}; return __builtin_bit_cast(unsigned, __builtin_convertvector(f, bf16x2_native)); }
__device__ __forceinline__ float bf2f(bf16_t b) { return __uint_as_float(((unsigned)b) << 16); }
__device__ __forceinline__ float bflo(unsigned w) { return __uint_as_float(w << 16); }
__device__ __forceinline__ float bfhi(unsigned w) { return __uint_as_float(w & 0xffff0000u); }
__device__ __forceinline__ bf16_t f2bf(float f) { return (bf16_t)(cvt_pk_bf16(f, 0.f) & 0xffffu); }
typedef _Float16 half2_t __attribute__((ext_vector_type(2)));
__device__ __forceinline__ unsigned cvt_pk_f16(float a, float b) { half2_t h = {(_Float16)a, (_Float16)b}; return __builtin_bit_cast(unsigned, h); }
__device__ __forceinline__ f32x2 h2_to_f2(unsigned w) { const half2_t h = __builtin_bit_cast(half2_t, w); return (f32x2){(float)h[0], (float)h[1]}; }
__device__ __forceinline__ float sigmoidf_(float x) { return __builtin_amdgcn_rcpf(1.f + __expf(-x)); }
__device__ __forceinline__ float wave_sum(float v) {
#pragma unroll
    for (int o = 1; o < 64; o <<= 1) v += __shfl_xor(v, o);
    return v;
}
__device__ __forceinline__ float ein_elem(int type, float x, float lbc) {
    if (type == 0) return x * sigmoidf_(x) * 0.08838834764831845f;
    if (type == 1) return __builtin_amdgcn_logf(lbc + (1.f - lbc) * sigmoidf_(x)) * 0.6931471805599453f;
    if (type == 2) return x;
    return sigmoidf_(x);
}
__device__ __forceinline__ float lb_of(const float* lb, int c) { return 1.f / (1.f + __expf(lb[1024 + c] - lb[c])); }

namespace pg8 {
constexpr int BM = 256, BK = 64, HALF = 128, HTB = HALF * BK * 2, STAGE_BYTES = 8 * HTB, NXCD = 8, WGM = 4;
__host__ __device__ __forceinline__ int lds_byte(int r, int c) { const int st = (r >> 4) * 2 + (c >> 5), rr = r & 15, cc = c & 31, ob = rr * 64 + cc * 2; return st * 1024 + (ob ^ (((ob >> 9) & 1) << 5)); }
__host__ __device__ __forceinline__ void stage_rc(int b, int& R, int& C) { const int st = b / 1024, sb = b % 1024, swz = sb ^ (((sb >> 9) & 1) << 5); R = (st >> 1) * 16 + swz / 64; C = (st & 1) * 32 + (swz % 64) / 2; }
__host__ __device__ __forceinline__ int perm32(int rho) { const int n = rho >> 4, i = rho & 15; return 8 * (i >> 2) + 4 * n + (i & 3); }
struct Unit { int pm, pn; };
struct Gemm { const bf16_t* A; const bf16_t* Bt; int M, N, K, lda, agroup; };
struct StaticOrder {
    int nM, nN, nwg, G, c, wgm;
    __device__ void init(int M, int N, int G_, int c_) { nM = M / BM; nN = N / BM; nwg = nM * nN; G = G_; c = c_; wgm = nN >= 16 ? 4 : 8; }
    __device__ bool next(int i, Unit& u) const {
        const long L = (long)i * G + c; if (L >= nwg) return false;
        int wgid = (int)L; { const int q = nwg / NXCD, r = nwg % NXCD, xcd = wgid % NXCD, off = wgid / NXCD; wgid = (xcd < r ? xcd * (q + 1) : r * (q + 1) + (xcd - r) * q) + off; }
        const int nig = wgm * nN, gid = wgid / nig, fm = gid * wgm, gsz = (nM - fm) < wgm ? (nM - fm) : wgm;
        u.pm = fm + ((wgid % nig) % gsz); u.pn = (wgid % nig) / gsz; return true;
    }
};

template <class Epi>
__device__ __forceinline__ void gemm_phase(LAS unsigned char* lds, const Gemm g, const StaticOrder& S, const Epi& E) {
    int tid_ = threadIdx.x; asm volatile("" : "+v"(tid_));
    const int tid = tid_, wid = __builtin_amdgcn_readfirstlane(tid >> 6), lane = tid & 63, wr = wid >> 2, wc = wid & 3, fr = lane & 15, fq = lane >> 4;
    const int K = g.K, nt = K / BK, lda = g.lda;
    unsigned voffA[2], voffB[2];
#pragma unroll
    for (int i = 0; i < 2; ++i) { int R, C; stage_rc(tid * 16 + i * 8192, R, C); const int Rb = (R & ~31) + perm32(R & 31);
        voffA[i] = (unsigned)(R * lda + C) * 2u; voffB[i] = (unsigned)(Rb * K + C) * 2u; }
    const size_t kstep = (size_t)(BK * 2);
    const size_t hstepA = (size_t)HALF * lda * 2, hstepB = (size_t)HALF * K * 2;
    const size_t tstepA = 2 * hstepA, tstepB = 2 * hstepB;
    const unsigned ldsw = (unsigned)wid * 1024u;
    const int aoff = lds_byte(wr * 64 + fr, fq * 8), boff = lds_byte(wc * 32 + fr, fq * 8);
#define PG8_SA(b, h) (((b) * 2 + (h)) * HTB)
#define PG8_SB(b, h) ((4 + (b) * 2 + (h)) * HTB)
#define PG8_STAGE(bufoff, gbase, voff) do { _Pragma("unroll") for (int _i = 0; _i < 2; ++_i) \
        __builtin_amdgcn_global_load_lds((const unsigned*)((const char*)(gbase) + (voff)[_i]), (LAS unsigned*)(lds + (bufoff) + ldsw + _i * 8192), 16, 0, 0); } while (0)
#define PG8_LDA(dst, b, h) do { _Pragma("unroll") for (int m = 0; m < 4; ++m) _Pragma("unroll") for (int k = 0; k < 2; ++k) dst[m][k] = *(const LAS bf16x8*)(lds + PG8_SA(b, h) + aoff + m * 2048 + k * 1024); } while (0)
#define PG8_LDB(dst, b, h) do { _Pragma("unroll") for (int n = 0; n < 2; ++n) _Pragma("unroll") for (int k = 0; k < 2; ++k) dst[n][k] = *(const LAS bf16x8*)(lds + PG8_SB(b, h) + boff + n * 2048 + k * 1024); } while (0)
#define PG8_MMA(ai, bj, At, Bt) do { __builtin_amdgcn_s_setprio(1); _Pragma("unroll") for (int m = 0; m < 4; ++m) _Pragma("unroll") for (int n = 0; n < 2; ++n) _Pragma("unroll") for (int k = 0; k < 2; ++k) \
        acc[ai][bj][m][n] = __builtin_amdgcn_mfma_f32_16x16x32_bf16(Bt[n][k], At[m][k], acc[ai][bj][m][n], 0, 0, 0); __builtin_amdgcn_s_setprio(0); } while (0)
#define PG8_WAIT_V(n) asm volatile("s_waitcnt vmcnt(" #n ")" ::: "memory")
#define PG8_WAIT_L(n) asm volatile("s_waitcnt lgkmcnt(" #n ")" ::: "memory")
#define PG8_BAR __builtin_amdgcn_s_barrier()
#define PG8_SCHED __builtin_amdgcn_sched_barrier(0)
    Unit cur, nxt; int ui = 0;
    if (!S.next(0, cur)) return;
    f32x4 acc[2][2][4][2];
#pragma unroll
    for (int a = 0; a < 2; ++a)
#pragma unroll
        for (int b = 0; b < 2; ++b)
#pragma unroll
            for (int m = 0; m < 4; ++m)
#pragma unroll
                for (int n = 0; n < 2; ++n) acc[a][b][m][n] = (f32x4){0.f, 0.f, 0.f, 0.f};
    bf16x8 At[4][2], B0[2][2], B1[2][2];
    const char* cA = (const char*)g.A + (size_t)cur.pm * tstepA + (size_t)cur.pn * g.agroup * 2; const char* cB = (const char*)g.Bt + (size_t)cur.pn * tstepB;
    PG8_STAGE(PG8_SB(0, 0), cB, voffB); PG8_STAGE(PG8_SA(0, 0), cA, voffA); PG8_STAGE(PG8_SB(0, 1), cB + hstepB, voffB); PG8_STAGE(PG8_SA(0, 1), cA + hstepA, voffA);
    if (wr == 1) PG8_BAR;
    PG8_WAIT_V(4); PG8_BAR;
    PG8_STAGE(PG8_SB(1, 0), cB + kstep, voffB); PG8_STAGE(PG8_SA(1, 0), cA + kstep, voffA); PG8_STAGE(PG8_SB(1, 1), cB + hstepB + kstep, voffB);
    PG8_WAIT_V(6); PG8_BAR;
    for (;;) {
        const bool has_next = S.next(ui + 1, nxt);
        const char* nA = has_next ? (const char*)g.A + (size_t)nxt.pm * tstepA + (size_t)nxt.pn * g.agroup * 2 : cA; const char* nB = has_next ? (const char*)g.Bt + (size_t)nxt.pn * tstepB : cB;
        for (int t = 0; t < nt; t += 2) {
            const bool last = (t == nt - 2);
            const char* a1 = cA + (size_t)(t + 1) * kstep;
            const char* a2 = last ? nA : cA + (size_t)(t + 2) * kstep; const char* b2 = last ? nB : cB + (size_t)(t + 2) * kstep;
            const char* a3 = a2 + kstep; const char* b3 = b2 + kstep;
            PG8_LDB(B0, 0, 0); PG8_SCHED; PG8_LDA(At, 0, 0); PG8_STAGE(PG8_SA(1, 1), a1 + hstepA, voffA);
            PG8_WAIT_L(8); PG8_BAR; PG8_WAIT_L(0); PG8_MMA(0, 0, At, B0); PG8_BAR; PG8_SCHED;
            PG8_LDB(B1, 0, 1); PG8_STAGE(PG8_SB(0, 0), b2, voffB);
            PG8_BAR; PG8_WAIT_L(0); PG8_MMA(0, 1, At, B1); PG8_BAR;
            PG8_LDA(At, 0, 1); PG8_STAGE(PG8_SA(0, 0), a2, voffA);
            PG8_BAR; PG8_WAIT_L(0); PG8_MMA(1, 0, At, B0); PG8_BAR; PG8_SCHED;
            PG8_STAGE(PG8_SB(0, 1), b2 + hstepB, voffB);
            PG8_WAIT_V(6); PG8_BAR; PG8_MMA(1, 1, At, B1); PG8_BAR;
            PG8_LDB(B0, 1, 0); PG8_SCHED; PG8_LDA(At, 1, 0); PG8_STAGE(PG8_SA(0, 1), a2 + hstepA, voffA);
            PG8_WAIT_L(8); PG8_BAR; PG8_WAIT_L(0); PG8_MMA(0, 0, At, B0); PG8_BAR; PG8_SCHED;
            PG8_LDB(B1, 1, 1); PG8_STAGE(PG8_SB(1, 0), b3, voffB);
            PG8_BAR; PG8_WAIT_L(0); PG8_MMA(0, 1, At, B1); PG8_BAR;
            PG8_LDA(At, 1, 1); PG8_STAGE(PG8_SA(1, 0), a3, voffA);
            PG8_BAR; PG8_WAIT_L(0); PG8_MMA(1, 0, At, B0); PG8_BAR; PG8_SCHED;
            PG8_STAGE(PG8_SB(1, 1), b3 + hstepB, voffB);
            PG8_WAIT_V(6); PG8_BAR; PG8_MMA(1, 1, At, B1); PG8_BAR;
        }
        if constexpr (!Epi::AFTER_DRAIN) E(acc, cur, wr, wc, fr, fq);
        if (!has_next) break;
#pragma unroll
        for (int a = 0; a < 2; ++a)
#pragma unroll
            for (int b = 0; b < 2; ++b)
#pragma unroll
                for (int m = 0; m < 4; ++m)
#pragma unroll
                    for (int n = 0; n < 2; ++n) acc[a][b][m][n] = (f32x4){0.f, 0.f, 0.f, 0.f};
        cur = nxt; cA = nA; cB = nB; ++ui;
    }
    PG8_WAIT_V(0);
    if (wr == 0) PG8_BAR;
    PG8_BAR;
    if constexpr (Epi::AFTER_DRAIN) E.fused(acc, cur, wr, wc, fr, fq, lds);
#undef PG8_SA
#undef PG8_SB
#undef PG8_STAGE
#undef PG8_LDA
#undef PG8_LDB
#undef PG8_MMA
#undef PG8_WAIT_V
#undef PG8_WAIT_L
#undef PG8_BAR
#undef PG8_SCHED
}
}

struct EpiIn {
    static constexpr bool AFTER_DRAIN = false;
    bf16_t *Q, *V, *OG; bf16_t* G; const float* lb;
    __device__ __forceinline__ void operator()(const f32x4 (&acc)[2][2][4][2], const pg8::Unit& u, int wr, int wc, int fr, int fq) const {
        const int sblk = u.pn >> 2, type = sblk == 2 ? 3 : (sblk == 3 ? 2 : sblk);
        const int row0 = u.pm * 256 + wr * 64 + fr, col0 = (u.pn & 3) * 256 + wc * 32 + 8 * fq;
        if (type == 1) {
            f32x4 lbv[2][2];
#pragma unroll
            for (int bj = 0; bj < 2; ++bj) { lbv[bj][0] = *(const f32x4*)(lb + col0 + bj * 128); lbv[bj][1] = *(const f32x4*)(lb + col0 + bj * 128 + 4); }
#pragma unroll
            for (int ai = 0; ai < 2; ++ai)
#pragma unroll
                for (int m = 0; m < 4; ++m) { bf16_t* rowp = G + (size_t)(row0 + ai * 128 + m * 16) * 1024 + col0;
#pragma unroll
                    for (int bj = 0; bj < 2; ++bj) { f32x4 o0, o1; const f32x4 l0 = lbv[bj][0], l1 = lbv[bj][1];
#pragma unroll
                        for (int e = 0; e < 4; ++e) { o0[e] = ein_elem(1, acc[ai][bj][m][0][e], l0[e]); o1[e] = ein_elem(1, acc[ai][bj][m][1][e], l1[e]); }
                        u32x4 w; w.x = cvt_pk_f16(o0[0], o0[1]); w.y = cvt_pk_f16(o0[2], o0[3]); w.z = cvt_pk_f16(o1[0], o1[1]); w.w = cvt_pk_f16(o1[2], o1[3]);
                        *(u32x4*)(rowp + bj * 128) = w; }
                    asm volatile("" ::: "memory"); }
        } else {
            bf16_t* base = Q + (size_t)(type == 0 ? 0 : type - 1) * (ACT_B / 2);
            if (type == 0) store_bf16<0>(acc, base, row0, col0);
            else if (type == 2) store_bf16<2>(acc, base, row0, col0);
            else store_bf16<3>(acc, base, row0, col0);
        }
    }
    template <int TYPE> __device__ __forceinline__ void store_bf16(const f32x4 (&acc)[2][2][4][2], bf16_t* base, int row0, int col0) const {
#pragma unroll
        for (int ai = 0; ai < 2; ++ai)
#pragma unroll
            for (int m = 0; m < 4; ++m) { bf16_t* rowp = base + (size_t)(row0 + ai * 128 + m * 16) * 1024 + col0;
#pragma unroll
                for (int bj = 0; bj < 2; ++bj) { f32x4 o0, o1;
#pragma unroll
                    for (int e = 0; e < 4; ++e) { o0[e] = ein_elem(TYPE, acc[ai][bj][m][0][e], 0.f); o1[e] = ein_elem(TYPE, acc[ai][bj][m][1][e], 0.f); }
                    u32x4 w; w.x = cvt_pk_bf16(o0[0], o0[1]); w.y = cvt_pk_bf16(o0[2], o0[3]); w.z = cvt_pk_bf16(o1[0], o1[1]); w.w = cvt_pk_bf16(o1[2], o1[3]);
                    *(u32x4*)(rowp + bj * 128) = w; }
                asm volatile("" ::: "memory"); }
    }
};
template <bool IN16, bool OUT32> struct EpiRes {
    static constexpr bool AFTER_DRAIN = false;
    const float* Xin32; const bf16_t* Xin16; float* Xout32; bf16_t* Xb; const float* scale; float* part;
    __device__ __forceinline__ void operator()(const f32x4 (&acc)[2][2][4][2], const pg8::Unit& u, int wr, int wc, int fr, int fq) const {
        const int row0 = u.pm * 256 + wr * 64 + fr, col0 = u.pn * 256 + wc * 32 + 8 * fq;
        constexpr int NB = 2;
        f32x4 sc[2][2];
#pragma unroll
        for (int bj = 0; bj < 2; ++bj) { sc[bj][0] = scale ? *(const f32x4*)(scale + col0 + bj * 128) : (f32x4){1.f, 1.f, 1.f, 1.f}; sc[bj][1] = scale ? *(const f32x4*)(scale + col0 + bj * 128 + 4) : (f32x4){1.f, 1.f, 1.f, 1.f}; }
        constexpr int AIB = 2 / NB;
#pragma unroll
        for (int bt = 0; bt < NB; ++bt) {
            f32x4 xr[AIB][4][2][IN16 ? 1 : 2];
#pragma unroll
            for (int a2 = 0; a2 < AIB; ++a2)
#pragma unroll
                for (int m = 0; m < 4; ++m) { const int ai = bt * AIB + a2; const size_t off = (size_t)(row0 + ai * 128 + m * 16) * 1024 + col0;
#pragma unroll
                    for (int bj = 0; bj < 2; ++bj) {
                        if (IN16) xr[a2][m][bj][0] = __builtin_bit_cast(f32x4, *(const u32x4*)(Xin16 + off + bj * 128));
                        else { xr[a2][m][bj][0] = *(const f32x4*)(Xin32 + off + bj * 128); xr[a2][m][bj][IN16 ? 0 : 1] = *(const f32x4*)(Xin32 + off + bj * 128 + 4); } } }
#pragma unroll
            for (int a2 = 0; a2 < AIB; ++a2)
#pragma unroll
                for (int m = 0; m < 4; ++m) { const int ai = bt * AIB + a2; const int row = row0 + ai * 128 + m * 16; const size_t off = (size_t)row * 1024 + col0; float ss = 0.f;
#pragma unroll
                    for (int bj = 0; bj < 2; ++bj) {
                        const f32x4 a0 = acc[ai][bj][m][0] * sc[bj][0], a1 = acc[ai][bj][m][1] * sc[bj][1];
                        f32x4 x0, x1;
                        if (IN16) { const u32x4 w = __builtin_bit_cast(u32x4, xr[a2][m][bj][0]); x0 = (f32x4){bflo(w.x), bfhi(w.x), bflo(w.y), bfhi(w.y)}; x1 = (f32x4){bflo(w.z), bfhi(w.z), bflo(w.w), bfhi(w.w)}; }
                        else { x0 = xr[a2][m][bj][0]; x1 = xr[a2][m][bj][IN16 ? 0 : 1]; }
                        x0 = x0 + a0; x1 = x1 + a1;
                        if (OUT32) { *(f32x4*)(Xout32 + off + bj * 128) = x0; *(f32x4*)(Xout32 + off + bj * 128 + 4) = x1; }
                        if (Xb) { u32x4 w; w.x = cvt_pk_bf16(x0[0], x0[1]); w.y = cvt_pk_bf16(x0[2], x0[3]); w.z = cvt_pk_bf16(x1[0], x1[1]); w.w = cvt_pk_bf16(x1[2], x1[3]); *(u32x4*)(Xb + off + bj * 128) = w; }
                        ss += x0[0] * x0[0] + x0[1] * x0[1] + x0[2] * x0[2] + x0[3] * x0[3] + x1[0] * x1[0] + x1[1] * x1[1] + x1[2] * x1[2] + x1[3] * x1[3]; }
                    ss += __shfl_xor(ss, 16); ss += __shfl_xor(ss, 32);
                    if (fq == 0 && part) part[(size_t)row * 16 + u.pn * 4 + wc] = ss; }
            asm volatile("" ::: "memory"); }
    }
};
struct EpiFinal {
    static constexpr bool AFTER_DRAIN = true;
    const bf16_t* Xin16; float* Y; const float* gfin; float* part; unsigned* cnt;
    __device__ __forceinline__ void fused(f32x4 (&acc)[2][2][4][2], const pg8::Unit& u, int wr, int wc, int fr, int fq, LAS unsigned char* lds) const {
        const int row0 = u.pm * 256 + wr * 64 + fr, col0 = u.pn * 256 + wc * 32 + 8 * fq;
        u32x4 xr[2][4][2];
#pragma unroll
        for (int ai = 0; ai < 2; ++ai)
#pragma unroll
            for (int m = 0; m < 4; ++m) { const size_t off = (size_t)(row0 + ai * 128 + m * 16) * 1024 + col0;
#pragma unroll
                for (int bj = 0; bj < 2; ++bj) xr[ai][m][bj] = *(const u32x4*)(Xin16 + off + bj * 128); }
#pragma unroll
        for (int ai = 0; ai < 2; ++ai) {
#pragma unroll
            for (int m = 0; m < 4; ++m) { const int row = row0 + ai * 128 + m * 16; float ss = 0.f;
#pragma unroll
                for (int bj = 0; bj < 2; ++bj) { const u32x4 w = xr[ai][m][bj];
                    const f32x4 x0 = (f32x4){bflo(w.x), bfhi(w.x), bflo(w.y), bfhi(w.y)} + acc[ai][bj][m][0], x1 = (f32x4){bflo(w.z), bfhi(w.z), bflo(w.w), bfhi(w.w)} + acc[ai][bj][m][1];
                    acc[ai][bj][m][0] = x0; acc[ai][bj][m][1] = x1;
                    ss += x0[0] * x0[0] + x0[1] * x0[1] + x0[2] * x0[2] + x0[3] * x0[3] + x1[0] * x1[0] + x1[1] * x1[1] + x1[2] * x1[2] + x1[3] * x1[3]; }
                ss += __shfl_xor(ss, 16); ss += __shfl_xor(ss, 32);
                if (fq == 0) __hip_atomic_store(part + (size_t)row * 16 + u.pn * 4 + wc, ss, __ATOMIC_RELAXED, __HIP_MEMORY_SCOPE_AGENT); }
            asm volatile("" ::: "memory"); }
        asm volatile("s_waitcnt vmcnt(0)" ::: "memory");
        __syncthreads();
        if (threadIdx.x == 0) {
            __hip_atomic_fetch_add(cnt + u.pm, 1u, __ATOMIC_RELAXED, __HIP_MEMORY_SCOPE_AGENT);
            unsigned sp = 0;
            while (__hip_atomic_load(cnt + u.pm, __ATOMIC_RELAXED, __HIP_MEMORY_SCOPE_AGENT) < 4u) { __builtin_amdgcn_s_sleep(1); if (++sp > (1u << 20)) break; }
        }
        __syncthreads();
        LAS float* rsl = (LAS float*)lds;
        if (threadIdx.x < 256) { const float* pr = part + (size_t)(u.pm * 256 + threadIdx.x) * 16; float sq = 0.f;
#pragma unroll
            for (int i = 0; i < 16; ++i) sq += __hip_atomic_load(pr + i, __ATOMIC_RELAXED, __HIP_MEMORY_SCOPE_AGENT);
            rsl[threadIdx.x] = rsqrtf(sq * (1.f / 1024.f) + EPS); }
        __syncthreads();
#pragma unroll
        for (int ai = 0; ai < 2; ++ai)
#pragma unroll
            for (int m = 0; m < 4; ++m) { const int rl = ai * 128 + wr * 64 + m * 16 + fr; const float rs = rsl[rl]; float* yp = Y + (size_t)(u.pm * 256 + rl) * 1024 + col0;
#pragma unroll
                for (int bj = 0; bj < 2; ++bj) { const f32x4 g0 = *(const f32x4*)(gfin + col0 + bj * 128), g1 = *(const f32x4*)(gfin + col0 + bj * 128 + 4);
                    __builtin_nontemporal_store(acc[ai][bj][m][0] * rs * g0, (f32x4*)(yp + bj * 128)); __builtin_nontemporal_store(acc[ai][bj][m][1] * rs * g1, (f32x4*)(yp + bj * 128 + 4)); } }
        __syncthreads();
    }
};
struct EpiNull { float* sink; static constexpr bool AFTER_DRAIN = false;
    __device__ __forceinline__ void operator()(const f32x4 (&acc)[2][2][4][2], const pg8::Unit& u, int wr, int wc, int fr, int fq) const {
        f32x4 t = (f32x4){0.f, 0.f, 0.f, 0.f};
#pragma unroll
        for (int a = 0; a < 2; ++a)
#pragma unroll
            for (int b = 0; b < 2; ++b)
#pragma unroll
                for (int m = 0; m < 4; ++m)
#pragma unroll
                    for (int n = 0; n < 2; ++n) t = t + acc[a][b][m][n];
        if (t[0] + t[1] + t[2] + t[3] == 12345.678f) sink[0] = 1.f; } };
struct SNull { float* sink; __device__ __forceinline__ void rowpart(int, int, float) const {}
    __device__ __forceinline__ float operator()(int r, int c, f32x4 v) const { if (v[0] + v[1] + v[2] + v[3] == 12345.678f) sink[0] = 1.f; return 0.f; } };
struct EpiUp {
    static constexpr bool AFTER_DRAIN = false;
    bf16_t* H; const float* part;
    __device__ __forceinline__ void operator()(const f32x4 (&acc)[2][2][4][2], const pg8::Unit& u, int wr, int wc, int fr, int fq) const {
        const int row0 = u.pm * 256 + wr * 64 + fr, col0 = u.pn * 256 + wc * 32 + 8 * fq;
        f32x4 pv[2][4]; float rs[2][4];
#pragma unroll
        for (int ai = 0; ai < 2; ++ai)
#pragma unroll
            for (int m = 0; m < 4; ++m) pv[ai][m] = *(const f32x4*)(part + (size_t)(row0 + ai * 128 + m * 16) * 16 + fq * 4);
#pragma unroll
        for (int ai = 0; ai < 2; ++ai)
#pragma unroll
            for (int m = 0; m < 4; ++m) { float sq = (pv[ai][m][0] + pv[ai][m][1]) + (pv[ai][m][2] + pv[ai][m][3]); sq += __shfl_xor(sq, 16); sq += __shfl_xor(sq, 32); rs[ai][m] = rsqrtf(sq * (1.f / 1024.f) + EPS); }
#pragma unroll
        for (int ai = 0; ai < 2; ++ai)
#pragma unroll
            for (int m = 0; m < 4; ++m) { const int row = row0 + ai * 128 + m * 16; const float r = rs[ai][m]; bf16_t* rowp = H + (size_t)row * 4096 + col0;
#pragma unroll
                for (int bj = 0; bj < 2; ++bj) { f32x4 o0, o1;
#pragma unroll
                    for (int e = 0; e < 4; ++e) { float a = fmaxf(acc[ai][bj][m][0][e] * r, 0.f), b2 = fmaxf(acc[ai][bj][m][1][e] * r, 0.f); o0[e] = a * a; o1[e] = b2 * b2; }
                    u32x4 w; w.x = cvt_pk_bf16(o0[0], o0[1]); w.y = cvt_pk_bf16(o0[2], o0[3]); w.z = cvt_pk_bf16(o1[0], o1[1]); w.w = cvt_pk_bf16(o1[2], o1[3]);
                    *(u32x4*)(rowp + bj * 128) = w; } }
    }
};

template <int NCT, class F>
__device__ __forceinline__ void sample_gemm(LAS unsigned char* lds, const bf16_t* A, int lda, int agroup, const bf16_t* Bt, int K, const F& f) {
    constexpr int CT = NCT * 16;
    const int tid = threadIdx.x, wid = tid >> 6, lane = tid & 63, fr = lane & 15, fq = lane >> 4;
    LAS float* red = (LAS float*)lds;
    for (int blk = blockIdx.x; blk < 256; blk += gridDim.x) {
        const int rb = blk & 3, cb = blk >> 2, r0 = rb * 32, c0 = cb * CT;
        const int Kw = K >> 3, kb = wid * Kw;
        const bf16_t* Ab = A + (size_t)(c0 >> 8) * agroup;
        f32x4 acc[2][NCT];
#pragma unroll
        for (int i = 0; i < 2; ++i)
#pragma unroll
            for (int j = 0; j < NCT; ++j) acc[i][j] = (f32x4){0.f, 0.f, 0.f, 0.f};
        constexpr int UN = NCT == 1 ? 8 : 2;
        for (int k = kb; k < kb + Kw; k += 32 * UN) {
            bf16x8 af[UN][2], bfr[UN][NCT];
#pragma unroll
            for (int uu = 0; uu < UN; ++uu) { const int ku = k + 32 * uu; const bool ok = ku < kb + Kw;
#pragma unroll
                for (int i = 0; i < 2; ++i) af[uu][i] = ok ? *(const bf16x8*)(Ab + (size_t)(r0 + i * 16 + fr) * lda + ku + fq * 8) : (bf16x8){0, 0, 0, 0, 0, 0, 0, 0};
#pragma unroll
                for (int j = 0; j < NCT; ++j) bfr[uu][j] = ok ? *(const bf16x8*)(Bt + (size_t)(c0 + j * 16 + fr) * K + ku + fq * 8) : (bf16x8){0, 0, 0, 0, 0, 0, 0, 0}; }
#pragma unroll
            for (int uu = 0; uu < UN; ++uu)
#pragma unroll
                for (int i = 0; i < 2; ++i)
#pragma unroll
                    for (int j = 0; j < NCT; ++j) acc[i][j] = __builtin_amdgcn_mfma_f32_16x16x32_bf16(bfr[uu][j], af[uu][i], acc[i][j], 0, 0, 0);
        }
#pragma unroll
        for (int i = 0; i < 2; ++i)
#pragma unroll
            for (int j = 0; j < NCT; ++j) *(LAS f32x4*)(red + ((size_t)wid * 32 + i * 16 + fr) * CT + j * 16 + fq * 4) = acc[i][j];
        __syncthreads();
        constexpr int NG = 32 * CT / 4;
        for (int i = tid; i < NG; i += 512) { const int row = i / (CT / 4), cgp = i % (CT / 4);
            f32x4 s = (f32x4){0.f, 0.f, 0.f, 0.f};
#pragma unroll
            for (int w = 0; w < 8; ++w) s = s + *(const LAS f32x4*)(red + ((size_t)w * 32 + row) * CT + cgp * 4);
            float ss = f(r0 + row, c0 + cgp * 4, s);
#pragma unroll
            for (int o = 1; o < CT / 4; o <<= 1) ss += __shfl_xor(ss, o);
            if (cgp == 0) f.rowpart(r0 + row, cb, ss); }
        __syncthreads();
    }
}
struct SIn { bf16_t *Q, *V, *OG; bf16_t* G; const float* lb;
    __device__ __forceinline__ void rowpart(int, int, float) const {}
    __device__ __forceinline__ float operator()(int r, int c, f32x4 v) const { const int sblk = c >> 10, type = sblk == 2 ? 3 : (sblk == 3 ? 2 : sblk), cc = c & 1023; const size_t off = (size_t)(TP + r) * 1024 + cc;
        if (type == 1) { f32x4 o;
#pragma unroll
            for (int e = 0; e < 4; ++e) o[e] = ein_elem(1, v[e], lb[cc + e]);
            u32x2 w; w.x = cvt_pk_f16(o[0], o[1]); w.y = cvt_pk_f16(o[2], o[3]); *(u32x2*)(G + off) = w; }
        else { bf16_t* base = Q + (size_t)(type == 0 ? 0 : type - 1) * (ACT_B / 2); f32x4 o;
            if (type == 0) {
#pragma unroll
                for (int e = 0; e < 4; ++e) o[e] = ein_elem(0, v[e], 0.f); }
            else if (type == 2) o = v;
            else {
#pragma unroll
                for (int e = 0; e < 4; ++e) o[e] = ein_elem(3, v[e], 0.f); }
            u32x2 w; w.x = cvt_pk_bf16(o[0], o[1]); w.y = cvt_pk_bf16(o[2], o[3]); *(u32x2*)(base + off) = w; } return 0.f; } };
struct SRes { const float* Xin; float* Xout; bf16_t* Xb; const float* scale; float* parts;
    __device__ __forceinline__ void rowpart(int r, int cb, float ss) const { if (parts) parts[r * 64 + cb] = ss; }
    __device__ __forceinline__ float operator()(int r, int c, f32x4 v) const { const size_t off = (size_t)r * 1024 + c;
        f32x4 x = *(const f32x4*)(Xin + off); if (scale) v = v * *(const f32x4*)(scale + c); x = x + v; *(f32x4*)(Xout + off) = x;
        if (Xb) { u32x2 w; w.x = cvt_pk_bf16(x[0], x[1]); w.y = cvt_pk_bf16(x[2], x[3]); *(u32x2*)(Xb + off) = w; }
        return x[0] * x[0] + x[1] * x[1] + x[2] * x[2] + x[3] * x[3]; } };
struct SUp { bf16_t* H; const float* parts;
    __device__ __forceinline__ void rowpart(int, int, float) const {}
    __device__ __forceinline__ float operator()(int r, int c, f32x4 v) const { f32x4 t = (f32x4){0.f, 0.f, 0.f, 0.f};
#pragma unroll
        for (int i = 0; i < 16; ++i) t = t + *(const f32x4*)(parts + r * 64 + i * 4);
        const float rs = rsqrtf(((t[0] + t[1]) + (t[2] + t[3])) * (1.f / 1024.f) + EPS); f32x4 o;
#pragma unroll
        for (int e = 0; e < 4; ++e) { float a = fmaxf(v[e] * rs, 0.f); o[e] = a * a; }
        u32x2 w; w.x = cvt_pk_bf16(o[0], o[1]); w.y = cvt_pk_bf16(o[2], o[3]); *(u32x2*)(H + (size_t)r * 4096 + c) = w; return 0.f; } };

struct TJob { const float* src; bf16_t* dst; const float* gain; int N, ldd, k0, n0; };
__device__ __forceinline__ bool prep_job(const Params& p, int it, TJob& j) {
    unsigned char* ws = p.ws;
    constexpr int T_IN = 1024, T_OUT = 256, T_UP = 1024, T_DN = 1024, T_P = 64;
    constexpr int NT = T_IN + T_OUT + 2 * T_UP + 2 * T_DN + T_P;
    if (it >= NT) return false;
    int r = it; j.gain = nullptr;
    if (r < T_IN) { j.src = p.hgrn_w_in; j.N = 4096; j.dst = (bf16_t*)(ws + WS_WIN); j.ldd = 1024; j.k0 = (r >> 6) * 64; j.n0 = (r & 63) * 64; return true; } r -= T_IN;
    if (r < T_OUT) { j.src = p.hgrn_w_out; j.N = 1024; j.dst = (bf16_t*)(ws + WS_WOUT); j.ldd = 1024; j.k0 = (r >> 4) * 64; j.n0 = (r & 15) * 64; return true; } r -= T_OUT;
    if (r < T_UP) { j.src = p.mlp_up; j.N = 4096; j.dst = (bf16_t*)(ws + WS_WUP0); j.ldd = 1024; j.k0 = (r >> 6) * 64; j.n0 = (r & 63) * 64; j.gain = p.mlp_norm; return true; } r -= T_UP;
    if (r < T_UP) { j.src = p.mlp_up + (size_t)1024 * 4096; j.N = 4096; j.dst = (bf16_t*)(ws + WS_WUP1); j.ldd = 1024; j.k0 = (r >> 6) * 64; j.n0 = (r & 63) * 64; j.gain = p.mlp_norm + 1024; return true; } r -= T_UP;
    if (r < T_DN) { j.src = p.mlp_down; j.N = 1024; j.dst = (bf16_t*)(ws + WS_WDN0); j.ldd = 4096; j.k0 = (r >> 4) * 64; j.n0 = (r & 15) * 64; return true; } r -= T_DN;
    if (r < T_DN) { j.src = p.mlp_down + (size_t)4096 * 1024; j.N = 1024; j.dst = (bf16_t*)(ws + WS_WDN1); j.ldd = 4096; j.k0 = (r >> 4) * 64; j.n0 = (r & 15) * 64; return true; } r -= T_DN;
    { const int g = r >> 4, rr = r & 15; j.src = p.pool_w + (size_t)g * 65536; j.N = 256; j.dst = (bf16_t*)(ws + WS_WP) + (size_t)g * 65536; j.ldd = 256; j.k0 = (rr >> 2) * 64; j.n0 = (rr & 3) * 64; }
    return true;
}
__device__ __forceinline__ void phase_prep(const Params& p, LAS unsigned char* lds) {
    LAS float* tiles = (LAS float*)lds;
    unsigned char* ws = p.ws;
    constexpr int NT = 1024 + 256 + 2 * 1024 + 2 * 1024 + 64;
    { const int tid = threadIdx.x, i = tid >> 4, j4 = (tid & 15) * 4, n = tid >> 3, k8 = (tid & 7) * 8;
#pragma unroll 1
      for (int it0 = blockIdx.x; it0 < NT; it0 += 2 * gridDim.x) {
          TJob j[2]; bool ok[2]; f32x4 v[2][2];
#pragma unroll
          for (int q = 0; q < 2; ++q) { ok[q] = prep_job(p, it0 + q * gridDim.x, j[q]);
              if (ok[q]) {
#pragma unroll
                  for (int hh = 0; hh < 2; ++hh) v[q][hh] = __builtin_nontemporal_load((const f32x4*)(j[q].src + (size_t)(j[q].k0 + i + 32 * hh) * j[q].N + j[q].n0 + j4)); } }
#pragma unroll
          for (int q = 0; q < 2; ++q) if (ok[q]) {
#pragma unroll
              for (int hh = 0; hh < 2; ++hh)
#pragma unroll
                  for (int e = 0; e < 4; ++e) tiles[q * 4160 + (j4 + e) * 65 + i + 32 * hh] = v[q][hh][e]; }
          __syncthreads();
#pragma unroll
          for (int q = 0; q < 2; ++q) if (ok[q]) { float o[8];
#pragma unroll
              for (int e = 0; e < 8; ++e) { o[e] = tiles[q * 4160 + n * 65 + k8 + e]; if (j[q].gain) o[e] *= j[q].gain[j[q].k0 + k8 + e]; }
              u32x4 w; w.x = cvt_pk_bf16(o[0], o[1]); w.y = cvt_pk_bf16(o[2], o[3]); w.z = cvt_pk_bf16(o[4], o[5]); w.w = cvt_pk_bf16(o[6], o[7]);
              int nd = j[q].n0; if (j[q].src == p.hgrn_w_in) { const int ob = nd >> 10; nd = (nd & 1023) + ((ob == 2 ? 3 : ob == 3 ? 2 : ob) << 10); }
              *(u32x4*)(j[q].dst + (size_t)(nd + n) * j[q].ldd + j[q].k0 + k8) = w; }
          __syncthreads();
      } }
    const int tid = threadIdx.x, wid = tid >> 6, lane = tid & 63;
    bf16_t* U = (bf16_t*)(ws + WS_R2);
    for (int row0 = blockIdx.x * 8 + wid; row0 < MP; row0 += gridDim.x * 32) {
        f32x4 v[4][4];
#pragma unroll
        for (int rr = 0; rr < 4; ++rr) { const int row = row0 + rr * gridDim.x * 8; if (row < MP) { const float* src = row < TP ? p.x_prompt + (size_t)row * 1024 : p.x_sample + (size_t)(row - TP) * 1024;
#pragma unroll
            for (int j = 0; j < 4; ++j) v[rr][j] = *(const f32x4*)(src + lane * 4 + 256 * j); } }
#pragma unroll
        for (int rr = 0; rr < 4; ++rr) { const int row = row0 + rr * gridDim.x * 8; if (row < MP) { float sacc = 0.f;
#pragma unroll
            for (int j = 0; j < 4; ++j) sacc += v[rr][j][0] * v[rr][j][0] + v[rr][j][1] * v[rr][j][1] + v[rr][j][2] * v[rr][j][2] + v[rr][j][3] * v[rr][j][3];
            const float rs = rsqrtf(wave_sum(sacc) * (1.f / 1024.f) + EPS);
#pragma unroll
            for (int j = 0; j < 4; ++j) { const f32x4 g = *(const f32x4*)(p.hgrn_norm + lane * 4 + 256 * j);
                u32x2 w; w.x = cvt_pk_bf16(v[rr][j][0] * rs * g[0], v[rr][j][1] * rs * g[1]); w.y = cvt_pk_bf16(v[rr][j][2] * rs * g[2], v[rr][j][3] * rs * g[3]);
                *(u32x2*)(U + (size_t)row * 1024 + lane * 4 + 256 * j) = w; } } }
    }
    if (blockIdx.x < 2) { const int c = blockIdx.x * 512 + tid; ((float*)(ws + WS_LB))[c] = lb_of(p.hgrn_lb, c); }
}

__device__ __forceinline__ bf16x8 lds_frag(const LAS bf16_t* p) { return *(const LAS bf16x8*)p; }
__device__ __forceinline__ void rec_prompt(const Params& p, LAS unsigned char* lds, int b, int h, int seg) {
    const int tid = threadIdx.x, wid = tid >> 6, lane = tid & 63, fr = lane & 15, fq = lane >> 4;
    LAS bf16_t* QT = (LAS bf16_t*)(lds + 0);
    LAS bf16_t* KT = (LAS bf16_t*)(lds + 17408);
    LAS bf16_t* KH = (LAS bf16_t*)(lds + 34816);
    LAS bf16_t* VT = (LAS bf16_t*)(lds + 53248);
    LAS bf16_t* SB = (LAS bf16_t*)(lds + 71680);
    LAS bf16_t* AM = (LAS bf16_t*)(lds + 106496);
    LAS float* TOT = (LAS float*)(lds + 115712);
    LAS float* DD = (LAS float*)(lds + 119808);
    LAS float* SSQ = (LAS float*)(lds + 120320);
    const unsigned char* ws = p.ws;
    const size_t gbase = (size_t)b * SEQ * 1024 + h * 128;
    const bf16_t* Qg = (const bf16_t*)(ws + WS_Q) + gbase; const bf16_t* Vg = (const bf16_t*)(ws + WS_V) + gbase; const bf16_t* OGg = (const bf16_t*)(ws + WS_OG) + gbase;
    const bf16_t* Gg = (const bf16_t*)(ws + WS_G) + gbase;
    bf16_t* Og = (bf16_t*)(p.ws + WS_R2) + gbase;
    bf16_t* QCg = (bf16_t*)(p.ws + WS_R2) + gbase;
    float* OLg = p.out + gbase;
    f32x2 Gseg = (f32x2){0.f, 0.f};
    f32x4 Sacc[8];
#pragma unroll
    for (int i = 0; i < 8; ++i) Sacc[i] = (f32x4){0.f, 0.f, 0.f, 0.f};
    const int d2 = (tid & 63) * 2, part = tid >> 6;
    unsigned gr[8], qr[8], vr[8];
#define REC_LOAD(c) do { const unsigned o_ = (unsigned)(((c) * 64 + part * 8) * 1024 + d2); \
        _Pragma("unroll") for (int i = 0; i < 8; ++i) { gr[i] = *(const unsigned*)(Gg + o_ + (unsigned)i * 1024u); qr[i] = *(const unsigned*)(Qg + o_ + (unsigned)i * 1024u); vr[i] = *(const unsigned*)(Vg + o_ + (unsigned)i * 1024u); } } while (0)
    REC_LOAD(seg * 8);
    const int tb = wid & 3, vh = wid >> 2;
    for (int cc = 0; cc < 8; ++cc) {
        const int c = seg * 8 + cc;
#pragma unroll
        for (int vb = 0; vb < 8; ++vb) { u32x2 w; w.x = cvt_pk_bf16(Sacc[vb][0], Sacc[vb][1]); w.y = cvt_pk_bf16(Sacc[vb][2], Sacc[vb][3]);
            *(LAS u32x2*)(SB + (vb * 16 + fr) * 136 + wid * 16 + fq * 4) = w; }
        f32x2 cs[8];
        { f32x2 run = (f32x2){0.f, 0.f};
#pragma unroll
          for (int i = 0; i < 8; ++i) { run = run + h2_to_f2(gr[i]); cs[i] = run; }
          *(LAS f32x2*)(TOT + part * 128 + d2) = run; }
        __syncthreads();
        { f32x2 off = (f32x2){0.f, 0.f}, Gl = (f32x2){0.f, 0.f};
#pragma unroll
          for (int pp = 0; pp < 8; ++pp) { const f32x2 tv = *(const LAS f32x2*)(TOT + pp * 128 + d2); Gl = Gl + tv; if (pp < part) off = off + tv; }
          const float eGl0 = __expf(Gl[0]), eGl1 = __expf(Gl[1]), eGs0 = __expf(Gseg[0]), eGs1 = __expf(Gseg[1]);
          float kh0[8], kh1[8];
#pragma unroll
          for (int i = 0; i < 8; ++i) { const int t = part * 8 + i; const f32x2 G = off + cs[i];
              const float e0 = __expf(G[0]), e1 = __expf(G[1]), ei0 = __builtin_amdgcn_rcpf(e0), ei1 = __builtin_amdgcn_rcpf(e1);
              const f32x2 gv = h2_to_f2(gr[i]); const float k0 = 1.f - __expf(gv[0]), k1 = 1.f - __expf(gv[1]);
              const float q0 = bflo(qr[i]) * e0, q1 = bfhi(qr[i]) * e1;
              *(LAS unsigned*)(QT + t * 136 + d2) = cvt_pk_bf16(q0, q1); *(LAS unsigned*)(KT + t * 136 + d2) = cvt_pk_bf16(k0 * ei0, k1 * ei1);
              kh0[i] = k0 * eGl0 * ei0; kh1[i] = k1 * eGl1 * ei1;
              if (seg > 0) *(unsigned*)(QCg + (unsigned)((c * 64 + t) * 1024 + d2)) = cvt_pk_bf16(q0 * eGs0, q1 * eGs1); }
          Gseg = Gseg + Gl;
          u32x4 w0, w1; w0.x = cvt_pk_bf16(kh0[0], kh0[1]); w0.y = cvt_pk_bf16(kh0[2], kh0[3]); w0.z = cvt_pk_bf16(kh0[4], kh0[5]); w0.w = cvt_pk_bf16(kh0[6], kh0[7]);
          w1.x = cvt_pk_bf16(kh1[0], kh1[1]); w1.y = cvt_pk_bf16(kh1[2], kh1[3]); w1.z = cvt_pk_bf16(kh1[4], kh1[5]); w1.w = cvt_pk_bf16(kh1[6], kh1[7]);
          *(LAS u32x4*)(KH + d2 * 72 + part * 8) = w0; *(LAS u32x4*)(KH + (d2 + 1) * 72 + part * 8) = w1;
          u32x4 v0, v1;
          v0.x = (vr[0] & 0xffffu) | (vr[1] << 16); v0.y = (vr[2] & 0xffffu) | (vr[3] << 16); v0.z = (vr[4] & 0xffffu) | (vr[5] << 16); v0.w = (vr[6] & 0xffffu) | (vr[7] << 16);
          v1.x = (vr[0] >> 16) | (vr[1] & 0xffff0000u); v1.y = (vr[2] >> 16) | (vr[3] & 0xffff0000u); v1.z = (vr[4] >> 16) | (vr[5] & 0xffff0000u); v1.w = (vr[6] >> 16) | (vr[7] & 0xffff0000u);
          *(LAS u32x4*)(VT + d2 * 72 + part * 8) = v0; *(LAS u32x4*)(VT + (d2 + 1) * 72 + part * 8) = v1;
          if (part == 0) *(LAS f32x2*)(DD + d2) = (f32x2){eGl0, eGl1}; }
        if (cc + 1 < 8) REC_LOAD(c + 1);
        __syncthreads();
        { const int sb = wid >> 1;
#pragma unroll
          for (int ti = 0; ti < 2; ++ti) { const int tbb = (wid & 1) * 2 + ti; f32x4 a = (f32x4){0.f, 0.f, 0.f, 0.f};
              if (sb <= tbb) {
#pragma unroll
                  for (int kk = 0; kk < 4; ++kk) a = __builtin_amdgcn_mfma_f32_16x16x32_bf16(lds_frag(KT + (sb * 16 + fr) * 136 + kk * 32 + fq * 8), lds_frag(QT + (tbb * 16 + fr) * 136 + kk * 32 + fq * 8), a, 0, 0, 0);
                  const int t = tbb * 16 + fr, s0 = sb * 16 + fq * 4;
#pragma unroll
                  for (int j = 0; j < 4; ++j) if (s0 + j > t) a[j] = 0.f; }
              u32x2 w; w.x = cvt_pk_bf16(a[0], a[1]); w.y = cvt_pk_bf16(a[2], a[3]);
              *(LAS u32x2*)(AM + (tbb * 16 + fr) * 72 + sb * 16 + fq * 4) = w; } }
        { const f32x4 dd = *(const LAS f32x4*)(DD + wid * 16 + fq * 4);
          const bf16x8 a0 = lds_frag(KH + (wid * 16 + fr) * 72 + fq * 8), a1 = lds_frag(KH + (wid * 16 + fr) * 72 + 32 + fq * 8);
#pragma unroll
          for (int vb = 0; vb < 8; ++vb) { f32x4 a = Sacc[vb] * dd;
              a = __builtin_amdgcn_mfma_f32_16x16x32_bf16(a0, lds_frag(VT + (vb * 16 + fr) * 72 + fq * 8), a, 0, 0, 0);
              a = __builtin_amdgcn_mfma_f32_16x16x32_bf16(a1, lds_frag(VT + (vb * 16 + fr) * 72 + 32 + fq * 8), a, 0, 0, 0);
              Sacc[vb] = a; } }
        __syncthreads();
        f32x4 oacc[4]; u32x2 ogv[4];
        const size_t tok = (size_t)c * 64 + tb * 16 + fr;
        if (seg == 0) {
#pragma unroll
        for (int vi = 0; vi < 4; ++vi) ogv[vi] = *(const u32x2*)(OGg + tok * 1024 + (vh * 4 + vi) * 16 + fq * 4); }
        { bf16x8 qf[4], af[2];
#pragma unroll
          for (int kk = 0; kk < 4; ++kk) qf[kk] = lds_frag(QT + (tb * 16 + fr) * 136 + kk * 32 + fq * 8);
#pragma unroll
          for (int kk = 0; kk < 2; ++kk) af[kk] = lds_frag(AM + (tb * 16 + fr) * 72 + kk * 32 + fq * 8);
#pragma unroll
          for (int vi = 0; vi < 4; ++vi) { const int vb = vh * 4 + vi; f32x4 a = (f32x4){0.f, 0.f, 0.f, 0.f};
#pragma unroll
              for (int kk = 0; kk < 4; ++kk) a = __builtin_amdgcn_mfma_f32_16x16x32_bf16(lds_frag(SB + (vb * 16 + fr) * 136 + kk * 32 + fq * 8), qf[kk], a, 0, 0, 0);
#pragma unroll
              for (int kk = 0; kk < 2; ++kk) a = __builtin_amdgcn_mfma_f32_16x16x32_bf16(lds_frag(VT + (vb * 16 + fr) * 72 + kk * 32 + fq * 8), af[kk], a, 0, 0, 0);
              oacc[vi] = a; } }
        if (seg == 0) {
        { float ss = 0.f;
#pragma unroll
          for (int vi = 0; vi < 4; ++vi) ss += oacc[vi][0] * oacc[vi][0] + oacc[vi][1] * oacc[vi][1] + oacc[vi][2] * oacc[vi][2] + oacc[vi][3] * oacc[vi][3];
          ss += __shfl_xor(ss, 16); ss += __shfl_xor(ss, 32);
          if (fq == 0) SSQ[vh * 64 + tb * 16 + fr] = ss; }
        __syncthreads();
        { const float tot = SSQ[tb * 16 + fr] + SSQ[64 + tb * 16 + fr]; const float rs = rsqrtf(tot * (1.f / 128.f) + EPS);
#pragma unroll
          for (int vi = 0; vi < 4; ++vi) { const f32x4 o = oacc[vi] * rs * *(const f32x4*)(p.hgrn_onorm + h * 128 + (vh * 4 + vi) * 16 + fq * 4);
              u32x2 w; w.x = cvt_pk_bf16(o[0] * bflo(ogv[vi].x), o[1] * bfhi(ogv[vi].x)); w.y = cvt_pk_bf16(o[2] * bflo(ogv[vi].y), o[3] * bfhi(ogv[vi].y));
              *(u32x2*)(Og + tok * 1024 + (vh * 4 + vi) * 16 + fq * 4) = w; } }
        } else {
#pragma unroll
          for (int vi = 0; vi < 4; ++vi) *(f32x4*)(OLg + tok * 1024 + (vh * 4 + vi) * 16 + fq * 4) = oacc[vi];
          __syncthreads();
        }
    }
#undef REC_LOAD
    float* So = seg == 3 ? p.out + O_HP + (size_t)(b * 8 + h) * 16384 : (float*)(p.ws + WS_LSEG) + ((size_t)(b * 8 + h) * 3 + seg) * 16384;
    if (part == 0) *(f32x2*)((float*)(p.ws + WS_DSEG) + ((size_t)(b * 8 + h) * 4 + seg) * 128 + d2) = (f32x2){__expf(Gseg[0]), __expf(Gseg[1])};
#pragma unroll
    for (int vb = 0; vb < 8; ++vb)
#pragma unroll
        for (int j = 0; j < 4; ++j) So[(size_t)(wid * 16 + fq * 4 + j) * 128 + vb * 16 + fr] = Sacc[vb][j];
    __syncthreads();
}
__device__ __forceinline__ void rec_sample(const Params& p, LAS unsigned char* lds, int item) {
    const int tid = threadIdx.x, b = item >> 3, h = item & 7;
    LAS float* qs = (LAS float*)lds; LAS float* fs = qs + 128; LAS float* ks = qs + 256; LAS float* vs = qs + 384; LAS float* red = qs + 512;
    LAS float* sq = qs + 512 + 2048;
    const unsigned char* ws = p.ws;
    const size_t roff = (size_t)(TP + b) * 1024 + h * 128;
    if (tid < 128) { qs[tid] = bf2f(((const bf16_t*)(ws + WS_Q))[roff + tid]); const float f = __expf((float)((const _Float16*)(ws + WS_G))[roff + tid]); fs[tid] = f; ks[tid] = 1.f - f;
        vs[tid] = bf2f(((const bf16_t*)(ws + WS_V))[roff + tid]); }
    __syncthreads();
    const int v4 = (tid & 31) * 4, dg = tid >> 5;
    const float* Sin = p.state_hgrn + (size_t)item * 16384; float* Sout = p.out + O_HS + (size_t)item * 16384;
    const f32x4 vv = *(const LAS f32x4*)(vs + v4);
    f32x4 o = (f32x4){0.f, 0.f, 0.f, 0.f};
    f32x4 sv[8];
#pragma unroll
    for (int i = 0; i < 8; ++i) sv[i] = *(const f32x4*)(Sin + (size_t)(dg * 8 + i) * 128 + v4);
#pragma unroll
    for (int i = 0; i < 8; ++i) { const int dd = dg * 8 + i; const f32x4 sn = sv[i] * fs[dd] + vv * ks[dd]; *(f32x4*)(Sout + (size_t)dd * 128 + v4) = sn; o = o + sn * qs[dd]; }
    *(LAS f32x4*)(red + dg * 128 + v4) = o;
    __syncthreads();
    float ov = 0.f;
    if (tid < 128) {
#pragma unroll
        for (int i = 0; i < 16; ++i) ov += red[i * 128 + tid];
        const float s = wave_sum(ov * ov); if ((tid & 63) == 0) sq[tid >> 6] = s; }
    __syncthreads();
    if (tid < 128) { const float rs = rsqrtf((sq[0] + sq[1]) * (1.f / 128.f) + EPS);
        const float og = bf2f(((const bf16_t*)(ws + WS_OG))[roff + tid]);
        ((bf16_t*)(p.ws + WS_R2))[roff + tid] = f2bf(ov * rs * p.hgrn_onorm[h * 128 + tid] * og); }
    __syncthreads();
}

__device__ __forceinline__ void rec_sample_list(const Params& p, LAS unsigned char* lds, int first, int stride, int count, size_t obase = WS_R2) {
    const int tid = threadIdx.x;
    LAS float* qs = (LAS float*)lds; LAS float* fs = qs + 128; LAS float* ks = qs + 256; LAS float* vs = qs + 384; LAS float* red = qs + 512;
    LAS float* sq = qs + 512 + 2048;
    const unsigned char* ws = p.ws;
    const int v4 = (tid & 31) * 4, dg = tid >> 5;
    f32x4 svA[8], svB[8]; float lqA = 0.f, lgA = 0.f, lvA = 0.f, loA = 0.f, lqB = 0.f, lgB = 0.f, lvB = 0.f, loB = 0.f;
#define RS_ISSUE(item_, sv, lq, lg, lv, lo) do { const int it_ = (item_); const size_t ro_ = (size_t)(TP + (it_ >> 3)) * 1024 + (it_ & 7) * 128; \
        if (tid < 128) { lq = bf2f(((const bf16_t*)(ws + WS_Q))[ro_ + tid]); lg = (float)((const _Float16*)(ws + WS_G))[ro_ + tid]; lv = bf2f(((const bf16_t*)(ws + WS_V))[ro_ + tid]); lo = bf2f(((const bf16_t*)(ws + WS_OG))[ro_ + tid]); } \
        const float* Sin_ = p.state_hgrn + (size_t)it_ * 16384; \
        _Pragma("unroll") for (int i = 0; i < 8; ++i) sv[i] = __builtin_nontemporal_load((const f32x4*)(Sin_ + (size_t)(dg * 8 + i) * 128 + v4)); } while (0)
#define RS_ITEM(j_, sv, lq, lg, lv, lo) do { \
        const int item = first + (j_) * stride, b = item >> 3, h = item & 7; \
        const size_t roff = (size_t)(TP + b) * 1024 + h * 128; \
        const float og = lo; \
        if (tid < 128) { const float f = __expf(lg); qs[tid] = lq; fs[tid] = f; ks[tid] = 1.f - f; vs[tid] = lv; } \
        __syncthreads(); \
        float* Sout = p.out + O_HS + (size_t)item * 16384; \
        const f32x4 vv = *(const LAS f32x4*)(vs + v4); \
        f32x4 o = (f32x4){0.f, 0.f, 0.f, 0.f}; \
        _Pragma("unroll") for (int i = 0; i < 8; ++i) { const int dd = dg * 8 + i; const f32x4 sn = sv[i] * fs[dd] + vv * ks[dd]; __builtin_nontemporal_store(sn, (f32x4*)(Sout + (size_t)dd * 128 + v4)); o = o + sn * qs[dd]; } \
        if ((j_) + 2 < count) RS_ISSUE(first + ((j_) + 2) * stride, sv, lq, lg, lv, lo); \
        *(LAS f32x4*)(red + dg * 128 + v4) = o; \
        __syncthreads(); \
        float ov = 0.f; \
        if (tid < 128) { \
            _Pragma("unroll") for (int i = 0; i < 16; ++i) ov += red[i * 128 + tid]; \
            const float s2 = wave_sum(ov * ov); if ((tid & 63) == 0) sq[tid >> 6] = s2; } \
        __syncthreads(); \
        if (tid < 128) { const float rs = rsqrtf((sq[0] + sq[1]) * (1.f / 128.f) + EPS); \
            ((bf16_t*)(p.ws + obase))[roff + tid] = f2bf(ov * rs * p.hgrn_onorm[h * 128 + tid] * og); } \
        __syncthreads(); } while (0)
    if (count > 0) RS_ISSUE(first, svA, lqA, lgA, lvA, loA);
    if (count > 1) RS_ISSUE(first + stride, svB, lqB, lgB, lvB, loB);
    for (int j = 0; j < count; j += 2) {
        RS_ITEM(j, svA, lqA, lgA, lvA, loA);
        if (j + 1 < count) RS_ITEM(j + 1, svB, lqB, lgB, lvB, loB);
    }
#undef RS_ITEM
#undef RS_ISSUE
}
__device__ __forceinline__ void rec_fix(const Params& p, LAS unsigned char* lds, int b, int h, int seg) {
    const int tid = threadIdx.x, wid = tid >> 6, lane = tid & 63, fr = lane & 15, fq = lane >> 4;
    LAS bf16_t* QT = (LAS bf16_t*)(lds + 0);
    LAS bf16_t* SB = (LAS bf16_t*)(lds + 71680);
    LAS float* SSQ = (LAS float*)(lds + 118272);
    const unsigned char* ws = p.ws;
    const int bh = b * 8 + h;
    const size_t gbase = (size_t)b * SEQ * 1024 + h * 128;
    const bf16_t* OGg = (const bf16_t*)(ws + WS_OG) + gbase; const bf16_t* QCg = (const bf16_t*)(ws + WS_R2) + gbase;
    const float* OLg = p.out + gbase; bf16_t* Og = (bf16_t*)(p.ws + WS_R2) + gbase;
    const float* Ls = (const float*)(ws + WS_LSEG) + (size_t)bh * 3 * 16384; const float* Ds = (const float*)(ws + WS_DSEG) + (size_t)bh * 4 * 128;
    { f32x4 S[8];
#pragma unroll
      for (int i = 0; i < 8; ++i) S[i] = (f32x4){0.f, 0.f, 0.f, 0.f};
      f32x4 Lr[3][8]; float Dr[3][8];
#pragma unroll
      for (int sp = 0; sp < 3; ++sp)
#pragma unroll
          for (int i = 0; i < 8; ++i) { const int e4 = (tid + 512 * i) * 4, dd = e4 >> 7;
              if (sp < seg) { Lr[sp][i] = *(const f32x4*)(Ls + (size_t)sp * 16384 + e4); Dr[sp][i] = Ds[sp * 128 + dd]; } else { Lr[sp][i] = (f32x4){0.f, 0.f, 0.f, 0.f}; Dr[sp][i] = 1.f; } }
#pragma unroll
      for (int sp = 0; sp < 3; ++sp)
#pragma unroll
          for (int i = 0; i < 8; ++i) S[i] = S[i] * Dr[sp][i] + Lr[sp][i];
#pragma unroll
      for (int i = 0; i < 8; ++i) { const int e4 = (tid + 512 * i) * 4, dd = e4 >> 7, v0 = e4 & 127;
#pragma unroll
          for (int j = 0; j < 4; ++j) SB[(v0 + j) * 136 + dd] = f2bf(S[i][j]);
          if (seg == 3) { float* So = p.out + O_HP + (size_t)bh * 16384 + e4; *(f32x4*)So = S[i] * Ds[3 * 128 + dd] + *(const f32x4*)So; } } }
    const int qrow0 = tid >> 4, qc8 = (tid & 15) * 8;
    const int tb = wid & 3, vh = wid >> 2;
    const f32x4 onv[4] = { *(const f32x4*)(p.hgrn_onorm + h * 128 + (vh * 4 + 0) * 16 + fq * 4), *(const f32x4*)(p.hgrn_onorm + h * 128 + (vh * 4 + 1) * 16 + fq * 4),
                           *(const f32x4*)(p.hgrn_onorm + h * 128 + (vh * 4 + 2) * 16 + fq * 4), *(const f32x4*)(p.hgrn_onorm + h * 128 + (vh * 4 + 3) * 16 + fq * 4) };
    u32x4 nq[2];
#pragma unroll
    for (int i = 0; i < 2; ++i) nq[i] = *(const u32x4*)(QCg + ((size_t)seg * 512 + qrow0 + 32 * i) * 1024 + qc8);
    f32x4 nol[4]; u32x2 nog[4];
    { const size_t tokf = (size_t)seg * 512 + tb * 16 + fr;
#pragma unroll
      for (int vi = 0; vi < 4; ++vi) { nol[vi] = *(const f32x4*)(OLg + tokf * 1024 + (vh * 4 + vi) * 16 + fq * 4); nog[vi] = *(const u32x2*)(OGg + tokf * 1024 + (vh * 4 + vi) * 16 + fq * 4); } }
    for (int cc = 0; cc < 8; ++cc) {
        const size_t t0 = (size_t)seg * 512 + cc * 64;
#pragma unroll
        for (int i = 0; i < 2; ++i) *(LAS u32x4*)(QT + (qrow0 + 32 * i) * 136 + qc8) = nq[i];
        __syncthreads();
        if (cc + 1 < 8) {
#pragma unroll
            for (int i = 0; i < 2; ++i) nq[i] = *(const u32x4*)(QCg + (t0 + 64 + qrow0 + 32 * i) * 1024 + qc8); }
        const size_t tok = t0 + tb * 16 + fr;
        f32x4 oacc[4]; u32x2 ogv[4];
#pragma unroll
        for (int vi = 0; vi < 4; ++vi) { oacc[vi] = nol[vi]; ogv[vi] = nog[vi]; }
        if (cc + 1 < 8) {
#pragma unroll
            for (int vi = 0; vi < 4; ++vi) { nol[vi] = *(const f32x4*)(OLg + (tok + 64) * 1024 + (vh * 4 + vi) * 16 + fq * 4); nog[vi] = *(const u32x2*)(OGg + (tok + 64) * 1024 + (vh * 4 + vi) * 16 + fq * 4); } }
        { bf16x8 qf[4];
#pragma unroll
          for (int kk = 0; kk < 4; ++kk) qf[kk] = lds_frag(QT + (tb * 16 + fr) * 136 + kk * 32 + fq * 8);
#pragma unroll
          for (int vi = 0; vi < 4; ++vi) { const int vb = vh * 4 + vi; f32x4 a = oacc[vi];
#pragma unroll
              for (int kk = 0; kk < 4; ++kk) a = __builtin_amdgcn_mfma_f32_16x16x32_bf16(lds_frag(SB + (vb * 16 + fr) * 136 + kk * 32 + fq * 8), qf[kk], a, 0, 0, 0);
              oacc[vi] = a; } }
        { float ss = 0.f;
#pragma unroll
          for (int vi = 0; vi < 4; ++vi) ss += oacc[vi][0] * oacc[vi][0] + oacc[vi][1] * oacc[vi][1] + oacc[vi][2] * oacc[vi][2] + oacc[vi][3] * oacc[vi][3];
          ss += __shfl_xor(ss, 16); ss += __shfl_xor(ss, 32);
          if (fq == 0) SSQ[vh * 64 + tb * 16 + fr] = ss; }
        __syncthreads();
        { const float tot = SSQ[tb * 16 + fr] + SSQ[64 + tb * 16 + fr]; const float rs = rsqrtf(tot * (1.f / 128.f) + EPS);
#pragma unroll
          for (int vi = 0; vi < 4; ++vi) { const f32x4 o = oacc[vi] * rs * onv[vi];
              u32x2 w; w.x = cvt_pk_bf16(o[0] * bflo(ogv[vi].x), o[1] * bfhi(ogv[vi].x)); w.y = cvt_pk_bf16(o[2] * bflo(ogv[vi].y), o[3] * bfhi(ogv[vi].y));
              *(u32x2*)(Og + tok * 1024 + (vh * 4 + vi) * 16 + fq * 4) = w; } }
    }
    __syncthreads();
}

__device__ __forceinline__ float* part_slot(unsigned char* ws, int k) { return (float*)(ws + WS_PART + (size_t)k * PART_SLOT); }
__device__ __forceinline__ float row_ssq16(const float* slot, size_t row) {
    const f32x4* pp = (const f32x4*)(slot + row * 16); const f32x4 t = (pp[0] + pp[1]) + (pp[2] + pp[3]); return (t[0] + t[1]) + (t[2] + t[3]); }
__device__ __forceinline__ float row_ssq64(const float* slot, int r) {
    const f32x4* pp = (const f32x4*)(slot + (size_t)TP * 16 + (size_t)r * 64); f32x4 t = pp[0];
#pragma unroll
    for (int i = 1; i < 16; ++i) t = t + pp[i];
    return (t[0] + t[1]) + (t[2] + t[3]); }
__device__ __forceinline__ void phase_pool(const Params& p, LAS unsigned char* lds) {
    const int tid = threadIdx.x, c = tid * 2, gi = c >> 8, w = 2 << gi;
    LAS f32x2* ring = (LAS f32x2*)lds;
    const float* slot = part_slot(p.ws, 1);
    bf16_t* Z = (bf16_t*)(p.ws + WS_R2);
    const bf16_t* XBs = (const bf16_t*)(p.ws + WS_XB);
    const f32x2 gp = *(const f32x2*)(p.pool_norm + c);
    for (int unit = blockIdx.x; unit < 256; unit += gridDim.x) {
        const int b = unit >> 5, t0 = (unit & 31) * 64;
#pragma unroll
        for (int i = 0; i < 16; ++i) ring[i * 512 + tid] = (f32x2){0.f, 0.f};
        f32x2 sum = (f32x2){0.f, 0.f};
        LAS float* rsl = (LAS float*)(lds + 65536);
        __syncthreads();
        if (tid < 80) { const int t = t0 - 16 + tid; rsl[tid] = t >= 0 ? rsqrtf(row_ssq16(slot, (size_t)b * SEQ + t) * (1.f / 1024.f) + EPS) : 0.f; }
        __syncthreads();
        for (int tt = -16; tt < 64; tt += 16) {
            unsigned xw[16];
#pragma unroll
            for (int i = 0; i < 16; ++i) { const int t = t0 + tt + i; xw[i] = t >= 0 ? *(const unsigned*)(XBs + ((size_t)b * SEQ + t) * 1024 + c) : 0u; }
#pragma unroll
            for (int i = 0; i < 16; ++i) { const int t = t0 + tt + i; const float rs = rsl[tt + 16 + i];
                const f32x2 u = (f32x2){bflo(xw[i]), bfhi(xw[i])} * rs * gp;
                const f32x2 old = ring[((t - w) & 15) * 512 + tid];
                ring[(t & 15) * 512 + tid] = u; sum = sum + u - old;
                if (tt + i >= 0) { const float cnt = (float)min(w, t + 1); const f32x2 z = sum / cnt - u; const size_t row = (size_t)b * SEQ + t;
                    *(unsigned*)(Z + row * 1024 + c) = cvt_pk_bf16(z[0], z[1]);
                    if (t >= SEQ - 15) *(f32x2*)(p.out + O_PP + ((size_t)b * 15 + (t - (SEQ - 15))) * 1024 + c) = u; } }
        }
    }
    for (int sb = blockIdx.x; sb < TS; sb += gridDim.x) {
        const size_t row = (size_t)TP + sb;
        const float rs = rsqrtf(row_ssq64(slot, sb) * (1.f / 1024.f) + EPS);
        const f32x2 u = *(const f32x2*)(p.out + row * 1024 + c) * rs * gp;
        const float* hist = p.state_pool + (size_t)sb * 15 * 1024 + c;
        float* ho = p.out + O_PS + (size_t)sb * 15 * 1024 + c;
        f32x2 sum = u;
#pragma unroll
        for (int j = 0; j < 15; ++j) { const f32x2 hv = *(const f32x2*)(hist + (size_t)j * 1024); if (j >= 16 - w) sum = sum + hv; if (j >= 1) *(f32x2*)(ho + (size_t)(j - 1) * 1024) = hv; }
        *(f32x2*)(ho + (size_t)14 * 1024) = u;
        const f32x2 z = sum / (float)w - u;
        *(unsigned*)(Z + row * 1024 + c) = cvt_pk_bf16(z[0], z[1]);
    }
}

__device__ __forceinline__ void phase_final(const Params& p) {
    const int tid = threadIdx.x, wid = tid >> 6, lane = tid & 63;
    const float* slot = part_slot(p.ws, 3);
    const int r = blockIdx.x * 8 + wid;
    if (r < TS) {
        float* xr = p.out + O_YS + (size_t)r * 1024;
        const float rs = rsqrtf(wave_sum(slot[(size_t)TP * 16 + (size_t)r * 64 + lane]) * (1.f / 1024.f) + EPS);
#pragma unroll
        for (int j = 0; j < 4; ++j) { const f32x4 v = *(const f32x4*)(xr + lane * 4 + 256 * j); const f32x4 g = *(const f32x4*)(p.final_norm + lane * 4 + 256 * j); *(f32x4*)(xr + lane * 4 + 256 * j) = v * rs * g; }
    }
}

#define XB_TMO      128
#define XB_XCNT(j)  (256  + 64 * (j))
#define XB_XSUB(j)  (1280 + 64 * (j))
#define XB_XGEN(j)  (2304 + 64 * (j))
#define XB_TOP      3328
#define XB_TOPGEN   3392
#define XCD_BAR_WORDS 3456
#define XB_SPIN_CAP (1u << 18)
__device__ __forceinline__ unsigned xb_ld(unsigned* p)              { return __hip_atomic_load(p, __ATOMIC_RELAXED, __HIP_MEMORY_SCOPE_AGENT); }
__device__ __forceinline__ unsigned xb_add(unsigned* p, unsigned v) { return __hip_atomic_fetch_add(p, v, __ATOMIC_RELAXED, __HIP_MEMORY_SCOPE_AGENT); }
__device__ __forceinline__ unsigned xb_xcc_id() { return (unsigned)__builtin_amdgcn_s_getreg((3 << 11) | 20) & 0xFu; }
#define XB_SPIN(cond, bar) do { unsigned _sp = 0; while (cond) { __builtin_amdgcn_s_sleep(1); \
    if ((++_sp & 255u) == 0u) { if (xb_ld(&(bar)[XB_TMO])) break; if (_sp > XB_SPIN_CAP) { atomicAdd(&(bar)[XB_TMO], 1u); break; } } } } while (0)
struct XcdBarrier { unsigned* bar; unsigned x; volatile LAS unsigned* st; };
__device__ __forceinline__ XcdBarrier xcd_barrier_post(unsigned* bar, volatile LAS unsigned* st) {
    XcdBarrier b; b.bar = bar; b.x = xb_xcc_id(); b.st = st;
    if (threadIdx.x == 0) (void)xb_add(&bar[XB_XCNT(b.x)], 1u);
    return b;
}
__device__ __forceinline__ void xcd_barrier_complete(unsigned* bar, unsigned x, unsigned& nloc, unsigned& nx) {
    const unsigned G = gridDim.x * gridDim.y * gridDim.z;
    unsigned sum, cnt, mine, sp = 0u;
    for (;;) {
        sum = 0u; cnt = 0u; mine = 0u;
#pragma unroll
        for (unsigned j = 0; j < 16; ++j) { const unsigned c = xb_ld(&bar[XB_XCNT(j)]); sum += c; cnt += (c > 0u) ? 1u : 0u; mine = (j == x) ? c : mine; }
        if (sum == G) break;
        __builtin_amdgcn_s_sleep(1);
        if ((++sp & 255u) == 0u) { if (xb_ld(&bar[XB_TMO])) break; if (sp > XB_SPIN_CAP) { atomicAdd(&bar[XB_TMO], 1u); break; } }
    }
    nloc = mine > 0u ? mine : 1u; nx = cnt > 0u ? cnt : 1u;
}
__device__ __forceinline__ void xcd_barrier(const XcdBarrier& b) {
    asm volatile("s_waitcnt vmcnt(0)" ::: "memory");
    __syncthreads();
    if (threadIdx.x == 0) {
        unsigned* bar = b.bar;
        __builtin_amdgcn_s_waitcnt(0);
        unsigned nloc = b.st[0], nx = b.st[1];
        if (nloc == 0u) { xcd_barrier_complete(bar, b.x, nloc, nx); b.st[0] = nloc; b.st[1] = nx; }
        const unsigned old = xb_add(&bar[XB_XSUB(b.x)], 1u);
        const unsigned gen = old / nloc;
        if (old + 1u == (gen + 1u) * nloc) {
            __builtin_amdgcn_fence(__ATOMIC_RELEASE, "agent");
            asm volatile("s_waitcnt vmcnt(0)" ::: "memory");
            const unsigned og = xb_add(&bar[XB_TOP], 1u);
            const unsigned tg = og / nx;
            if (og + 1u == (tg + 1u) * nx) xb_add(&bar[XB_TOPGEN], 1u);
            else XB_SPIN(xb_ld(&bar[XB_TOPGEN]) == tg, bar);
            __builtin_amdgcn_fence(__ATOMIC_ACQUIRE, "agent");
            xb_add(&bar[XB_XGEN(b.x)], 1u);
            asm volatile("s_waitcnt vmcnt(0)" ::: "memory");
        } else {
            XB_SPIN(xb_ld(&bar[XB_XGEN(b.x)]) == gen, bar);
            __builtin_amdgcn_fence(__ATOMIC_ACQUIRE, "agent");
            asm volatile("s_waitcnt vmcnt(0)" ::: "memory");
        }
    }
    __syncthreads();
}
#define PH_ON(n) ((PHMASK & (1 << (n))) && p.ph_lo <= (n) && (n) < p.ph_hi)
#define PH_SYNC(n) do { if (p.ph_lo < (n) && (n) < p.ph_hi) { xcd_barrier(xb); } } while (0)
__device__ __forceinline__ void ph_in(const Params& p, LAS unsigned char* lds) {
    unsigned char* ws = p.ws; pg8::StaticOrder S;
    EpiIn E{(bf16_t*)(ws + WS_Q), (bf16_t*)(ws + WS_V), (bf16_t*)(ws + WS_OG), (bf16_t*)(ws + WS_G), (const float*)(ws + WS_LB)};
    pg8::Gemm g{(const bf16_t*)(ws + WS_R2), (const bf16_t*)(ws + WS_WIN), TP, 4096, 1024, 1024, 0};
    S.init(g.M, g.N, gridDim.x, blockIdx.x); pg8::gemm_phase(lds, g, S, E);
    SIn F{E.Q, E.V, E.OG, E.G, (const float*)(ws + WS_LB)};
    sample_gemm<4>(lds, (const bf16_t*)(ws + WS_R2) + (size_t)TP * 1024, 1024, 0, (const bf16_t*)(ws + WS_WIN), 1024, F);
}
__device__ __forceinline__ void ph_rec1(const Params& p, LAS unsigned char* lds) {
    for (int it = blockIdx.x; it < 256; it += gridDim.x) { const int seg = it & 3, bh = it >> 2; rec_prompt(p, lds, bh >> 3, bh & 7, seg); }
}
__device__ __forceinline__ void ph_rec2(const Params& p, LAS unsigned char* lds) {
    for (int it = blockIdx.x; it < 256; it += gridDim.x) { const int seg = it & 3, bh = it >> 2; if (seg > 0) rec_fix(p, lds, bh >> 3, bh & 7, seg); }
    if (gridDim.x == 256) {
        const int seg = blockIdx.x & 3, bh = blockIdx.x >> 2;
        if (seg == 0) rec_sample_list(p, lds, bh * 10, 1, 10);
        else { const int k = bh * 3 + (seg - 1); rec_sample_list(p, lds, 640 + k, 192, 2); }
    } else rec_sample_list(p, lds, blockIdx.x, gridDim.x, (TS * 8 - (int)blockIdx.x + (int)gridDim.x - 1) / (int)gridDim.x);
}
__device__ __forceinline__ void ph_out(const Params& p, LAS unsigned char* lds, bool dummy = false) {
    unsigned char* ws = p.ws; pg8::StaticOrder S; float* slot = dummy ? (float*)nullptr : part_slot(ws, 0);
    EpiRes<false, false> E{p.x_prompt, nullptr, nullptr, (bf16_t*)(ws + WS_XB), nullptr, slot};
    pg8::Gemm g{(const bf16_t*)(ws + WS_R2), (const bf16_t*)(ws + WS_WOUT), TP, 1024, 1024, 1024, 0};
    S.init(g.M, g.N, gridDim.x, blockIdx.x); pg8::gemm_phase(lds, g, S, E);
    SRes F{p.x_sample, p.out + O_YS, (bf16_t*)(ws + WS_XB) + (size_t)TP * 1024, nullptr, dummy ? (float*)nullptr : slot + (size_t)TP * 16};
    sample_gemm<1>(lds, (const bf16_t*)(ws + WS_R2) + (size_t)TP * 1024, 1024, 0, (const bf16_t*)(ws + WS_WOUT), 1024, F);
}
__device__ __forceinline__ void ph_up(const Params& p, LAS unsigned char* lds, int L) {
    unsigned char* ws = p.ws; pg8::StaticOrder S; float* sq = part_slot(ws, L ? 2 : 0);
    const bf16_t* W = (const bf16_t*)(ws + (L ? WS_WUP1 : WS_WUP0));
    EpiUp E{(bf16_t*)(ws + WS_H), sq};
    pg8::Gemm g{(const bf16_t*)(ws + WS_XB), W, TP, 4096, 1024, 1024, 0};
    S.init(g.M, g.N, gridDim.x, blockIdx.x); pg8::gemm_phase(lds, g, S, E);
    SUp F{(bf16_t*)(ws + WS_H) + (size_t)TP * 4096, sq + (size_t)TP * 16};
    sample_gemm<4>(lds, (const bf16_t*)(ws + WS_XB) + (size_t)TP * 1024, 1024, 0, W, 1024, F);
}
__device__ __forceinline__ void ph_down(const Params& p, LAS unsigned char* lds, int L) {
    unsigned char* ws = p.ws; pg8::StaticOrder S; float* sq = part_slot(ws, L ? 3 : 1);
    const bf16_t* W = (const bf16_t*)(ws + (L ? WS_WDN1 : WS_WDN0));
    pg8::Gemm g{(const bf16_t*)(ws + WS_H), W, TP, 1024, 4096, 4096, 0};
    S.init(g.M, g.N, gridDim.x, blockIdx.x);
    if (L == 0) { EpiRes<true, false> E{nullptr, (const bf16_t*)(ws + WS_XB), nullptr, (bf16_t*)(ws + WS_XB), nullptr, sq}; pg8::gemm_phase(lds, g, S, E); }
    else { EpiFinal E{(const bf16_t*)(ws + WS_XB), p.out, p.final_norm, sq, (unsigned*)(ws + WS_BAR) + XCD_BAR_WORDS}; pg8::gemm_phase(lds, g, S, E); }
    SRes F{p.out + O_YS, p.out + O_YS, nullptr, nullptr, sq + (size_t)TP * 16};
    sample_gemm<1>(lds, (const bf16_t*)(ws + WS_H) + (size_t)TP * 4096, 4096, 0, W, 4096, F);
}
__device__ __forceinline__ void ph_poolg(const Params& p, LAS unsigned char* lds) {
    unsigned char* ws = p.ws; pg8::StaticOrder S; float* sq = part_slot(ws, 2);
    EpiRes<true, false> E{nullptr, (const bf16_t*)(ws + WS_XB), nullptr, (bf16_t*)(ws + WS_XB), p.pool_scale, sq};
    pg8::Gemm g{(const bf16_t*)(ws + WS_R2), (const bf16_t*)(ws + WS_WP), TP, 1024, 256, 1024, 256};
    S.init(g.M, g.N, gridDim.x, blockIdx.x); pg8::gemm_phase(lds, g, S, E);
    SRes F{p.out + O_YS, p.out + O_YS, (bf16_t*)(ws + WS_XB) + (size_t)TP * 1024, p.pool_scale, sq + (size_t)TP * 16};
    sample_gemm<1>(lds, (const bf16_t*)(ws + WS_R2) + (size_t)TP * 1024, 1024, 256, (const bf16_t*)(ws + WS_WP), 256, F);
}
__global__ void __launch_bounds__(512, 2) mega(Params p) {
    extern __shared__ __attribute__((aligned(16))) unsigned char shm[];
    LAS unsigned char* lds = (LAS unsigned char*)shm;
    volatile LAS unsigned* xst = (volatile LAS unsigned*)(lds + 151552);
    if (threadIdx.x == 0) { xst[0] = 0u; xst[1] = 0u; }
    __syncthreads();
    const XcdBarrier xb = xcd_barrier_post((unsigned*)(p.ws + WS_BAR), xst);
    if (p.ph_hi > 4096) cg::this_grid().sync();
    phase_prep(p, lds);
    if (DUP_PHASE == 0) { xcd_barrier(xb); phase_prep(p, lds); }
    if (DUP_PHASE == 20) { for (int i = 0; i < 20; ++i) xcd_barrier(xb); }
    xcd_barrier(xb); ph_in(p, lds);
    if (DUP_PHASE == 1) { xcd_barrier(xb); ph_in(p, lds); }
    xcd_barrier(xb); ph_rec1(p, lds);
    if (DUP_PHASE == 2) { xcd_barrier(xb); ph_rec1(p, lds); }
    xcd_barrier(xb); ph_rec2(p, lds);
    xcd_barrier(xb); ph_out(p, lds);
    if (DUP_PHASE == 3) { xcd_barrier(xb); ph_out(p, lds); }
    xcd_barrier(xb); ph_up(p, lds, 0);
    if (DUP_PHASE == 4) { xcd_barrier(xb); ph_up(p, lds, 0); }
    xcd_barrier(xb); ph_down(p, lds, 0);
    xcd_barrier(xb); phase_pool(p, lds);
    if (DUP_PHASE == 6) { xcd_barrier(xb); phase_pool(p, lds); }
    xcd_barrier(xb); ph_poolg(p, lds);
    xcd_barrier(xb); ph_up(p, lds, 1);
    xcd_barrier(xb); ph_down(p, lds, 1);
    if (DUP_PHASE == 9) { xcd_barrier(xb); ph_down(p, lds, 1); }
    xcd_barrier(xb);
    phase_final(p);
}

extern "C" void kernel_launch(void* const* d_in, const int* in_sizes, int n_in, void* d_out, int out_size, void* d_ws, size_t ws_size, hipStream_t stream) {
    static int grid = 0;
    if (grid == 0) {
        int dev = 0, cus = 0, per_cu = 0;
        hipGetDevice(&dev);
        hipDeviceGetAttribute(&cus, hipDeviceAttributeMultiprocessorCount, dev);
        if (hipFuncSetAttribute((const void*)mega, hipFuncAttributeMaxDynamicSharedMemorySize, LDS_BYTES) != hipSuccess) fprintf(stderr, "kernel_launch: hipFuncSetAttribute failed\n");
        if (hipOccupancyMaxActiveBlocksPerMultiprocessor(&per_cu, (const void*)mega, 512, LDS_BYTES) != hipSuccess || per_cu < 1) { fprintf(stderr, "kernel_launch: occupancy query gave %d\n", per_cu); per_cu = 1; }
        (void)hipGetLastError();
        grid = cus * per_cu;
        if (ws_size < WS_END3) fprintf(stderr, "kernel_launch: workspace too small: %zu < %zu\n", ws_size, (size_t)WS_END3);
        fprintf(stderr, "kernel_launch: grid %d (cus %d x %d), ws %zu\n", grid, cus, per_cu, ws_size);
    }
    Params p{};
    const float** pp = (const float**)&p;
    for (int i = 0; i < 16; ++i) pp[i] = (const float*)d_in[i];
    p.out = (float*)d_out; p.ws = (unsigned char*)d_ws;
    (void)hipMemsetAsync((unsigned char*)d_ws + WS_BAR, 0, 16384, stream);
    p.ph_lo = 0; p.ph_hi = NPHASE;
    void* args[] = {&p};
    hipError_t e = hipLaunchCooperativeKernel((const void*)mega, dim3(grid), dim3(512), args, LDS_BYTES, stream);
    if (e != hipSuccess) fprintf(stderr, "cooperative launch failed: %s (grid %d)\n", hipGetErrorString(e), grid);
}
```

```cpp
#include <hip/hip_runtime.h>
#include <hip/hip_cooperative_groups.h>
#include <cstdio>
namespace cg = cooperative_groups;

#define LAS __attribute__((address_space(3)))
typedef unsigned short bf16_t;
typedef short bf16x8 __attribute__((ext_vector_type(8)));
typedef float f32x4 __attribute__((ext_vector_type(4)));
typedef float f32x2 __attribute__((ext_vector_type(2)));
typedef unsigned u32x4 __attribute__((ext_vector_type(4)));
typedef unsigned u32x2 __attribute__((ext_vector_type(2)));

#ifndef PHMASK
#define PHMASK 0x7ff
#endif
#ifndef DUP_PHASE
#define DUP_PHASE -1
#endif
#ifndef EXTRA_SYNCS
#define EXTRA_SYNCS 0
#endif
#ifndef MK_LAUNCHES
#define MK_LAUNCHES 1
#endif

constexpr int D = 1024, TP = 16384, TS = 128, MP = TP + TS, FF = 4096, SEQ = 2048;
constexpr float EPS = 1e-6f;
constexpr int NPHASE = 11;
constexpr int LDS_BYTES = 151552 + 16;

constexpr size_t WS_WIN = 0;
constexpr size_t WS_WOUT = WS_WIN + (size_t)4096 * 1024 * 2;
constexpr size_t WS_WUP0 = WS_WOUT + (size_t)1024 * 1024 * 2;
constexpr size_t WS_WDN0 = WS_WUP0 + (size_t)4096 * 1024 * 2;
constexpr size_t WS_WP = WS_WDN0 + (size_t)4096 * 1024 * 2;
constexpr size_t WS_WUP1 = WS_WP + (size_t)1024 * 256 * 2;
constexpr size_t WS_WDN1 = WS_WUP1 + (size_t)4096 * 1024 * 2;
constexpr size_t WS_SSQ = WS_WDN1 + (size_t)4096 * 1024 * 2;
constexpr size_t WS_LB = WS_SSQ + 264192;
constexpr size_t WS_BAR = WS_SSQ + 268288;
constexpr size_t WS_R2 = WS_SSQ + 284672;
constexpr size_t ACT_B = (size_t)MP * 1024 * 2;
constexpr size_t WS_R1 = WS_R2 + ACT_B;
constexpr size_t WS_Q = WS_R1, WS_V = WS_R1 + ACT_B, WS_OG = WS_R1 + 2 * ACT_B, WS_G = WS_R1 + 3 * ACT_B;
constexpr size_t WS_H = WS_R1;
constexpr size_t WS_XB = WS_R1 + (size_t)MP * 4096 * 2;
constexpr size_t WS_END = WS_R1 + 5 * ACT_B;
constexpr size_t WS_PART = WS_END;
constexpr size_t PART_SLOT = (size_t)TP * 16 * 4 + (size_t)TS * 64 * 4;
constexpr size_t WS_END2 = WS_PART + 4 * PART_SLOT;
constexpr size_t WS_LSEG = WS_END2;
constexpr size_t WS_END3 = WS_LSEG + (size_t)64 * 3 * 16384 * 4;
constexpr size_t WS_DSEG = WS_SSQ;

constexpr size_t O_YP = 0, O_YS = 16777216, O_HP = 16908288, O_HS = 17956864, O_PP = 34734080, O_PS = 34856960;

struct Params {
    const float *x_prompt, *x_sample, *state_hgrn, *state_pool, *hgrn_norm, *hgrn_w_in, *hgrn_lb, *hgrn_onorm, *hgrn_w_out,
        *pool_norm, *pool_w, *pool_scale, *mlp_norm, *mlp_up, *mlp_down, *final_norm;
    float* out;
    unsigned char* ws;
    int ph_lo, ph_hi;
};

typedef __bf16 bf16x2_native __attribute__((ext_vector_type(2)));
__device__ __forceinline__ unsigned cvt_pk_bf16(float lo, float hi) { const f32x2 f = {lo, hi}; return __builtin_bit_cast(unsigned, __builtin_convertvector(f, bf16x2_native)); }
__device__ __forceinline__ float bf2f(bf16_t b) { return __uint_as_float(((unsigned)b) << 16); }
__device__ __forceinline__ float bflo(unsigned w) { return __uint_as_float(w << 16); }
__device__ __forceinline__ float bfhi(unsigned w) { return __uint_as_float(w & 0xffff0000u); }
__device__ __forceinline__ bf16_t f2bf(float f) { return (bf16_t)(cvt_pk_bf16(f, 0.f) & 0xffffu); }
typedef _Float16 half2_t __attribute__((ext_vector_type(2)));
__device__ __forceinline__ unsigned cvt_pk_f16(float a, float b) { half2_t h = {(_Float16)a, (_Float16)b}; return __builtin_bit_cast(unsigned, h); }
__device__ __forceinline__ f32x2 h2_to_f2(unsigned w) { const half2_t h = __builtin_bit_cast(half2_t, w); return (f32x2){(float)h[0], (float)h[1]}; }
__device__ __forceinline__ float sigmoidf_(float x) { return __builtin_amdgcn_rcpf(1.f + __expf(-x)); }
__device__ __forceinline__ float wave_sum(float v) {
#pragma unroll
    for (int o = 1; o < 64; o <<= 1) v += __shfl_xor(v, o);
    return v;
}
__device__ __forceinline__ float ein_elem(int type, float x, float lbc) {
    if (type == 0) return x * sigmoidf_(x) * 0.08838834764831845f;
    if (type == 1) return __builtin_amdgcn_logf(lbc + (1.f - lbc) * sigmoidf_(x)) * 0.6931471805599453f;
    if (type == 2) return x;
    return sigmoidf_(x);
}
__device__ __forceinline__ float lb_of(const float* lb, int c) { return 1.f / (1.f + __expf(lb[1024 + c] - lb[c])); }

namespace pg8 {
constexpr int BM = 256, BK = 64, HALF = 128, HTB = HALF * BK * 2, STAGE_BYTES = 8 * HTB, NXCD = 8, WGM = 4;
__host__ __device__ __forceinline__ int lds_byte(int r, int c) { const int st = (r >> 4) * 2 + (c >> 5), rr = r & 15, cc = c & 31, ob = rr * 64 + cc * 2; return st * 1024 + (ob ^ (((ob >> 9) & 1) << 5)); }
__host__ __device__ __forceinline__ void stage_rc(int b, int& R, int& C) { const int st = b / 1024, sb = b % 1024, swz = sb ^ (((sb >> 9) & 1) << 5); R = (st >> 1) * 16 + swz / 64; C = (st & 1) * 32 + (swz % 64) / 2; }
__host__ __device__ __forceinline__ int perm32(int rho) { const int n = rho >> 4, i = rho & 15; return 8 * (i >> 2) + 4 * n + (i & 3); }
struct Unit { int pm, pn; };
struct Gemm { const bf16_t* A; const bf16_t* Bt; int M, N, K, lda, agroup, akt, apanel; };
struct StaticOrder {
    int nM, nN, nwg, G, c, wgm;
    __device__ void init(int M, int N, int G_, int c_) { nM = M / BM; nN = N / BM; nwg = nM * nN; G = G_; c = c_; wgm = nN >= 16 ? 4 : 8; }
    __device__ bool next(int i, Unit& u) const {
        const long L = (long)i * G + c; if (L >= nwg) return false;
        int wgid = (int)L; { const int q = nwg / NXCD, r = nwg % NXCD, xcd = wgid % NXCD, off = wgid / NXCD; wgid = (xcd < r ? xcd * (q + 1) : r * (q + 1) + (xcd - r) * q) + off; }
        const int nig = wgm * nN, gid = wgid / nig, fm = gid * wgm, gsz = (nM - fm) < wgm ? (nM - fm) : wgm;
        u.pm = fm + ((wgid % nig) % gsz); u.pn = (wgid % nig) / gsz; return true;
    }
};

template <class Epi>
__device__ __forceinline__ void gemm_phase(LAS unsigned char* lds, const Gemm g, const StaticOrder& S, const Epi& E) {
    int tid_ = threadIdx.x; asm volatile("" : "+v"(tid_));
    const int tid = tid_, wid = __builtin_amdgcn_readfirstlane(tid >> 6), lane = tid & 63, wr = wid >> 2, wc = wid & 3, fr = lane & 15, fq = lane >> 4;
    const int K = g.K, nt = K / BK, lda = g.lda;
    unsigned voffA[2], voffB[2];
#pragma unroll
    for (int i = 0; i < 2; ++i) { int R, C; stage_rc(tid * 16 + i * 8192, R, C); const int Rb = (R & ~31) + perm32(R & 31);
        voffA[i] = (unsigned)(R * lda + C) * 2u; voffB[i] = (unsigned)(Rb * K + C) * 2u; }
    const size_t kstep = (size_t)(BK * 2), kstepA = g.akt ? (size_t)g.akt : kstep;
    const size_t hstepA = (size_t)HALF * lda * 2, hstepB = (size_t)HALF * K * 2;
    const size_t tstepA = g.apanel ? (size_t)g.apanel : 2 * hstepA, tstepB = 2 * hstepB;
    const unsigned ldsw = (unsigned)wid * 1024u;
    const int aoff = lds_byte(wr * 64 + fr, fq * 8), boff = lds_byte(wc * 32 + fr, fq * 8);
#define PG8_SA(b, h) (((b) * 2 + (h)) * HTB)
#define PG8_SB(b, h) ((4 + (b) * 2 + (h)) * HTB)
#define PG8_STAGE(bufoff, gbase, voff) do { _Pragma("unroll") for (int _i = 0; _i < 2; ++_i) \
        __builtin_amdgcn_global_load_lds((const unsigned*)((const char*)(gbase) + (voff)[_i]), (LAS unsigned*)(lds + (bufoff) + ldsw + _i * 8192), 16, 0, 0); } while (0)
#define PG8_LDA(dst, b, h) do { _Pragma("unroll") for (int m = 0; m < 4; ++m) _Pragma("unroll") for (int k = 0; k < 2; ++k) dst[m][k] = *(const LAS bf16x8*)(lds + PG8_SA(b, h) + aoff + m * 2048 + k * 1024); } while (0)
#define PG8_LDB(dst, b, h) do { _Pragma("unroll") for (int n = 0; n < 2; ++n) _Pragma("unroll") for (int k = 0; k < 2; ++k) dst[n][k] = *(const LAS bf16x8*)(lds + PG8_SB(b, h) + boff + n * 2048 + k * 1024); } while (0)
#define PG8_MMA(ai, bj, At, Bt) do { __builtin_amdgcn_s_setprio(1); _Pragma("unroll") for (int m = 0; m < 4; ++m) _Pragma("unroll") for (int n = 0; n < 2; ++n) _Pragma("unroll") for (int k = 0; k < 2; ++k) \
        acc[ai][bj][m][n] = __builtin_amdgcn_mfma_f32_16x16x32_bf16(Bt[n][k], At[m][k], acc[ai][bj][m][n], 0, 0, 0); __builtin_amdgcn_s_setprio(0); } while (0)
#define PG8_WAIT_V(n) asm volatile("s_waitcnt vmcnt(" #n ")" ::: "memory")
#define PG8_WAIT_L(n) asm volatile("s_waitcnt lgkmcnt(" #n ")" ::: "memory")
#define PG8_BAR __builtin_amdgcn_s_barrier()
#define PG8_SCHED __builtin_amdgcn_sched_barrier(0)
    Unit cur, nxt; int ui = 0;
    if (!S.next(0, cur)) return;
    f32x4 acc[2][2][4][2];
#pragma unroll
    for (int a = 0; a < 2; ++a)
#pragma unroll
        for (int b = 0; b < 2; ++b)
#pragma unroll
            for (int m = 0; m < 4; ++m)
#pragma unroll
                for (int n = 0; n < 2; ++n) acc[a][b][m][n] = (f32x4){0.f, 0.f, 0.f, 0.f};
    bf16x8 At[4][2], B0[2][2], B1[2][2];
    const char* cA = (const char*)g.A + (size_t)cur.pm * tstepA + (size_t)cur.pn * g.agroup * 2; const char* cB = (const char*)g.Bt + (size_t)cur.pn * tstepB;
    PG8_STAGE(PG8_SB(0, 0), cB, voffB); PG8_STAGE(PG8_SA(0, 0), cA, voffA); PG8_STAGE(PG8_SB(0, 1), cB + hstepB, voffB); PG8_STAGE(PG8_SA(0, 1), cA + hstepA, voffA);
    if (wr == 1) PG8_BAR;
    PG8_WAIT_V(4); PG8_BAR;
    PG8_STAGE(PG8_SB(1, 0), cB + kstep, voffB); PG8_STAGE(PG8_SA(1, 0), cA + kstepA, voffA); PG8_STAGE(PG8_SB(1, 1), cB + hstepB + kstep, voffB);
    PG8_WAIT_V(6); PG8_BAR;
    for (;;) {
        const bool has_next = S.next(ui + 1, nxt);
        const char* nA = has_next ? (const char*)g.A + (size_t)nxt.pm * tstepA + (size_t)nxt.pn * g.agroup * 2 : cA; const char* nB = has_next ? (const char*)g.Bt + (size_t)nxt.pn * tstepB : cB;
        for (int t = 0; t < nt; t += 2) {
            const bool last = (t == nt - 2);
            const char* a1 = cA + (size_t)(t + 1) * kstepA;
            const char* a2 = last ? nA : cA + (size_t)(t + 2) * kstepA; const char* b2 = last ? nB : cB + (size_t)(t + 2) * kstep;
            const char* a3 = a2 + kstepA; const char* b3 = b2 + kstep;
            PG8_LDB(B0, 0, 0); PG8_SCHED; PG8_LDA(At, 0, 0); PG8_STAGE(PG8_SA(1, 1), a1 + hstepA, voffA);
            PG8_WAIT_L(8); PG8_BAR; PG8_WAIT_L(0); PG8_MMA(0, 0, At, B0); PG8_BAR; PG8_SCHED;
            PG8_LDB(B1, 0, 1); PG8_STAGE(PG8_SB(0, 0), b2, voffB);
            PG8_BAR; PG8_WAIT_L(0); PG8_MMA(0, 1, At, B1); PG8_BAR;
            PG8_LDA(At, 0, 1); PG8_STAGE(PG8_SA(0, 0), a2, voffA);
            PG8_BAR; PG8_WAIT_L(0); PG8_MMA(1, 0, At, B0); PG8_BAR; PG8_SCHED;
            PG8_STAGE(PG8_SB(0, 1), b2 + hstepB, voffB);
            PG8_WAIT_V(6); PG8_BAR; PG8_MMA(1, 1, At, B1); PG8_BAR;
            PG8_LDB(B0, 1, 0); PG8_SCHED; PG8_LDA(At, 1, 0); PG8_STAGE(PG8_SA(0, 1), a2 + hstepA, voffA);
            PG8_WAIT_L(8); PG8_BAR; PG8_WAIT_L(0); PG8_MMA(0, 0, At, B0); PG8_BAR; PG8_SCHED;
            PG8_LDB(B1, 1, 1); PG8_STAGE(PG8_SB(1, 0), b3, voffB);
            PG8_BAR; PG8_WAIT_L(0); PG8_MMA(0, 1, At, B1); PG8_BAR;
            PG8_LDA(At, 1, 1); PG8_STAGE(PG8_SA(1, 0), a3, voffA);
            PG8_BAR; PG8_WAIT_L(0); PG8_MMA(1, 0, At, B0); PG8_BAR; PG8_SCHED;
            PG8_STAGE(PG8_SB(1, 1), b3 + hstepB, voffB);
            PG8_WAIT_V(6); PG8_BAR; PG8_MMA(1, 1, At, B1); PG8_BAR;
        }
        if constexpr (!Epi::AFTER_DRAIN) E(acc, cur, wr, wc, fr, fq);
        if (!has_next) break;
#pragma unroll
        for (int a = 0; a < 2; ++a)
#pragma unroll
            for (int b = 0; b < 2; ++b)
#pragma unroll
                for (int m = 0; m < 4; ++m)
#pragma unroll
                    for (int n = 0; n < 2; ++n) acc[a][b][m][n] = (f32x4){0.f, 0.f, 0.f, 0.f};
        cur = nxt; cA = nA; cB = nB; ++ui;
    }
    PG8_WAIT_V(0);
    if (wr == 0) PG8_BAR;
    PG8_BAR;
    if constexpr (Epi::AFTER_DRAIN) E.fused(acc, cur, wr, wc, fr, fq, lds);
#undef PG8_SA
#undef PG8_SB
#undef PG8_STAGE
#undef PG8_LDA
#undef PG8_LDB
#undef PG8_MMA
#undef PG8_WAIT_V
#undef PG8_WAIT_L
#undef PG8_BAR
#undef PG8_SCHED
}
}

struct EpiIn {
    static constexpr bool AFTER_DRAIN = false;
    bf16_t *Q, *V, *OG; bf16_t* G; const float* lb;
    __device__ __forceinline__ void operator()(const f32x4 (&acc)[2][2][4][2], const pg8::Unit& u, int wr, int wc, int fr, int fq) const {
        const int sblk = u.pn >> 2, type = sblk == 2 ? 3 : (sblk == 3 ? 2 : sblk);
        const int row0 = u.pm * 256 + wr * 64 + fr, col0 = (u.pn & 3) * 256 + wc * 32 + 8 * fq;
        if (type == 1) {
            f32x4 lbv[2][2];
#pragma unroll
            for (int bj = 0; bj < 2; ++bj) { lbv[bj][0] = *(const f32x4*)(lb + col0 + bj * 128); lbv[bj][1] = *(const f32x4*)(lb + col0 + bj * 128 + 4); }
#pragma unroll
            for (int ai = 0; ai < 2; ++ai)
#pragma unroll
                for (int m = 0; m < 4; ++m) { bf16_t* rowp = G + (size_t)(row0 + ai * 128 + m * 16) * 1024 + col0;
#pragma unroll
                    for (int bj = 0; bj < 2; ++bj) { f32x4 o0, o1; const f32x4 l0 = lbv[bj][0], l1 = lbv[bj][1];
#pragma unroll
                        for (int e = 0; e < 4; ++e) { o0[e] = ein_elem(1, acc[ai][bj][m][0][e], l0[e]); o1[e] = ein_elem(1, acc[ai][bj][m][1][e], l1[e]); }
                        u32x4 w; w.x = cvt_pk_f16(o0[0], o0[1]); w.y = cvt_pk_f16(o0[2], o0[3]); w.z = cvt_pk_f16(o1[0], o1[1]); w.w = cvt_pk_f16(o1[2], o1[3]);
                        *(u32x4*)(rowp + bj * 128) = w; }
                    asm volatile("" ::: "memory"); }
        } else {
            bf16_t* base = Q + (size_t)(type == 0 ? 0 : type - 1) * (ACT_B / 2);
            if (type == 0) store_bf16<0>(acc, base, row0, col0);
            else if (type == 2) store_bf16<2>(acc, base, row0, col0);
            else store_bf16<3>(acc, base, row0, col0);
        }
    }
    template <int TYPE> __device__ __forceinline__ void store_bf16(const f32x4 (&acc)[2][2][4][2], bf16_t* base, int row0, int col0) const {
#pragma unroll
        for (int ai = 0; ai < 2; ++ai)
#pragma unroll
            for (int m = 0; m < 4; ++m) { bf16_t* rowp = base + (size_t)(row0 + ai * 128 + m * 16) * 1024 + col0;
#pragma unroll
                for (int bj = 0; bj < 2; ++bj) { f32x4 o0, o1;
#pragma unroll
                    for (int e = 0; e < 4; ++e) { o0[e] = ein_elem(TYPE, acc[ai][bj][m][0][e], 0.f); o1[e] = ein_elem(TYPE, acc[ai][bj][m][1][e], 0.f); }
                    u32x4 w; w.x = cvt_pk_bf16(o0[0], o0[1]); w.y = cvt_pk_bf16(o0[2], o0[3]); w.z = cvt_pk_bf16(o1[0], o1[1]); w.w = cvt_pk_bf16(o1[2], o1[3]);
                    *(u32x4*)(rowp + bj * 128) = w; }
                asm volatile("" ::: "memory"); }
    }
};
template <bool IN16, bool OUT32> struct EpiRes {
    static constexpr bool AFTER_DRAIN = false;
    const float* Xin32; const bf16_t* Xin16; float* Xout32; bf16_t* Xb; const float* scale; float* part;
    __device__ __forceinline__ void operator()(const f32x4 (&acc)[2][2][4][2], const pg8::Unit& u, int wr, int wc, int fr, int fq) const {
        const int row0 = u.pm * 256 + wr * 64 + fr, col0 = u.pn * 256 + wc * 32 + 8 * fq;
        constexpr int NB = 2;
        f32x4 sc[2][2];
#pragma unroll
        for (int bj = 0; bj < 2; ++bj) { sc[bj][0] = scale ? *(const f32x4*)(scale + col0 + bj * 128) : (f32x4){1.f, 1.f, 1.f, 1.f}; sc[bj][1] = scale ? *(const f32x4*)(scale + col0 + bj * 128 + 4) : (f32x4){1.f, 1.f, 1.f, 1.f}; }
        constexpr int AIB = 2 / NB;
#pragma unroll
        for (int bt = 0; bt < NB; ++bt) {
            f32x4 xr[AIB][4][2][IN16 ? 1 : 2];
#pragma unroll
            for (int a2 = 0; a2 < AIB; ++a2)
#pragma unroll
                for (int m = 0; m < 4; ++m) { const int ai = bt * AIB + a2; const size_t off = (size_t)(row0 + ai * 128 + m * 16) * 1024 + col0;
#pragma unroll
                    for (int bj = 0; bj < 2; ++bj) {
                        if (IN16) xr[a2][m][bj][0] = __builtin_bit_cast(f32x4, *(const u32x4*)(Xin16 + off + bj * 128));
                        else { xr[a2][m][bj][0] = *(const f32x4*)(Xin32 + off + bj * 128); xr[a2][m][bj][IN16 ? 0 : 1] = *(const f32x4*)(Xin32 + off + bj * 128 + 4); } } }
#pragma unroll
            for (int a2 = 0; a2 < AIB; ++a2)
#pragma unroll
                for (int m = 0; m < 4; ++m) { const int ai = bt * AIB + a2; const int row = row0 + ai * 128 + m * 16; const size_t off = (size_t)row * 1024 + col0; float ss = 0.f;
#pragma unroll
                    for (int bj = 0; bj < 2; ++bj) {
                        const f32x4 a0 = acc[ai][bj][m][0] * sc[bj][0], a1 = acc[ai][bj][m][1] * sc[bj][1];
                        f32x4 x0, x1;
                        if (IN16) { const u32x4 w = __builtin_bit_cast(u32x4, xr[a2][m][bj][0]); x0 = (f32x4){bflo(w.x), bfhi(w.x), bflo(w.y), bfhi(w.y)}; x1 = (f32x4){bflo(w.z), bfhi(w.z), bflo(w.w), bfhi(w.w)}; }
                        else { x0 = xr[a2][m][bj][0]; x1 = xr[a2][m][bj][IN16 ? 0 : 1]; }
                        x0 = x0 + a0; x1 = x1 + a1;
                        if (OUT32) { *(f32x4*)(Xout32 + off + bj * 128) = x0; *(f32x4*)(Xout32 + off + bj * 128 + 4) = x1; }
                        if (Xb) { u32x4 w; w.x = cvt_pk_bf16(x0[0], x0[1]); w.y = cvt_pk_bf16(x0[2], x0[3]); w.z = cvt_pk_bf16(x1[0], x1[1]); w.w = cvt_pk_bf16(x1[2], x1[3]); *(u32x4*)(Xb + off + bj * 128) = w; }
                        ss += x0[0] * x0[0] + x0[1] * x0[1] + x0[2] * x0[2] + x0[3] * x0[3] + x1[0] * x1[0] + x1[1] * x1[1] + x1[2] * x1[2] + x1[3] * x1[3]; }
                    ss += __shfl_xor(ss, 16); ss += __shfl_xor(ss, 32);
                    if (fq == 0 && part) part[(size_t)row * 16 + u.pn * 4 + wc] = ss; }
            asm volatile("" ::: "memory"); }
    }
};
struct EpiFinal {
    static constexpr bool AFTER_DRAIN = true;
    const bf16_t* Xin16; float* Y; const float* gfin; float* part; unsigned* cnt;
    __device__ __forceinline__ void fused(f32x4 (&acc)[2][2][4][2], const pg8::Unit& u, int wr, int wc, int fr, int fq, LAS unsigned char* lds) const {
        const int row0 = u.pm * 256 + wr * 64 + fr, col0 = u.pn * 256 + wc * 32 + 8 * fq;
        u32x4 xr[2][4][2];
#pragma unroll
        for (int ai = 0; ai < 2; ++ai)
#pragma unroll
            for (int m = 0; m < 4; ++m) { const size_t off = (size_t)(row0 + ai * 128 + m * 16) * 1024 + col0;
#pragma unroll
                for (int bj = 0; bj < 2; ++bj) xr[ai][m][bj] = *(const u32x4*)(Xin16 + off + bj * 128); }
#pragma unroll
        for (int ai = 0; ai < 2; ++ai) {
#pragma unroll
            for (int m = 0; m < 4; ++m) { const int row = row0 + ai * 128 + m * 16; float ss = 0.f;
#pragma unroll
                for (int bj = 0; bj < 2; ++bj) { const u32x4 w = xr[ai][m][bj];
                    const f32x4 x0 = (f32x4){bflo(w.x), bfhi(w.x), bflo(w.y), bfhi(w.y)} + acc[ai][bj][m][0], x1 = (f32x4){bflo(w.z), bfhi(w.z), bflo(w.w), bfhi(w.w)} + acc[ai][bj][m][1];
                    acc[ai][bj][m][0] = x0; acc[ai][bj][m][1] = x1;
                    ss += x0[0] * x0[0] + x0[1] * x0[1] + x0[2] * x0[2] + x0[3] * x0[3] + x1[0] * x1[0] + x1[1] * x1[1] + x1[2] * x1[2] + x1[3] * x1[3]; }
                ss += __shfl_xor(ss, 16); ss += __shfl_xor(ss, 32);
                if (fq == 0) __hip_atomic_store(part + (size_t)row * 16 + u.pn * 4 + wc, ss, __ATOMIC_RELAXED, __HIP_MEMORY_SCOPE_AGENT); }
            asm volatile("" ::: "memory"); }
        asm volatile("s_waitcnt vmcnt(0)" ::: "memory");
        __syncthreads();
        if (threadIdx.x == 0) {
            __hip_atomic_fetch_add(cnt + u.pm, 1u, __ATOMIC_RELAXED, __HIP_MEMORY_SCOPE_AGENT);
            unsigned sp = 0;
            while (__hip_atomic_load(cnt + u.pm, __ATOMIC_RELAXED, __HIP_MEMORY_SCOPE_AGENT) < 4u) { __builtin_amdgcn_s_sleep(1); if (++sp > (1u << 20)) break; }
        }
        __syncthreads();
        LAS float* rsl = (LAS float*)lds;
        if (threadIdx.x < 256) { const float* pr = part + (size_t)(u.pm * 256 + threadIdx.x) * 16; float sq = 0.f;
#pragma unroll
            for (int i = 0; i < 16; ++i) sq += __hip_atomic_load(pr + i, __ATOMIC_RELAXED, __HIP_MEMORY_SCOPE_AGENT);
            rsl[threadIdx.x] = rsqrtf(sq * (1.f / 1024.f) + EPS); }
        __syncthreads();
#pragma unroll
        for (int ai = 0; ai < 2; ++ai)
#pragma unroll
            for (int m = 0; m < 4; ++m) { const int rl = ai * 128 + wr * 64 + m * 16 + fr; const float rs = rsl[rl]; float* yp = Y + (size_t)(u.pm * 256 + rl) * 1024 + col0;
#pragma unroll
                for (int bj = 0; bj < 2; ++bj) { const f32x4 g0 = *(const f32x4*)(gfin + col0 + bj * 128), g1 = *(const f32x4*)(gfin + col0 + bj * 128 + 4);
                    __builtin_nontemporal_store(acc[ai][bj][m][0] * rs * g0, (f32x4*)(yp + bj * 128)); __builtin_nontemporal_store(acc[ai][bj][m][1] * rs * g1, (f32x4*)(yp + bj * 128 + 4)); } }
        __syncthreads();
    }
};
struct EpiNull { float* sink; static constexpr bool AFTER_DRAIN = false;
    __device__ __forceinline__ void operator()(const f32x4 (&acc)[2][2][4][2], const pg8::Unit& u, int wr, int wc, int fr, int fq) const {
        f32x4 t = (f32x4){0.f, 0.f, 0.f, 0.f};
#pragma unroll
        for (int a = 0; a < 2; ++a)
#pragma unroll
            for (int b = 0; b < 2; ++b)
#pragma unroll
                for (int m = 0; m < 4; ++m)
#pragma unroll
                    for (int n = 0; n < 2; ++n) t = t + acc[a][b][m][n];
        if (t[0] + t[1] + t[2] + t[3] == 12345.678f) sink[0] = 1.f; } };
struct SNull { float* sink; __device__ __forceinline__ void rowpart(int, int, float) const {}
    __device__ __forceinline__ float operator()(int r, int c, f32x4 v) const { if (v[0] + v[1] + v[2] + v[3] == 12345.678f) sink[0] = 1.f; return 0.f; } };
struct EpiUp {
    static constexpr bool AFTER_DRAIN = false;
    bf16_t* H; const float* part;
    __device__ __forceinline__ void operator()(const f32x4 (&acc)[2][2][4][2], const pg8::Unit& u, int wr, int wc, int fr, int fq) const {
        const int row0 = u.pm * 256 + wr * 64 + fr, col0 = u.pn * 256 + wc * 32 + 8 * fq;
        f32x4 pv[2][4]; float rs[2][4];
#pragma unroll
        for (int ai = 0; ai < 2; ++ai)
#pragma unroll
            for (int m = 0; m < 4; ++m) pv[ai][m] = *(const f32x4*)(part + (size_t)(row0 + ai * 128 + m * 16) * 16 + fq * 4);
#pragma unroll
        for (int ai = 0; ai < 2; ++ai)
#pragma unroll
            for (int m = 0; m < 4; ++m) { float sq = (pv[ai][m][0] + pv[ai][m][1]) + (pv[ai][m][2] + pv[ai][m][3]); sq += __shfl_xor(sq, 16); sq += __shfl_xor(sq, 32); rs[ai][m] = rsqrtf(sq * (1.f / 1024.f) + EPS); }
#pragma unroll
        for (int ai = 0; ai < 2; ++ai)
#pragma unroll
            for (int m = 0; m < 4; ++m) { const int row = row0 + ai * 128 + m * 16; const float r = rs[ai][m]; bf16_t* rowp = H + ((size_t)(row >> 8) * 64 + (col0 >> 6)) * 16384 + (size_t)(row & 255) * 64 + (col0 & 63);
#pragma unroll
                for (int bj = 0; bj < 2; ++bj) { f32x4 o0, o1;
#pragma unroll
                    for (int e = 0; e < 4; ++e) { float a = fmaxf(acc[ai][bj][m][0][e] * r, 0.f), b2 = fmaxf(acc[ai][bj][m][1][e] * r, 0.f); o0[e] = a * a; o1[e] = b2 * b2; }
                    u32x4 w; w.x = cvt_pk_bf16(o0[0], o0[1]); w.y = cvt_pk_bf16(o0[2], o0[3]); w.z = cvt_pk_bf16(o1[0], o1[1]); w.w = cvt_pk_bf16(o1[2], o1[3]);
                    *(u32x4*)(rowp + (size_t)bj * 2 * 16384) = w; } }
    }
};

template <int NCT, class F>
__device__ __forceinline__ void sample_gemm(LAS unsigned char* lds, const bf16_t* A, int lda, int agroup, const bf16_t* Bt, int K, const F& f) {
    constexpr int CT = NCT * 16;
    const int tid = threadIdx.x, wid = tid >> 6, lane = tid & 63, fr = lane & 15, fq = lane >> 4;
    LAS float* red = (LAS float*)lds;
    for (int blk = blockIdx.x; blk < 256; blk += gridDim.x) {
        const int rb = blk & 3, cb = blk >> 2, r0 = rb * 32, c0 = cb * CT;
        const int Kw = K >> 3, kb = wid * Kw;
        const bf16_t* Ab = A + (size_t)(c0 >> 8) * agroup;
        f32x4 acc[2][NCT];
#pragma unroll
        for (int i = 0; i < 2; ++i)
#pragma unroll
            for (int j = 0; j < NCT; ++j) acc[i][j] = (f32x4){0.f, 0.f, 0.f, 0.f};
        constexpr int UN = NCT == 1 ? 8 : 2;
        for (int k = kb; k < kb + Kw; k += 32 * UN) {
            bf16x8 af[UN][2], bfr[UN][NCT];
#pragma unroll
            for (int uu = 0; uu < UN; ++uu) { const int ku = k + 32 * uu; const bool ok = ku < kb + Kw;
#pragma unroll
                for (int i = 0; i < 2; ++i) af[uu][i] = ok ? *(const bf16x8*)(Ab + (size_t)(r0 + i * 16 + fr) * lda + ku + fq * 8) : (bf16x8){0, 0, 0, 0, 0, 0, 0, 0};
#pragma unroll
                for (int j = 0; j < NCT; ++j) bfr[uu][j] = ok ? *(const bf16x8*)(Bt + (size_t)(c0 + j * 16 + fr) * K + ku + fq * 8) : (bf16x8){0, 0, 0, 0, 0, 0, 0, 0}; }
#pragma unroll
            for (int uu = 0; uu < UN; ++uu)
#pragma unroll
                for (int i = 0; i < 2; ++i)
#pragma unroll
                    for (int j = 0; j < NCT; ++j) acc[i][j] = __builtin_amdgcn_mfma_f32_16x16x32_bf16(bfr[uu][j], af[uu][i], acc[i][j], 0, 0, 0);
        }
#pragma unroll
        for (int i = 0; i < 2; ++i)
#pragma unroll
            for (int j = 0; j < NCT; ++j) *(LAS f32x4*)(red + ((size_t)wid * 32 + i * 16 + fr) * CT + j * 16 + fq * 4) = acc[i][j];
        __syncthreads();
        constexpr int NG = 32 * CT / 4;
        for (int i = tid; i < NG; i += 512) { const int row = i / (CT / 4), cgp = i % (CT / 4);
            f32x4 s = (f32x4){0.f, 0.f, 0.f, 0.f};
#pragma unroll
            for (int w = 0; w < 8; ++w) s = s + *(const LAS f32x4*)(red + ((size_t)w * 32 + row) * CT + cgp * 4);
            float ss = f(r0 + row, c0 + cgp * 4, s);
#pragma unroll
            for (int o = 1; o < CT / 4; o <<= 1) ss += __shfl_xor(ss, o);
            if (cgp == 0) f.rowpart(r0 + row, cb, ss); }
        __syncthreads();
    }
}
struct SIn { bf16_t *Q, *V, *OG; bf16_t* G; const float* lb;
    __device__ __forceinline__ void rowpart(int, int, float) const {}
    __device__ __forceinline__ float operator()(int r, int c, f32x4 v) const { const int sblk = c >> 10, type = sblk == 2 ? 3 : (sblk == 3 ? 2 : sblk), cc = c & 1023; const size_t off = (size_t)(TP + r) * 1024 + cc;
        if (type == 1) { f32x4 o;
#pragma unroll
            for (int e = 0; e < 4; ++e) o[e] = ein_elem(1, v[e], lb[cc + e]);
            u32x2 w; w.x = cvt_pk_f16(o[0], o[1]); w.y = cvt_pk_f16(o[2], o[3]); *(u32x2*)(G + off) = w; }
        else { bf16_t* base = Q + (size_t)(type == 0 ? 0 : type - 1) * (ACT_B / 2); f32x4 o;
            if (type == 0) {
#pragma unroll
                for (int e = 0; e < 4; ++e) o[e] = ein_elem(0, v[e], 0.f); }
            else if (type == 2) o = v;
            else {
#pragma unroll
                for (int e = 0; e < 4; ++e) o[e] = ein_elem(3, v[e], 0.f); }
            u32x2 w; w.x = cvt_pk_bf16(o[0], o[1]); w.y = cvt_pk_bf16(o[2], o[3]); *(u32x2*)(base + off) = w; } return 0.f; } };
struct SRes { const float* Xin; float* Xout; bf16_t* Xb; const float* scale; float* parts;
    __device__ __forceinline__ void rowpart(int r, int cb, float ss) const { if (parts) parts[r * 64 + cb] = ss; }
    __device__ __forceinline__ float operator()(int r, int c, f32x4 v) const { const size_t off = (size_t)r * 1024 + c;
        f32x4 x = *(const f32x4*)(Xin + off); if (scale) v = v * *(const f32x4*)(scale + c); x = x + v; *(f32x4*)(Xout + off) = x;
        if (Xb) { u32x2 w; w.x = cvt_pk_bf16(x[0], x[1]); w.y = cvt_pk_bf16(x[2], x[3]); *(u32x2*)(Xb + off) = w; }
        return x[0] * x[0] + x[1] * x[1] + x[2] * x[2] + x[3] * x[3]; } };
struct SUp { bf16_t* H; const float* parts;
    __device__ __forceinline__ void rowpart(int, int, float) const {}
    __device__ __forceinline__ float operator()(int r, int c, f32x4 v) const { f32x4 t = (f32x4){0.f, 0.f, 0.f, 0.f};
#pragma unroll
        for (int i = 0; i < 16; ++i) t = t + *(const f32x4*)(parts + r * 64 + i * 4);
        const float rs = rsqrtf(((t[0] + t[1]) + (t[2] + t[3])) * (1.f / 1024.f) + EPS); f32x4 o;
#pragma unroll
        for (int e = 0; e < 4; ++e) { float a = fmaxf(v[e] * rs, 0.f); o[e] = a * a; }
        u32x2 w; w.x = cvt_pk_bf16(o[0], o[1]); w.y = cvt_pk_bf16(o[2], o[3]); *(u32x2*)(H + (size_t)r * 4096 + c) = w; return 0.f; } };

struct TJob { const float* src; bf16_t* dst; const float* gain; int N, ldd, k0, n0; };
__device__ __forceinline__ bool prep_job(const Params& p, int it, TJob& j) {
    unsigned char* ws = p.ws;
    constexpr int T_IN = 1024, T_OUT = 256, T_UP = 1024, T_DN = 1024, T_P = 64;
    constexpr int NT = T_IN + T_OUT + 2 * T_UP + 2 * T_DN + T_P;
    if (it >= NT) return false;
    int r = it; j.gain = nullptr;
    if (r < T_IN) { j.src = p.hgrn_w_in; j.N = 4096; j.dst = (bf16_t*)(ws + WS_WIN); j.ldd = 1024; j.k0 = (r >> 6) * 64; j.n0 = (r & 63) * 64; return true; } r -= T_IN;
    if (r < T_OUT) { j.src = p.hgrn_w_out; j.N = 1024; j.dst = (bf16_t*)(ws + WS_WOUT); j.ldd = 1024; j.k0 = (r >> 4) * 64; j.n0 = (r & 15) * 64; return true; } r -= T_OUT;
    if (r < T_UP) { j.src = p.mlp_up; j.N = 4096; j.dst = (bf16_t*)(ws + WS_WUP0); j.ldd = 1024; j.k0 = (r >> 6) * 64; j.n0 = (r & 63) * 64; j.gain = p.mlp_norm; return true; } r -= T_UP;
    if (r < T_UP) { j.src = p.mlp_up + (size_t)1024 * 4096; j.N = 4096; j.dst = (bf16_t*)(ws + WS_WUP1); j.ldd = 1024; j.k0 = (r >> 6) * 64; j.n0 = (r & 63) * 64; j.gain = p.mlp_norm + 1024; return true; } r -= T_UP;
    if (r < T_DN) { j.src = p.mlp_down; j.N = 1024; j.dst = (bf16_t*)(ws + WS_WDN0); j.ldd = 4096; j.k0 = (r >> 4) * 64; j.n0 = (r & 15) * 64; return true; } r -= T_DN;
    if (r < T_DN) { j.src = p.mlp_down + (size_t)4096 * 1024; j.N = 1024; j.dst = (bf16_t*)(ws + WS_WDN1); j.ldd = 4096; j.k0 = (r >> 4) * 64; j.n0 = (r & 15) * 64; return true; } r -= T_DN;
    { const int g = r >> 4, rr = r & 15; j.src = p.pool_w + (size_t)g * 65536; j.N = 256; j.dst = (bf16_t*)(ws + WS_WP) + (size_t)g * 65536; j.ldd = 256; j.k0 = (rr >> 2) * 64; j.n0 = (rr & 3) * 64; }
    return true;
}
__device__ __forceinline__ void phase_prep(const Params& p, LAS unsigned char* lds) {
    LAS float* tiles = (LAS float*)lds;
    unsigned char* ws = p.ws;
    constexpr int NT = 1024 + 256 + 2 * 1024 + 2 * 1024 + 64;
    { const int tid = threadIdx.x, i = tid >> 4, j4 = (tid & 15) * 4, n = tid >> 3, k8 = (tid & 7) * 8;
#pragma unroll 1
      for (int it0 = blockIdx.x; it0 < NT; it0 += 2 * gridDim.x) {
          TJob j[2]; bool ok[2]; f32x4 v[2][2];
#pragma unroll
          for (int q = 0; q < 2; ++q) { ok[q] = prep_job(p, it0 + q * gridDim.x, j[q]);
              if (ok[q]) {
#pragma unroll
                  for (int hh = 0; hh < 2; ++hh) v[q][hh] = __builtin_nontemporal_load((const f32x4*)(j[q].src + (size_t)(j[q].k0 + i + 32 * hh) * j[q].N + j[q].n0 + j4)); } }
#pragma unroll
          for (int q = 0; q < 2; ++q) if (ok[q]) {
#pragma unroll
              for (int hh = 0; hh < 2; ++hh)
#pragma unroll
                  for (int e = 0; e < 4; ++e) tiles[q * 4160 + (j4 + e) * 65 + i + 32 * hh] = v[q][hh][e]; }
          __syncthreads();
#pragma unroll
          for (int q = 0; q < 2; ++q) if (ok[q]) { float o[8];
#pragma unroll
              for (int e = 0; e < 8; ++e) { o[e] = tiles[q * 4160 + n * 65 + k8 + e]; if (j[q].gain) o[e] *= j[q].gain[j[q].k0 + k8 + e]; }
              u32x4 w; w.x = cvt_pk_bf16(o[0], o[1]); w.y = cvt_pk_bf16(o[2], o[3]); w.z = cvt_pk_bf16(o[4], o[5]); w.w = cvt_pk_bf16(o[6], o[7]);
              int nd = j[q].n0; if (j[q].src == p.hgrn_w_in) { const int ob = nd >> 10; nd = (nd & 1023) + ((ob == 2 ? 3 : ob == 3 ? 2 : ob) << 10); }
              *(u32x4*)(j[q].dst + (size_t)(nd + n) * j[q].ldd + j[q].k0 + k8) = w; }
          __syncthreads();
      } }
    const int tid = threadIdx.x, wid = tid >> 6, lane = tid & 63;
    bf16_t* U = (bf16_t*)(ws + WS_R2);
    for (int row0 = blockIdx.x * 8 + wid; row0 < MP; row0 += gridDim.x * 32) {
        f32x4 v[4][4];
#pragma unroll
        for (int rr = 0; rr < 4; ++rr) { const int row = row0 + rr * gridDim.x * 8; if (row < MP) { const float* src = row < TP ? p.x_prompt + (size_t)row * 1024 : p.x_sample + (size_t)(row - TP) * 1024;
#pragma unroll
            for (int j = 0; j < 4; ++j) v[rr][j] = *(const f32x4*)(src + lane * 4 + 256 * j); } }
#pragma unroll
        for (int rr = 0; rr < 4; ++rr) { const int row = row0 + rr * gridDim.x * 8; if (row < MP) { float sacc = 0.f;
#pragma unroll
            for (int j = 0; j < 4; ++j) sacc += v[rr][j][0] * v[rr][j][0] + v[rr][j][1] * v[rr][j][1] + v[rr][j][2] * v[rr][j][2] + v[rr][j][3] * v[rr][j][3];
            const float rs = rsqrtf(wave_sum(sacc) * (1.f / 1024.f) + EPS);
#pragma unroll
            for (int j = 0; j < 4; ++j) { const f32x4 g = *(const f32x4*)(p.hgrn_norm + lane * 4 + 256 * j);
                u32x2 w; w.x = cvt_pk_bf16(v[rr][j][0] * rs * g[0], v[rr][j][1] * rs * g[1]); w.y = cvt_pk_bf16(v[rr][j][2] * rs * g[2], v[rr][j][3] * rs * g[3]);
                *(u32x2*)(U + (size_t)row * 1024 + lane * 4 + 256 * j) = w; } } }
    }
    if (blockIdx.x < 2) { const int c = blockIdx.x * 512 + tid; ((float*)(ws + WS_LB))[c] = lb_of(p.hgrn_lb, c); }
}

__device__ __forceinline__ bf16x8 lds_frag(const LAS bf16_t* p) { return *(const LAS bf16x8*)p; }
__device__ __forceinline__ void rec_prompt(const Params& p, LAS unsigned char* lds, int b, int h, int seg) {
    const int tid = threadIdx.x, wid = tid >> 6, lane = tid & 63, fr = lane & 15, fq = lane >> 4;
    LAS bf16_t* QT = (LAS bf16_t*)(lds + 0);
    LAS bf16_t* KT = (LAS bf16_t*)(lds + 17408);
    LAS bf16_t* KH = (LAS bf16_t*)(lds + 34816);
    LAS bf16_t* VT = (LAS bf16_t*)(lds + 53248);
    LAS bf16_t* SB = (LAS bf16_t*)(lds + 71680);
    LAS bf16_t* AM = (LAS bf16_t*)(lds + 106496);
    LAS float* TOT = (LAS float*)(lds + 115712);
    LAS float* DD = (LAS float*)(lds + 119808);
    LAS float* SSQ = (LAS float*)(lds + 120320);
    const unsigned char* ws = p.ws;
    const size_t gbase = (size_t)b * SEQ * 1024 + h * 128;
    const bf16_t* Qg = (const bf16_t*)(ws + WS_Q) + gbase; const bf16_t* Vg = (const bf16_t*)(ws + WS_V) + gbase; const bf16_t* OGg = (const bf16_t*)(ws + WS_OG) + gbase;
    const bf16_t* Gg = (const bf16_t*)(ws + WS_G) + gbase;
    bf16_t* Og = (bf16_t*)(p.ws + WS_R2) + gbase;
    bf16_t* QCg = (bf16_t*)(p.ws + WS_R2) + gbase;
    float* OLg = p.out + gbase;
    f32x2 Gseg = (f32x2){0.f, 0.f};
    f32x4 Sacc[8];
#pragma unroll
    for (int i = 0; i < 8; ++i) Sacc[i] = (f32x4){0.f, 0.f, 0.f, 0.f};
    const int d2 = (tid & 63) * 2, part = tid >> 6;
    unsigned gr[8], qr[8], vr[8];
#define REC_LOAD(c) do { const unsigned o_ = (unsigned)(((c) * 64 + part * 8) * 1024 + d2); \
        _Pragma("unroll") for (int i = 0; i < 8; ++i) { gr[i] = *(const unsigned*)(Gg + o_ + (unsigned)i * 1024u); qr[i] = *(const unsigned*)(Qg + o_ + (unsigned)i * 1024u); vr[i] = *(const unsigned*)(Vg + o_ + (unsigned)i * 1024u); } } while (0)
    REC_LOAD(seg * 8);
    const int tb = wid & 3, vh = wid >> 2;
    for (int cc = 0; cc < 8; ++cc) {
        const int c = seg * 8 + cc;
#pragma unroll
        for (int vb = 0; vb < 8; ++vb) { u32x2 w; w.x = cvt_pk_bf16(Sacc[vb][0], Sacc[vb][1]); w.y = cvt_pk_bf16(Sacc[vb][2], Sacc[vb][3]);
            *(LAS u32x2*)(SB + (vb * 16 + fr) * 136 + wid * 16 + fq * 4) = w; }
        f32x2 cs[8];
        { f32x2 run = (f32x2){0.f, 0.f};
#pragma unroll
          for (int i = 0; i < 8; ++i) { run = run + h2_to_f2(gr[i]); cs[i] = run; }
          *(LAS f32x2*)(TOT + part * 128 + d2) = run; }
        __syncthreads();
        { f32x2 off = (f32x2){0.f, 0.f}, Gl = (f32x2){0.f, 0.f};
#pragma unroll
          for (int pp = 0; pp < 8; ++pp) { const f32x2 tv = *(const LAS f32x2*)(TOT + pp * 128 + d2); Gl = Gl + tv; if (pp < part) off = off + tv; }
          const float eGl0 = __expf(Gl[0]), eGl1 = __expf(Gl[1]), eGs0 = __expf(Gseg[0]), eGs1 = __expf(Gseg[1]);
          float kh0[8], kh1[8];
#pragma unroll
          for (int i = 0; i < 8; ++i) { const int t = part * 8 + i; const f32x2 G = off + cs[i];
              const float e0 = __expf(G[0]), e1 = __expf(G[1]), ei0 = __builtin_amdgcn_rcpf(e0), ei1 = __builtin_amdgcn_rcpf(e1);
              const f32x2 gv = h2_to_f2(gr[i]); const float k0 = 1.f - __expf(gv[0]), k1 = 1.f - __expf(gv[1]);
              const float q0 = bflo(qr[i]) * e0, q1 = bfhi(qr[i]) * e1;
              *(LAS unsigned*)(QT + t * 136 + d2) = cvt_pk_bf16(q0, q1); *(LAS unsigned*)(KT + t * 136 + d2) = cvt_pk_bf16(k0 * ei0, k1 * ei1);
              kh0[i] = k0 * eGl0 * ei0; kh1[i] = k1 * eGl1 * ei1;
              if (seg > 0) *(unsigned*)(QCg + (unsigned)((c * 64 + t) * 1024 + d2)) = cvt_pk_bf16(q0 * eGs0, q1 * eGs1); }
          Gseg = Gseg + Gl;
          u32x4 w0, w1; w0.x = cvt_pk_bf16(kh0[0], kh0[1]); w0.y = cvt_pk_bf16(kh0[2], kh0[3]); w0.z = cvt_pk_bf16(kh0[4], kh0[5]); w0.w = cvt_pk_bf16(kh0[6], kh0[7]);
          w1.x = cvt_pk_bf16(kh1[0], kh1[1]); w1.y = cvt_pk_bf16(kh1[2], kh1[3]); w1.z = cvt_pk_bf16(kh1[4], kh1[5]); w1.w = cvt_pk_bf16(kh1[6], kh1[7]);
          *(LAS u32x4*)(KH + d2 * 72 + part * 8) = w0; *(LAS u32x4*)(KH + (d2 + 1) * 72 + part * 8) = w1;
          u32x4 v0, v1;
          v0.x = (vr[0] & 0xffffu) | (vr[1] << 16); v0.y = (vr[2] & 0xffffu) | (vr[3] << 16); v0.z = (vr[4] & 0xffffu) | (vr[5] << 16); v0.w = (vr[6] & 0xffffu) | (vr[7] << 16);
          v1.x = (vr[0] >> 16) | (vr[1] & 0xffff0000u); v1.y = (vr[2] >> 16) | (vr[3] & 0xffff0000u); v1.z = (vr[4] >> 16) | (vr[5] & 0xffff0000u); v1.w = (vr[6] >> 16) | (vr[7] & 0xffff0000u);
          *(LAS u32x4*)(VT + d2 * 72 + part * 8) = v0; *(LAS u32x4*)(VT + (d2 + 1) * 72 + part * 8) = v1;
          if (part == 0) *(LAS f32x2*)(DD + d2) = (f32x2){eGl0, eGl1}; }
        if (cc + 1 < 8) REC_LOAD(c + 1);
        __syncthreads();
        { const int sb = wid >> 1;
#pragma unroll
          for (int ti = 0; ti < 2; ++ti) { const int tbb = (wid & 1) * 2 + ti; f32x4 a = (f32x4){0.f, 0.f, 0.f, 0.f};
              if (sb <= tbb) {
#pragma unroll
                  for (int kk = 0; kk < 4; ++kk) a = __builtin_amdgcn_mfma_f32_16x16x32_bf16(lds_frag(KT + (sb * 16 + fr) * 136 + kk * 32 + fq * 8), lds_frag(QT + (tbb * 16 + fr) * 136 + kk * 32 + fq * 8), a, 0, 0, 0);
                  const int t = tbb * 16 + fr, s0 = sb * 16 + fq * 4;
#pragma unroll
                  for (int j = 0; j < 4; ++j) if (s0 + j > t) a[j] = 0.f; }
              u32x2 w; w.x = cvt_pk_bf16(a[0], a[1]); w.y = cvt_pk_bf16(a[2], a[3]);
              *(LAS u32x2*)(AM + (tbb * 16 + fr) * 72 + sb * 16 + fq * 4) = w; } }
        { const f32x4 dd = *(const LAS f32x4*)(DD + wid * 16 + fq * 4);
          const bf16x8 a0 = lds_frag(KH + (wid * 16 + fr) * 72 + fq * 8), a1 = lds_frag(KH + (wid * 16 + fr) * 72 + 32 + fq * 8);
#pragma unroll
          for (int vb = 0; vb < 8; ++vb) { f32x4 a = Sacc[vb] * dd;
              a = __builtin_amdgcn_mfma_f32_16x16x32_bf16(a0, lds_frag(VT + (vb * 16 + fr) * 72 + fq * 8), a, 0, 0, 0);
              a = __builtin_amdgcn_mfma_f32_16x16x32_bf16(a1, lds_frag(VT + (vb * 16 + fr) * 72 + 32 + fq * 8), a, 0, 0, 0);
              Sacc[vb] = a; } }
        __syncthreads();
        f32x4 oacc[4]; u32x2 ogv[4];
        const size_t tok = (size_t)c * 64 + tb * 16 + fr;
        if (seg == 0) {
#pragma unroll
        for (int vi = 0; vi < 4; ++vi) ogv[vi] = *(const u32x2*)(OGg + tok * 1024 + (vh * 4 + vi) * 16 + fq * 4); }
        { bf16x8 qf[4], af[2];
#pragma unroll
          for (int kk = 0; kk < 4; ++kk) qf[kk] = lds_frag(QT + (tb * 16 + fr) * 136 + kk * 32 + fq * 8);
#pragma unroll
          for (int kk = 0; kk < 2; ++kk) af[kk] = lds_frag(AM + (tb * 16 + fr) * 72 + kk * 32 + fq * 8);
#pragma unroll
          for (int vi = 0; vi < 4; ++vi) { const int vb = vh * 4 + vi; f32x4 a = (f32x4){0.f, 0.f, 0.f, 0.f};
#pragma unroll
              for (int kk = 0; kk < 4; ++kk) a = __builtin_amdgcn_mfma_f32_16x16x32_bf16(lds_frag(SB + (vb * 16 + fr) * 136 + kk * 32 + fq * 8), qf[kk], a, 0, 0, 0);
#pragma unroll
              for (int kk = 0; kk < 2; ++kk) a = __builtin_amdgcn_mfma_f32_16x16x32_bf16(lds_frag(VT + (vb * 16 + fr) * 72 + kk * 32 + fq * 8), af[kk], a, 0, 0, 0);
              oacc[vi] = a; } }
        if (seg == 0) {
        { float ss = 0.f;
#pragma unroll
          for (int vi = 0; vi < 4; ++vi) ss += oacc[vi][0] * oacc[vi][0] + oacc[vi][1] * oacc[vi][1] + oacc[vi][2] * oacc[vi][2] + oacc[vi][3] * oacc[vi][3];
          ss += __shfl_xor(ss, 16); ss += __shfl_xor(ss, 32);
          if (fq == 0) SSQ[vh * 64 + tb * 16 + fr] = ss; }
        __syncthreads();
        { const float tot = SSQ[tb * 16 + fr] + SSQ[64 + tb * 16 + fr]; const float rs = rsqrtf(tot * (1.f / 128.f) + EPS);
#pragma unroll
          for (int vi = 0; vi < 4; ++vi) { const f32x4 o = oacc[vi] * rs * *(const f32x4*)(p.hgrn_onorm + h * 128 + (vh * 4 + vi) * 16 + fq * 4);
              u32x2 w; w.x = cvt_pk_bf16(o[0] * bflo(ogv[vi].x), o[1] * bfhi(ogv[vi].x)); w.y = cvt_pk_bf16(o[2] * bflo(ogv[vi].y), o[3] * bfhi(ogv[vi].y));
              *(u32x2*)(Og + tok * 1024 + (vh * 4 + vi) * 16 + fq * 4) = w; } }
        } else {
#pragma unroll
          for (int vi = 0; vi < 4; ++vi) *(f32x4*)(OLg + tok * 1024 + (vh * 4 + vi) * 16 + fq * 4) = oacc[vi];
          __syncthreads();
        }
    }
#undef REC_LOAD
    float* So = seg == 3 ? p.out + O_HP + (size_t)(b * 8 + h) * 16384 : (float*)(p.ws + WS_LSEG) + ((size_t)(b * 8 + h) * 3 + seg) * 16384;
    if (part == 0) *(f32x2*)((float*)(p.ws + WS_DSEG) + ((size_t)(b * 8 + h) * 4 + seg) * 128 + d2) = (f32x2){__expf(Gseg[0]), __expf(Gseg[1])};
#pragma unroll
    for (int vb = 0; vb < 8; ++vb)
#pragma unroll
        for (int j = 0; j < 4; ++j) So[(size_t)(wid * 16 + fq * 4 + j) * 128 + vb * 16 + fr] = Sacc[vb][j];
    __syncthreads();
}
__device__ __forceinline__ void rec_sample(const Params& p, LAS unsigned char* lds, int item) {
    const int tid = threadIdx.x, b = item >> 3, h = item & 7;
    LAS float* qs = (LAS float*)lds; LAS float* fs = qs + 128; LAS float* ks = qs + 256; LAS float* vs = qs + 384; LAS float* red = qs + 512;
    LAS float* sq = qs + 512 + 2048;
    const unsigned char* ws = p.ws;
    const size_t roff = (size_t)(TP + b) * 1024 + h * 128;
    if (tid < 128) { qs[tid] = bf2f(((const bf16_t*)(ws + WS_Q))[roff + tid]); const float f = __expf((float)((const _Float16*)(ws + WS_G))[roff + tid]); fs[tid] = f; ks[tid] = 1.f - f;
        vs[tid] = bf2f(((const bf16_t*)(ws + WS_V))[roff + tid]); }
    __syncthreads();
    const int v4 = (tid & 31) * 4, dg = tid >> 5;
    const float* Sin = p.state_hgrn + (size_t)item * 16384; float* Sout = p.out + O_HS + (size_t)item * 16384;
    const f32x4 vv = *(const LAS f32x4*)(vs + v4);
    f32x4 o = (f32x4){0.f, 0.f, 0.f, 0.f};
    f32x4 sv[8];
#pragma unroll
    for (int i = 0; i < 8; ++i) sv[i] = *(const f32x4*)(Sin + (size_t)(dg * 8 + i) * 128 + v4);
#pragma unroll
    for (int i = 0; i < 8; ++i) { const int dd = dg * 8 + i; const f32x4 sn = sv[i] * fs[dd] + vv * ks[dd]; *(f32x4*)(Sout + (size_t)dd * 128 + v4) = sn; o = o + sn * qs[dd]; }
    *(LAS f32x4*)(red + dg * 128 + v4) = o;
    __syncthreads();
    float ov = 0.f;
    if (tid < 128) {
#pragma unroll
        for (int i = 0; i < 16; ++i) ov += red[i * 128 + tid];
        const float s = wave_sum(ov * ov); if ((tid & 63) == 0) sq[tid >> 6] = s; }
    __syncthreads();
    if (tid < 128) { const float rs = rsqrtf((sq[0] + sq[1]) * (1.f / 128.f) + EPS);
        const float og = bf2f(((const bf16_t*)(ws + WS_OG))[roff + tid]);
        ((bf16_t*)(p.ws + WS_R2))[roff + tid] = f2bf(ov * rs * p.hgrn_onorm[h * 128 + tid] * og); }
    __syncthreads();
}

__device__ __forceinline__ void rec_sample_list(const Params& p, LAS unsigned char* lds, int first, int stride, int count, size_t obase = WS_R2) {
    const int tid = threadIdx.x;
    LAS float* qs = (LAS float*)lds; LAS float* fs = qs + 128; LAS float* ks = qs + 256; LAS float* vs = qs + 384; LAS float* red = qs + 512;
    LAS float* sq = qs + 512 + 2048;
    const unsigned char* ws = p.ws;
    const int v4 = (tid & 31) * 4, dg = tid >> 5;
    f32x4 svA[8], svB[8]; float lqA = 0.f, lgA = 0.f, lvA = 0.f, loA = 0.f, lqB = 0.f, lgB = 0.f, lvB = 0.f, loB = 0.f;
#define RS_ISSUE(item_, sv, lq, lg, lv, lo) do { const int it_ = (item_); const size_t ro_ = (size_t)(TP + (it_ >> 3)) * 1024 + (it_ & 7) * 128; \
        if (tid < 128) { lq = bf2f(((const bf16_t*)(ws + WS_Q))[ro_ + tid]); lg = (float)((const _Float16*)(ws + WS_G))[ro_ + tid]; lv = bf2f(((const bf16_t*)(ws + WS_V))[ro_ + tid]); lo = bf2f(((const bf16_t*)(ws + WS_OG))[ro_ + tid]); } \
        const float* Sin_ = p.state_hgrn + (size_t)it_ * 16384; \
        _Pragma("unroll") for (int i = 0; i < 8; ++i) sv[i] = __builtin_nontemporal_load((const f32x4*)(Sin_ + (size_t)(dg * 8 + i) * 128 + v4)); } while (0)
#define RS_ITEM(j_, sv, lq, lg, lv, lo) do { \
        const int item = first + (j_) * stride, b = item >> 3, h = item & 7; \
        const size_t roff = (size_t)(TP + b) * 1024 + h * 128; \
        const float og = lo; \
        if (tid < 128) { const float f = __expf(lg); qs[tid] = lq; fs[tid] = f; ks[tid] = 1.f - f; vs[tid] = lv; } \
        __syncthreads(); \
        float* Sout = p.out + O_HS + (size_t)item * 16384; \
        const f32x4 vv = *(const LAS f32x4*)(vs + v4); \
        f32x4 o = (f32x4){0.f, 0.f, 0.f, 0.f}; \
        _Pragma("unroll") for (int i = 0; i < 8; ++i) { const int dd = dg * 8 + i; const f32x4 sn = sv[i] * fs[dd] + vv * ks[dd]; __builtin_nontemporal_store(sn, (f32x4*)(Sout + (size_t)dd * 128 + v4)); o = o + sn * qs[dd]; } \
        if ((j_) + 2 < count) RS_ISSUE(first + ((j_) + 2) * stride, sv, lq, lg, lv, lo); \
        *(LAS f32x4*)(red + dg * 128 + v4) = o; \
        __syncthreads(); \
        float ov = 0.f; \
        if (tid < 128) { \
            _Pragma("unroll") for (int i = 0; i < 16; ++i) ov += red[i * 128 + tid]; \
            const float s2 = wave_sum(ov * ov); if ((tid & 63) == 0) sq[tid >> 6] = s2; } \
        __syncthreads(); \
        if (tid < 128) { const float rs = rsqrtf((sq[0] + sq[1]) * (1.f / 128.f) + EPS); \
            ((bf16_t*)(p.ws + obase))[roff + tid] = f2bf(ov * rs * p.hgrn_onorm[h * 128 + tid] * og); } \
        __syncthreads(); } while (0)
    if (count > 0) RS_ISSUE(first, svA, lqA, lgA, lvA, loA);
    if (count > 1) RS_ISSUE(first + stride, svB, lqB, lgB, lvB, loB);
    for (int j = 0; j < count; j += 2) {
        RS_ITEM(j, svA, lqA, lgA, lvA, loA);
        if (j + 1 < count) RS_ITEM(j + 1, svB, lqB, lgB, lvB, loB);
    }
#undef RS_ITEM
#undef RS_ISSUE
}
__device__ __forceinline__ void rec_fix(const Params& p, LAS unsigned char* lds, int b, int h, int seg) {
    const int tid = threadIdx.x, wid = tid >> 6, lane = tid & 63, fr = lane & 15, fq = lane >> 4;
    LAS bf16_t* QT = (LAS bf16_t*)(lds + 0);
    LAS bf16_t* SB = (LAS bf16_t*)(lds + 71680);
    LAS float* SSQ = (LAS float*)(lds + 118272);
    const unsigned char* ws = p.ws;
    const int bh = b * 8 + h;
    const size_t gbase = (size_t)b * SEQ * 1024 + h * 128;
    const bf16_t* OGg = (const bf16_t*)(ws + WS_OG) + gbase; const bf16_t* QCg = (const bf16_t*)(ws + WS_R2) + gbase;
    const float* OLg = p.out + gbase; bf16_t* Og = (bf16_t*)(p.ws + WS_R2) + gbase;
    const float* Ls = (const float*)(ws + WS_LSEG) + (size_t)bh * 3 * 16384; const float* Ds = (const float*)(ws + WS_DSEG) + (size_t)bh * 4 * 128;
    { f32x4 S[8];
#pragma unroll
      for (int i = 0; i < 8; ++i) S[i] = (f32x4){0.f, 0.f, 0.f, 0.f};
      f32x4 Lr[3][8]; float Dr[3][8];
#pragma unroll
      for (int sp = 0; sp < 3; ++sp)
#pragma unroll
          for (int i = 0; i < 8; ++i) { const int e4 = (tid + 512 * i) * 4, dd = e4 >> 7;
              if (sp < seg) { Lr[sp][i] = *(const f32x4*)(Ls + (size_t)sp * 16384 + e4); Dr[sp][i] = Ds[sp * 128 + dd]; } else { Lr[sp][i] = (f32x4){0.f, 0.f, 0.f, 0.f}; Dr[sp][i] = 1.f; } }
#pragma unroll
      for (int sp = 0; sp < 3; ++sp)
#pragma unroll
          for (int i = 0; i < 8; ++i) S[i] = S[i] * Dr[sp][i] + Lr[sp][i];
#pragma unroll
      for (int i = 0; i < 8; ++i) { const int e4 = (tid + 512 * i) * 4, dd = e4 >> 7, v0 = e4 & 127;
#pragma unroll
          for (int j = 0; j < 4; ++j) SB[(v0 + j) * 136 + dd] = f2bf(S[i][j]);
          if (seg == 3) { float* So = p.out + O_HP + (size_t)bh * 16384 + e4; *(f32x4*)So = S[i] * Ds[3 * 128 + dd] + *(const f32x4*)So; } } }
    const int qrow0 = tid >> 4, qc8 = (tid & 15) * 8;
    const int tb = wid & 3, vh = wid >> 2;
    const f32x4 onv[4] = { *(const f32x4*)(p.hgrn_onorm + h * 128 + (vh * 4 + 0) * 16 + fq * 4), *(const f32x4*)(p.hgrn_onorm + h * 128 + (vh * 4 + 1) * 16 + fq * 4),
                           *(const f32x4*)(p.hgrn_onorm + h * 128 + (vh * 4 + 2) * 16 + fq * 4), *(const f32x4*)(p.hgrn_onorm + h * 128 + (vh * 4 + 3) * 16 + fq * 4) };
    u32x4 nq[2];
#pragma unroll
    for (int i = 0; i < 2; ++i) nq[i] = *(const u32x4*)(QCg + ((size_t)seg * 512 + qrow0 + 32 * i) * 1024 + qc8);
    f32x4 nol[4]; u32x2 nog[4];
    { const size_t tokf = (size_t)seg * 512 + tb * 16 + fr;
#pragma unroll
      for (int vi = 0; vi < 4; ++vi) { nol[vi] = *(const f32x4*)(OLg + tokf * 1024 + (vh * 4 + vi) * 16 + fq * 4); nog[vi] = *(const u32x2*)(OGg + tokf * 1024 + (vh * 4 + vi) * 16 + fq * 4); } }
    for (int cc = 0; cc < 8; ++cc) {
        const size_t t0 = (size_t)seg * 512 + cc * 64;
#pragma unroll
        for (int i = 0; i < 2; ++i) *(LAS u32x4*)(QT + (qrow0 + 32 * i) * 136 + qc8) = nq[i];
        __syncthreads();
        if (cc + 1 < 8) {
#pragma unroll
            for (int i = 0; i < 2; ++i) nq[i] = *(const u32x4*)(QCg + (t0 + 64 + qrow0 + 32 * i) * 1024 + qc8); }
        const size_t tok = t0 + tb * 16 + fr;
        f32x4 oacc[4]; u32x2 ogv[4];
#pragma unroll
        for (int vi = 0; vi < 4; ++vi) { oacc[vi] = nol[vi]; ogv[vi] = nog[vi]; }
        if (cc + 1 < 8) {
#pragma unroll
            for (int vi = 0; vi < 4; ++vi) { nol[vi] = *(const f32x4*)(OLg + (tok + 64) * 1024 + (vh * 4 + vi) * 16 + fq * 4); nog[vi] = *(const u32x2*)(OGg + (tok + 64) * 1024 + (vh * 4 + vi) * 16 + fq * 4); } }
        { bf16x8 qf[4];
#pragma unroll
          for (int kk = 0; kk < 4; ++kk) qf[kk] = lds_frag(QT + (tb * 16 + fr) * 136 + kk * 32 + fq * 8);
#pragma unroll
          for (int vi = 0; vi < 4; ++vi) { const int vb = vh * 4 + vi; f32x4 a = oacc[vi];
#pragma unroll
              for (int kk = 0; kk < 4; ++kk) a = __builtin_amdgcn_mfma_f32_16x16x32_bf16(lds_frag(SB + (vb * 16 + fr) * 136 + kk * 32 + fq * 8), qf[kk], a, 0, 0, 0);
              oacc[vi] = a; } }
        { float ss = 0.f;
#pragma unroll
          for (int vi = 0; vi < 4; ++vi) ss += oacc[vi][0] * oacc[vi][0] + oacc[vi][1] * oacc[vi][1] + oacc[vi][2] * oacc[vi][2] + oacc[vi][3] * oacc[vi][3];
          ss += __shfl_xor(ss, 16); ss += __shfl_xor(ss, 32);
          if (fq == 0) SSQ[vh * 64 + tb * 16 + fr] = ss; }
        __syncthreads();
        { const float tot = SSQ[tb * 16 + fr] + SSQ[64 + tb * 16 + fr]; const float rs = rsqrtf(tot * (1.f / 128.f) + EPS);
#pragma unroll
          for (int vi = 0; vi < 4; ++vi) { const f32x4 o = oacc[vi] * rs * onv[vi];
              u32x2 w; w.x = cvt_pk_bf16(o[0] * bflo(ogv[vi].x), o[1] * bfhi(ogv[vi].x)); w.y = cvt_pk_bf16(o[2] * bflo(ogv[vi].y), o[3] * bfhi(ogv[vi].y));
              *(u32x2*)(Og + tok * 1024 + (vh * 4 + vi) * 16 + fq * 4) = w; } }
    }
    __syncthreads();
}

__device__ __forceinline__ float* part_slot(unsigned char* ws, int k) { return (float*)(ws + WS_PART + (size_t)k * PART_SLOT); }
__device__ __forceinline__ float row_ssq16(const float* slot, size_t row) {
    const f32x4* pp = (const f32x4*)(slot + row * 16); const f32x4 t = (pp[0] + pp[1]) + (pp[2] + pp[3]); return (t[0] + t[1]) + (t[2] + t[3]); }
__device__ __forceinline__ float row_ssq64(const float* slot, int r) {
    const f32x4* pp = (const f32x4*)(slot + (size_t)TP * 16 + (size_t)r * 64); f32x4 t = pp[0];
#pragma unroll
    for (int i = 1; i < 16; ++i) t = t + pp[i];
    return (t[0] + t[1]) + (t[2] + t[3]); }
__device__ __forceinline__ void phase_pool(const Params& p, LAS unsigned char* lds) {
    const int tid = threadIdx.x, c = tid * 2, gi = c >> 8, w = 2 << gi;
    LAS f32x2* ring = (LAS f32x2*)lds;
    const float* slot = part_slot(p.ws, 1);
    bf16_t* Z = (bf16_t*)(p.ws + WS_R2);
    const bf16_t* XBs = (const bf16_t*)(p.ws + WS_XB);
    const f32x2 gp = *(const f32x2*)(p.pool_norm + c);
    for (int unit = blockIdx.x; unit < 256; unit += gridDim.x) {
        const int b = unit >> 5, t0 = (unit & 31) * 64;
#pragma unroll
        for (int i = 0; i < 16; ++i) ring[i * 512 + tid] = (f32x2){0.f, 0.f};
        f32x2 sum = (f32x2){0.f, 0.f};
        LAS float* rsl = (LAS float*)(lds + 65536);
        __syncthreads();
        if (tid < 80) { const int t = t0 - 16 + tid; rsl[tid] = t >= 0 ? rsqrtf(row_ssq16(slot, (size_t)b * SEQ + t) * (1.f / 1024.f) + EPS) : 0.f; }
        __syncthreads();
        for (int tt = -16; tt < 64; tt += 16) {
            unsigned xw[16];
#pragma unroll
            for (int i = 0; i < 16; ++i) { const int t = t0 + tt + i; xw[i] = t >= 0 ? *(const unsigned*)(XBs + ((size_t)b * SEQ + t) * 1024 + c) : 0u; }
#pragma unroll
            for (int i = 0; i < 16; ++i) { const int t = t0 + tt + i; const float rs = rsl[tt + 16 + i];
                const f32x2 u = (f32x2){bflo(xw[i]), bfhi(xw[i])} * rs * gp;
                const f32x2 old = ring[((t - w) & 15) * 512 + tid];
                ring[(t & 15) * 512 + tid] = u; sum = sum + u - old;
                if (tt + i >= 0) { const float cnt = (float)min(w, t + 1); const f32x2 z = sum / cnt - u; const size_t row = (size_t)b * SEQ + t;
                    *(unsigned*)(Z + row * 1024 + c) = cvt_pk_bf16(z[0], z[1]);
                    if (t >= SEQ - 15) *(f32x2*)(p.out + O_PP + ((size_t)b * 15 + (t - (SEQ - 15))) * 1024 + c) = u; } }
        }
    }
    for (int sb = blockIdx.x; sb < TS; sb += gridDim.x) {
        const size_t row = (size_t)TP + sb;
        const float rs = rsqrtf(row_ssq64(slot, sb) * (1.f / 1024.f) + EPS);
        const f32x2 u = *(const f32x2*)(p.out + row * 1024 + c) * rs * gp;
        const float* hist = p.state_pool + (size_t)sb * 15 * 1024 + c;
        float* ho = p.out + O_PS + (size_t)sb * 15 * 1024 + c;
        f32x2 sum = u;
#pragma unroll
        for (int j = 0; j < 15; ++j) { const f32x2 hv = *(const f32x2*)(hist + (size_t)j * 1024); if (j >= 16 - w) sum = sum + hv; if (j >= 1) *(f32x2*)(ho + (size_t)(j - 1) * 1024) = hv; }
        *(f32x2*)(ho + (size_t)14 * 1024) = u;
        const f32x2 z = sum / (float)w - u;
        *(unsigned*)(Z + row * 1024 + c) = cvt_pk_bf16(z[0], z[1]);
    }
}

__device__ __forceinline__ void phase_final(const Params& p) {
    const int tid = threadIdx.x, wid = tid >> 6, lane = tid & 63;
    const float* slot = part_slot(p.ws, 3);
    const int r = blockIdx.x * 8 + wid;
    if (r < TS) {
        float* xr = p.out + O_YS + (size_t)r * 1024;
        const float rs = rsqrtf(wave_sum(slot[(size_t)TP * 16 + (size_t)r * 64 + lane]) * (1.f / 1024.f) + EPS);
#pragma unroll
        for (int j = 0; j < 4; ++j) { const f32x4 v = *(const f32x4*)(xr + lane * 4 + 256 * j); const f32x4 g = *(const f32x4*)(p.final_norm + lane * 4 + 256 * j); *(f32x4*)(xr + lane * 4 + 256 * j) = v * rs * g; }
    }
}

#define XB_TMO      128
#define XB_XCNT(j)  (256  + 64 * (j))
#define XB_XSUB(j)  (1280 + 64 * (j))
#define XB_XGEN(j)  (2304 + 64 * (j))
#define XB_TOP      3328
#define XB_TOPGEN   3392
#define XCD_BAR_WORDS 3456
#define XB_SPIN_CAP (1u << 18)
__device__ __forceinline__ unsigned xb_ld(unsigned* p)              { return __hip_atomic_load(p, __ATOMIC_RELAXED, __HIP_MEMORY_SCOPE_AGENT); }
__device__ __forceinline__ unsigned xb_add(unsigned* p, unsigned v) { return __hip_atomic_fetch_add(p, v, __ATOMIC_RELAXED, __HIP_MEMORY_SCOPE_AGENT); }
__device__ __forceinline__ unsigned xb_xcc_id() { return (unsigned)__builtin_amdgcn_s_getreg((3 << 11) | 20) & 0xFu; }
#define XB_SPIN(cond, bar) do { unsigned _sp = 0; while (cond) { __builtin_amdgcn_s_sleep(1); \
    if ((++_sp & 255u) == 0u) { if (xb_ld(&(bar)[XB_TMO])) break; if (_sp > XB_SPIN_CAP) { atomicAdd(&(bar)[XB_TMO], 1u); break; } } } } while (0)
struct XcdBarrier { unsigned* bar; unsigned x; volatile LAS unsigned* st; };
__device__ __forceinline__ XcdBarrier xcd_barrier_post(unsigned* bar, volatile LAS unsigned* st) {
    XcdBarrier b; b.bar = bar; b.x = xb_xcc_id(); b.st = st;
    if (threadIdx.x == 0) (void)xb_add(&bar[XB_XCNT(b.x)], 1u);
    return b;
}
__device__ __forceinline__ void xcd_barrier_complete(unsigned* bar, unsigned x, unsigned& nloc, unsigned& nx) {
    const unsigned G = gridDim.x * gridDim.y * gridDim.z;
    unsigned sum, cnt, mine, sp = 0u;
    for (;;) {
        sum = 0u; cnt = 0u; mine = 0u;
#pragma unroll
        for (unsigned j = 0; j < 16; ++j) { const unsigned c = xb_ld(&bar[XB_XCNT(j)]); sum += c; cnt += (c > 0u) ? 1u : 0u; mine = (j == x) ? c : mine; }
        if (sum == G) break;
        __builtin_amdgcn_s_sleep(1);
        if ((++sp & 255u) == 0u) { if (xb_ld(&bar[XB_TMO])) break; if (sp > XB_SPIN_CAP) { atomicAdd(&bar[XB_TMO], 1u); break; } }
    }
    nloc = mine > 0u ? mine : 1u; nx = cnt > 0u ? cnt : 1u;
}
__device__ __forceinline__ void xcd_barrier(const XcdBarrier& b) {
    asm volatile("s_waitcnt vmcnt(0)" ::: "memory");
    __syncthreads();
    if (threadIdx.x == 0) {
        unsigned* bar = b.bar;
        __builtin_amdgcn_s_waitcnt(0);
        unsigned nloc = b.st[0], nx = b.st[1];
        if (nloc == 0u) { xcd_barrier_complete(bar, b.x, nloc, nx); b.st[0] = nloc; b.st[1] = nx; }
        const unsigned old = xb_add(&bar[XB_XSUB(b.x)], 1u);
        const unsigned gen = old / nloc;
        if (old + 1u == (gen + 1u) * nloc) {
            __builtin_amdgcn_fence(__ATOMIC_RELEASE, "agent");
            asm volatile("s_waitcnt vmcnt(0)" ::: "memory");
            const unsigned og = xb_add(&bar[XB_TOP], 1u);
            const unsigned tg = og / nx;
            if (og + 1u == (tg + 1u) * nx) xb_add(&bar[XB_TOPGEN], 1u);
            else XB_SPIN(xb_ld(&bar[XB_TOPGEN]) == tg, bar);
            __builtin_amdgcn_fence(__ATOMIC_ACQUIRE, "agent");
            xb_add(&bar[XB_XGEN(b.x)], 1u);
            asm volatile("s_waitcnt vmcnt(0)" ::: "memory");
        } else {
            XB_SPIN(xb_ld(&bar[XB_XGEN(b.x)]) == gen, bar);
            __builtin_amdgcn_fence(__ATOMIC_ACQUIRE, "agent");
            asm volatile("s_waitcnt vmcnt(0)" ::: "memory");
        }
    }
    __syncthreads();
}
#define PH_ON(n) ((PHMASK & (1 << (n))) && p.ph_lo <= (n) && (n) < p.ph_hi)
#define PH_SYNC(n) do { if (p.ph_lo < (n) && (n) < p.ph_hi) { xcd_barrier(xb); } } while (0)
__device__ __forceinline__ void ph_in(const Params& p, LAS unsigned char* lds) {
    unsigned char* ws = p.ws; pg8::StaticOrder S;
    EpiIn E{(bf16_t*)(ws + WS_Q), (bf16_t*)(ws + WS_V), (bf16_t*)(ws + WS_OG), (bf16_t*)(ws + WS_G), (const float*)(ws + WS_LB)};
    pg8::Gemm g{(const bf16_t*)(ws + WS_R2), (const bf16_t*)(ws + WS_WIN), TP, 4096, 1024, 1024, 0};
    S.init(g.M, g.N, gridDim.x, blockIdx.x); pg8::gemm_phase(lds, g, S, E);
    SIn F{E.Q, E.V, E.OG, E.G, (const float*)(ws + WS_LB)};
    sample_gemm<4>(lds, (const bf16_t*)(ws + WS_R2) + (size_t)TP * 1024, 1024, 0, (const bf16_t*)(ws + WS_WIN), 1024, F);
}
__device__ __forceinline__ void ph_rec1(const Params& p, LAS unsigned char* lds) {
    for (int it = blockIdx.x; it < 256; it += gridDim.x) { const int seg = it & 3, bh = it >> 2; rec_prompt(p, lds, bh >> 3, bh & 7, seg); }
}
__device__ __forceinline__ void ph_rec2(const Params& p, LAS unsigned char* lds) {
    for (int it = blockIdx.x; it < 256; it += gridDim.x) { const int seg = it & 3, bh = it >> 2; if (seg > 0) rec_fix(p, lds, bh >> 3, bh & 7, seg); }
    if (gridDim.x == 256) {
        const int seg = blockIdx.x & 3, bh = blockIdx.x >> 2;
        if (seg == 0) rec_sample_list(p, lds, bh * 10, 1, 10);
        else { const int k = bh * 3 + (seg - 1); rec_sample_list(p, lds, 640 + k, 192, 2); }
    } else rec_sample_list(p, lds, blockIdx.x, gridDim.x, (TS * 8 - (int)blockIdx.x + (int)gridDim.x - 1) / (int)gridDim.x);
}
__device__ __forceinline__ void ph_out(const Params& p, LAS unsigned char* lds, bool dummy = false) {
    unsigned char* ws = p.ws; pg8::StaticOrder S; float* slot = dummy ? (float*)nullptr : part_slot(ws, 0);
    EpiRes<false, false> E{p.x_prompt, nullptr, nullptr, (bf16_t*)(ws + WS_XB), nullptr, slot};
    pg8::Gemm g{(const bf16_t*)(ws + WS_R2), (const bf16_t*)(ws + WS_WOUT), TP, 1024, 1024, 1024, 0};
    S.init(g.M, g.N, gridDim.x, blockIdx.x); pg8::gemm_phase(lds, g, S, E);
    SRes F{p.x_sample, p.out + O_YS, (bf16_t*)(ws + WS_XB) + (size_t)TP * 1024, nullptr, dummy ? (float*)nullptr : slot + (size_t)TP * 16};
    sample_gemm<1>(lds, (const bf16_t*)(ws + WS_R2) + (size_t)TP * 1024, 1024, 0, (const bf16_t*)(ws + WS_WOUT), 1024, F);
}
__device__ __forceinline__ void ph_up(const Params& p, LAS unsigned char* lds, int L) {
    unsigned char* ws = p.ws; pg8::StaticOrder S; float* sq = part_slot(ws, L ? 2 : 0);
    const bf16_t* W = (const bf16_t*)(ws + (L ? WS_WUP1 : WS_WUP0));
    EpiUp E{(bf16_t*)(ws + WS_H), sq};
    pg8::Gemm g{(const bf16_t*)(ws + WS_XB), W, TP, 4096, 1024, 1024, 0};
    S.init(g.M, g.N, gridDim.x, blockIdx.x); pg8::gemm_phase(lds, g, S, E);
    SUp F{(bf16_t*)(ws + WS_H) + (size_t)TP * 4096, sq + (size_t)TP * 16};
    sample_gemm<4>(lds, (const bf16_t*)(ws + WS_XB) + (size_t)TP * 1024, 1024, 0, W, 1024, F);
}
__device__ __forceinline__ void ph_down(const Params& p, LAS unsigned char* lds, int L) {
    unsigned char* ws = p.ws; pg8::StaticOrder S; float* sq = part_slot(ws, L ? 3 : 1);
    const bf16_t* W = (const bf16_t*)(ws + (L ? WS_WDN1 : WS_WDN0));
    pg8::Gemm g{(const bf16_t*)(ws + WS_H), W, TP, 1024, 4096, 64, 0, 256 * 64 * 2, 256 * 4096 * 2};
    S.init(g.M, g.N, gridDim.x, blockIdx.x);
    if (L == 0) { EpiRes<true, false> E{nullptr, (const bf16_t*)(ws + WS_XB), nullptr, (bf16_t*)(ws + WS_XB), nullptr, sq}; pg8::gemm_phase(lds, g, S, E); }
    else { EpiFinal E{(const bf16_t*)(ws + WS_XB), p.out, p.final_norm, sq, (unsigned*)(ws + WS_BAR) + XCD_BAR_WORDS}; pg8::gemm_phase(lds, g, S, E); }
    SRes F{p.out + O_YS, p.out + O_YS, nullptr, nullptr, sq + (size_t)TP * 16};
    sample_gemm<1>(lds, (const bf16_t*)(ws + WS_H) + (size_t)TP * 4096, 4096, 0, W, 4096, F);
}
__device__ __forceinline__ void ph_poolg(const Params& p, LAS unsigned char* lds) {
    unsigned char* ws = p.ws; pg8::StaticOrder S; float* sq = part_slot(ws, 2);
    EpiRes<true, false> E{nullptr, (const bf16_t*)(ws + WS_XB), nullptr, (bf16_t*)(ws + WS_XB), p.pool_scale, sq};
    pg8::Gemm g{(const bf16_t*)(ws + WS_R2), (const bf16_t*)(ws + WS_WP), TP, 1024, 256, 1024, 256};
    S.init(g.M, g.N, gridDim.x, blockIdx.x); pg8::gemm_phase(lds, g, S, E);
    SRes F{p.out + O_YS, p.out + O_YS, (bf16_t*)(ws + WS_XB) + (size_t)TP * 1024, p.pool_scale, sq + (size_t)TP * 16};
    sample_gemm<1>(lds, (const bf16_t*)(ws + WS_R2) + (size_t)TP * 1024, 1024, 256, (const bf16_t*)(ws + WS_WP), 256, F);
}
__global__ void __launch_bounds__(512, 2) mega(Params p) {
    extern __shared__ __attribute__((aligned(16))) unsigned char shm[];
    LAS unsigned char* lds = (LAS unsigned char*)shm;
    volatile LAS unsigned* xst = (volatile LAS unsigned*)(lds + 151552);
    if (threadIdx.x == 0) { xst[0] = 0u; xst[1] = 0u; }
    __syncthreads();
    const XcdBarrier xb = xcd_barrier_post((unsigned*)(p.ws + WS_BAR), xst);
    if (p.ph_hi > 4096) cg::this_grid().sync();
    phase_prep(p, lds);
    if (DUP_PHASE == 0) { xcd_barrier(xb); phase_prep(p, lds); }
    if (DUP_PHASE == 20) { for (int i = 0; i < 20; ++i) xcd_barrier(xb); }
    xcd_barrier(xb); ph_in(p, lds);
    if (DUP_PHASE == 1) { xcd_barrier(xb); ph_in(p, lds); }
    xcd_barrier(xb); ph_rec1(p, lds);
    if (DUP_PHASE == 2) { xcd_barrier(xb); ph_rec1(p, lds); }
    xcd_barrier(xb); ph_rec2(p, lds);
    xcd_barrier(xb); ph_out(p, lds);
    if (DUP_PHASE == 3) { xcd_barrier(xb); ph_out(p, lds); }
    xcd_barrier(xb); ph_up(p, lds, 0);
    if (DUP_PHASE == 4) { xcd_barrier(xb); ph_up(p, lds, 0); }
    xcd_barrier(xb); ph_down(p, lds, 0);
    xcd_barrier(xb); phase_pool(p, lds);
    if (DUP_PHASE == 6) { xcd_barrier(xb); phase_pool(p, lds); }
    xcd_barrier(xb); ph_poolg(p, lds);
    xcd_barrier(xb); ph_up(p, lds, 1);
    xcd_barrier(xb); ph_down(p, lds, 1);
    if (DUP_PHASE == 9) { xcd_barrier(xb); ph_down(p, lds, 1); }
    xcd_barrier(xb);
    phase_final(p);
}

extern "C" void kernel_launch(void* const* d_in, const int* in_sizes, int n_in, void* d_out, int out_size, void* d_ws, size_t ws_size, hipStream_t stream) {
    static int grid = 0;
    if (grid == 0) {
        int dev = 0, cus = 0, per_cu = 0;
        hipGetDevice(&dev);
        hipDeviceGetAttribute(&cus, hipDeviceAttributeMultiprocessorCount, dev);
        if (hipFuncSetAttribute((const void*)mega, hipFuncAttributeMaxDynamicSharedMemorySize, LDS_BYTES) != hipSuccess) fprintf(stderr, "kernel_launch: hipFuncSetAttribute failed\n");
        if (hipOccupancyMaxActiveBlocksPerMultiprocessor(&per_cu, (const void*)mega, 512, LDS_BYTES) != hipSuccess || per_cu < 1) { fprintf(stderr, "kernel_launch: occupancy query gave %d\n", per_cu); per_cu = 1; }
        (void)hipGetLastError();
        grid = cus * per_cu;
        if (ws_size < WS_END3) fprintf(stderr, "kernel_launch: workspace too small: %zu < %zu\n", ws_size, (size_t)WS_END3);
        fprintf(stderr, "kernel_launch: grid %d (cus %d x %d), ws %zu\n", grid, cus, per_cu, ws_size);
    }
    Params p{};
    const float** pp = (const float**)&p;
    for (int i = 0; i < 16; ++i) pp[i] = (const float*)d_in[i];
    p.out = (float*)d_out; p.ws = (unsigned char*)d_ws;
    (void)hipMemsetAsync((unsigned char*)d_ws + WS_BAR, 0, 16384, stream);
    p.ph_lo = 0; p.ph_hi = NPHASE;
    void* args[] = {&p};
    hipError_t e = hipLaunchCooperativeKernel((const void*)mega, dim3(grid), dim3(512), args, LDS_BYTES, stream);
    if (e != hipSuccess) fprintf(stderr, "cooperative launch failed: %s (grid %d)\n", hipGetErrorString(e), grid);
}
```

```cpp
#include <hip/hip_runtime.h>
#include <hip/hip_cooperative_groups.h>
#include <cstdio>
namespace cg = cooperative_groups;

#define LAS __attribute__((address_space(3)))
typedef unsigned short bf16_t;
typedef short bf16x8 __attribute__((ext_vector_type(8)));
typedef float f32x4 __attribute__((ext_vector_type(4)));
typedef float f32x2 __attribute__((ext_vector_type(2)));
typedef unsigned u32x4 __attribute__((ext_vector_type(4)));
typedef unsigned u32x2 __attribute__((ext_vector_type(2)));

#ifndef PHMASK
#define PHMASK 0x7ff
#endif
#ifndef DUP_PHASE
#define DUP_PHASE -1
#endif
#ifndef EXTRA_SYNCS
#define EXTRA_SYNCS 0
#endif
#ifndef MK_LAUNCHES
#define MK_LAUNCHES 1
#endif

constexpr int D = 1024, TP = 16384, TS = 128, MP = TP + TS, FF = 4096, SEQ = 2048;
constexpr float EPS = 1e-6f;
constexpr int NPHASE = 11;
constexpr int LDS_BYTES = 151552 + 16;

constexpr size_t WS_WIN = 0;
constexpr size_t WS_WOUT = WS_WIN + (size_t)4096 * 1024 * 2;
constexpr size_t WS_WUP0 = WS_WOUT + (size_t)1024 * 1024 * 2;
constexpr size_t WS_WDN0 = WS_WUP0 + (size_t)4096 * 1024 * 2;
constexpr size_t WS_WP = WS_WDN0 + (size_t)4096 * 1024 * 2;
constexpr size_t WS_WUP1 = WS_WP + (size_t)1024 * 256 * 2;
constexpr size_t WS_WDN1 = WS_WUP1 + (size_t)4096 * 1024 * 2;
constexpr size_t WS_SSQ = WS_WDN1 + (size_t)4096 * 1024 * 2;
constexpr size_t WS_LB = WS_SSQ + 264192;
constexpr size_t WS_BAR = WS_SSQ + 268288;
constexpr size_t WS_R2 = WS_SSQ + 284672;
constexpr size_t ACT_B = (size_t)MP * 1024 * 2;
constexpr size_t WS_R1 = WS_R2 + ACT_B;
constexpr size_t WS_Q = WS_R1, WS_V = WS_R1 + ACT_B, WS_OG = WS_R1 + 2 * ACT_B, WS_G = WS_R1 + 3 * ACT_B;
constexpr size_t WS_H = WS_R1;
constexpr size_t WS_XB = WS_R1 + (size_t)MP * 4096 * 2;
constexpr size_t WS_END = WS_R1 + 5 * ACT_B;
constexpr size_t WS_PART = WS_END;
constexpr size_t PART_SLOT = (size_t)TP * 16 * 4 + (size_t)TS * 64 * 4;
constexpr size_t WS_END2 = WS_PART + 4 * PART_SLOT;
constexpr size_t WS_LSEG = WS_END2;
constexpr size_t WS_END3 = WS_LSEG + (size_t)64 * 3 * 16384 * 4;
constexpr size_t WS_DSEG = WS_SSQ;

constexpr size_t O_YP = 0, O_YS = 16777216, O_HP = 16908288, O_HS = 17956864, O_PP = 34734080, O_PS = 34856960;

struct Params {
    const float *x_prompt, *x_sample, *state_hgrn, *state_pool, *hgrn_norm, *hgrn_w_in, *hgrn_lb, *hgrn_onorm, *hgrn_w_out,
        *pool_norm, *pool_w, *pool_scale, *mlp_norm, *mlp_up, *mlp_down, *final_norm;
    float* out;
    unsigned char* ws;
    int ph_lo, ph_hi;
};

typedef __bf16 bf16x2_native __attribute__((ext_vector_type(2)));
__device__ __forceinline__ unsigned cvt_pk_bf16(float lo, float hi) { const f32x2 f = {lo, hi}; return __builtin_bit_cast(unsigned, __builtin_convertvector(f, bf16x2_native)); }
__device__ __forceinline__ float bf2f(bf16_t b) { return __uint_as_float(((unsigned)b) << 16); }
__device__ __forceinline__ float bflo(unsigned w) { return __uint_as_float(w << 16); }
__device__ __forceinline__ float bfhi(unsigned w) { return __uint_as_float(w & 0xffff0000u); }
__device__ __forceinline__ bf16_t f2bf(float f) { return (bf16_t)(cvt_pk_bf16(f, 0.f) & 0xffffu); }
typedef _Float16 half2_t __attribute__((ext_vector_type(2)));
__device__ __forceinline__ unsigned cvt_pk_f16(float a, float b) { half2_t h = {(_Float16)a, (_Float16)b}; return __builtin_bit_cast(unsigned, h); }
__device__ __forceinline__ f32x2 h2_to_f2(unsigned w) { const half2_t h = __builtin_bit_cast(half2_t, w); return (f32x2){(float)h[0], (float)h[1]}; }
__device__ __forceinline__ float sigmoidf_(float x) { return __builtin_amdgcn_rcpf(1.f + __expf(-x)); }
__device__ __forceinline__ float wave_sum(float v) {
#pragma unroll
    for (int o = 1; o < 64; o <<= 1) v += __shfl_xor(v, o);
    return v;
}
__device__ __forceinline__ size_t xb_off(int row, int col) { return ((size_t)(row >> 8) * 16 + (col >> 6)) * 16384 + (size_t)(row & 255) * 64 + (col & 63); }
__device__ __forceinline__ float ein_elem(int type, float x, float lbc) {
    if (type == 0) return x * sigmoidf_(x) * 0.08838834764831845f;
    if (type == 1) return __builtin_amdgcn_logf(lbc + (1.f - lbc) * sigmoidf_(x)) * 0.6931471805599453f;
    if (type == 2) return x;
    return sigmoidf_(x);
}
__device__ __forceinline__ float lb_of(const float* lb, int c) { return 1.f / (1.f + __expf(lb[1024 + c] - lb[c])); }

namespace pg8 {
constexpr int BM = 256, BK = 64, HALF = 128, HTB = HALF * BK * 2, STAGE_BYTES = 8 * HTB, NXCD = 8, WGM = 4;
__host__ __device__ __forceinline__ int lds_byte(int r, int c) { const int st = (r >> 4) * 2 + (c >> 5), rr = r & 15, cc = c & 31, ob = rr * 64 + cc * 2; return st * 1024 + (ob ^ (((ob >> 9) & 1) << 5)); }
__host__ __device__ __forceinline__ void stage_rc(int b, int& R, int& C) { const int st = b / 1024, sb = b % 1024, swz = sb ^ (((sb >> 9) & 1) << 5); R = (st >> 1) * 16 + swz / 64; C = (st & 1) * 32 + (swz % 64) / 2; }
__host__ __device__ __forceinline__ int perm32(int rho) { const int n = rho >> 4, i = rho & 15; return 8 * (i >> 2) + 4 * n + (i & 3); }
struct Unit { int pm, pn; };
struct Gemm { const bf16_t* A; const bf16_t* Bt; int M, N, K, lda, agroup, akt, apanel; };
struct StaticOrder {
    int nM, nN, nwg, G, c, wgm;
    __device__ void init(int M, int N, int G_, int c_) { nM = M / BM; nN = N / BM; nwg = nM * nN; G = G_; c = c_; wgm = nN >= 16 ? 4 : 8; }
    __device__ bool next(int i, Unit& u) const {
        const long L = (long)i * G + c; if (L >= nwg) return false;
        int wgid = (int)L; { const int q = nwg / NXCD, r = nwg % NXCD, xcd = wgid % NXCD, off = wgid / NXCD; wgid = (xcd < r ? xcd * (q + 1) : r * (q + 1) + (xcd - r) * q) + off; }
        const int nig = wgm * nN, gid = wgid / nig, fm = gid * wgm, gsz = (nM - fm) < wgm ? (nM - fm) : wgm;
        u.pm = fm + ((wgid % nig) % gsz); u.pn = (wgid % nig) / gsz; return true;
    }
};

template <class Epi>
__device__ __forceinline__ void gemm_phase(LAS unsigned char* lds, const Gemm g, const StaticOrder& S, const Epi& E) {
    int tid_ = threadIdx.x; asm volatile("" : "+v"(tid_));
    const int tid = tid_, wid = __builtin_amdgcn_readfirstlane(tid >> 6), lane = tid & 63, wr = wid >> 2, wc = wid & 3, fr = lane & 15, fq = lane >> 4;
    const int K = g.K, nt = K / BK, lda = g.lda;
    unsigned voffA[2], voffB[2];
#pragma unroll
    for (int i = 0; i < 2; ++i) { int R, C; stage_rc(tid * 16 + i * 8192, R, C); const int Rb = (R & ~31) + perm32(R & 31);
        voffA[i] = (unsigned)(R * lda + C) * 2u; voffB[i] = (unsigned)(Rb * K + C) * 2u; }
    const size_t kstep = (size_t)(BK * 2), kstepA = g.akt ? (size_t)g.akt : kstep;
    const size_t hstepA = (size_t)HALF * lda * 2, hstepB = (size_t)HALF * K * 2;
    const size_t tstepA = g.apanel ? (size_t)g.apanel : 2 * hstepA, tstepB = 2 * hstepB;
    const unsigned ldsw = (unsigned)wid * 1024u;
    const int aoff = lds_byte(wr * 64 + fr, fq * 8), boff = lds_byte(wc * 32 + fr, fq * 8);
#define PG8_SA(b, h) (((b) * 2 + (h)) * HTB)
#define PG8_SB(b, h) ((4 + (b) * 2 + (h)) * HTB)
#define PG8_STAGE(bufoff, gbase, voff) do { _Pragma("unroll") for (int _i = 0; _i < 2; ++_i) \
        __builtin_amdgcn_global_load_lds((const unsigned*)((const char*)(gbase) + (voff)[_i]), (LAS unsigned*)(lds + (bufoff) + ldsw + _i * 8192), 16, 0, 0); } while (0)
#define PG8_LDA(dst, b, h) do { _Pragma("unroll") for (int m = 0; m < 4; ++m) _Pragma("unroll") for (int k = 0; k < 2; ++k) dst[m][k] = *(const LAS bf16x8*)(lds + PG8_SA(b, h) + aoff + m * 2048 + k * 1024); } while (0)
#define PG8_LDB(dst, b, h) do { _Pragma("unroll") for (int n = 0; n < 2; ++n) _Pragma("unroll") for (int k = 0; k < 2; ++k) dst[n][k] = *(const LAS bf16x8*)(lds + PG8_SB(b, h) + boff + n * 2048 + k * 1024); } while (0)
#define PG8_MMA(ai, bj, At, Bt) do { __builtin_amdgcn_s_setprio(1); _Pragma("unroll") for (int m = 0; m < 4; ++m) _Pragma("unroll") for (int n = 0; n < 2; ++n) _Pragma("unroll") for (int k = 0; k < 2; ++k) \
        acc[ai][bj][m][n] = __builtin_amdgcn_mfma_f32_16x16x32_bf16(Bt[n][k], At[m][k], acc[ai][bj][m][n], 0, 0, 0); __builtin_amdgcn_s_setprio(0); } while (0)
#define PG8_WAIT_V(n) asm volatile("s_waitcnt vmcnt(" #n ")" ::: "memory")
#define PG8_WAIT_L(n) asm volatile("s_waitcnt lgkmcnt(" #n ")" ::: "memory")
#define PG8_BAR __builtin_amdgcn_s_barrier()
#define PG8_SCHED __builtin_amdgcn_sched_barrier(0)
    Unit cur, nxt; int ui = 0;
    if (!S.next(0, cur)) return;
    f32x4 acc[2][2][4][2];
#pragma unroll
    for (int a = 0; a < 2; ++a)
#pragma unroll
        for (int b = 0; b < 2; ++b)
#pragma unroll
            for (int m = 0; m < 4; ++m)
#pragma unroll
                for (int n = 0; n < 2; ++n) acc[a][b][m][n] = (f32x4){0.f, 0.f, 0.f, 0.f};
    bf16x8 At[4][2], B0[2][2], B1[2][2];
    const char* cA = (const char*)g.A + (size_t)cur.pm * tstepA + (size_t)cur.pn * g.agroup * 2; const char* cB = (const char*)g.Bt + (size_t)cur.pn * tstepB;
    PG8_STAGE(PG8_SB(0, 0), cB, voffB); PG8_STAGE(PG8_SA(0, 0), cA, voffA); PG8_STAGE(PG8_SB(0, 1), cB + hstepB, voffB); PG8_STAGE(PG8_SA(0, 1), cA + hstepA, voffA);
    if (wr == 1) PG8_BAR;
    PG8_WAIT_V(4); PG8_BAR;
    PG8_STAGE(PG8_SB(1, 0), cB + kstep, voffB); PG8_STAGE(PG8_SA(1, 0), cA + kstepA, voffA); PG8_STAGE(PG8_SB(1, 1), cB + hstepB + kstep, voffB);
    PG8_WAIT_V(6); PG8_BAR;
    for (;;) {
        const bool has_next = S.next(ui + 1, nxt);
        const char* nA = has_next ? (const char*)g.A + (size_t)nxt.pm * tstepA + (size_t)nxt.pn * g.agroup * 2 : cA; const char* nB = has_next ? (const char*)g.Bt + (size_t)nxt.pn * tstepB : cB;
        for (int t = 0; t < nt; t += 2) {
            const bool last = (t == nt - 2);
            const char* a1 = cA + (size_t)(t + 1) * kstepA;
            const char* a2 = last ? nA : cA + (size_t)(t + 2) * kstepA; const char* b2 = last ? nB : cB + (size_t)(t + 2) * kstep;
            const char* a3 = a2 + kstepA; const char* b3 = b2 + kstep;
            PG8_LDB(B0, 0, 0); PG8_SCHED; PG8_LDA(At, 0, 0); PG8_STAGE(PG8_SA(1, 1), a1 + hstepA, voffA);
            PG8_WAIT_L(8); PG8_BAR; PG8_WAIT_L(0); PG8_MMA(0, 0, At, B0); PG8_BAR; PG8_SCHED;
            PG8_LDB(B1, 0, 1); PG8_STAGE(PG8_SB(0, 0), b2, voffB);
            PG8_BAR; PG8_WAIT_L(0); PG8_MMA(0, 1, At, B1); PG8_BAR;
            PG8_LDA(At, 0, 1); PG8_STAGE(PG8_SA(0, 0), a2, voffA);
            PG8_BAR; PG8_WAIT_L(0); PG8_MMA(1, 0, At, B0); PG8_BAR; PG8_SCHED;
            PG8_STAGE(PG8_SB(0, 1), b2 + hstepB, voffB);
            PG8_WAIT_V(6); PG8_BAR; PG8_MMA(1, 1, At, B1); PG8_BAR;
            PG8_LDB(B0, 1, 0); PG8_SCHED; PG8_LDA(At, 1, 0); PG8_STAGE(PG8_SA(0, 1), a2 + hstepA, voffA);
            PG8_WAIT_L(8); PG8_BAR; PG8_WAIT_L(0); PG8_MMA(0, 0, At, B0); PG8_BAR; PG8_SCHED;
            PG8_LDB(B1, 1, 1); PG8_STAGE(PG8_SB(1, 0), b3, voffB);
            PG8_BAR; PG8_WAIT_L(0); PG8_MMA(0, 1, At, B1); PG8_BAR;
            PG8_LDA(At, 1, 1); PG8_STAGE(PG8_SA(1, 0), a3, voffA);
            PG8_BAR; PG8_WAIT_L(0); PG8_MMA(1, 0, At, B0); PG8_BAR; PG8_SCHED;
            PG8_STAGE(PG8_SB(1, 1), b3 + hstepB, voffB);
            PG8_WAIT_V(6); PG8_BAR; PG8_MMA(1, 1, At, B1); PG8_BAR;
        }
        if constexpr (!Epi::AFTER_DRAIN) E(acc, cur, wr, wc, fr, fq);
        if (!has_next) break;
#pragma unroll
        for (int a = 0; a < 2; ++a)
#pragma unroll
            for (int b = 0; b < 2; ++b)
#pragma unroll
                for (int m = 0; m < 4; ++m)
#pragma unroll
                    for (int n = 0; n < 2; ++n) acc[a][b][m][n] = (f32x4){0.f, 0.f, 0.f, 0.f};
        cur = nxt; cA = nA; cB = nB; ++ui;
    }
    PG8_WAIT_V(0);
    if (wr == 0) PG8_BAR;
    PG8_BAR;
    if constexpr (Epi::AFTER_DRAIN) E.fused(acc, cur, wr, wc, fr, fq, lds);
#undef PG8_SA
#undef PG8_SB
#undef PG8_STAGE
#undef PG8_LDA
#undef PG8_LDB
#undef PG8_MMA
#undef PG8_WAIT_V
#undef PG8_WAIT_L
#undef PG8_BAR
#undef PG8_SCHED
}
}

struct EpiIn {
    static constexpr bool AFTER_DRAIN = false;
    bf16_t *Q, *V, *OG; bf16_t* G; const float* lb;
    __device__ __forceinline__ void operator()(const f32x4 (&acc)[2][2][4][2], const pg8::Unit& u, int wr, int wc, int fr, int fq) const {
        const int sblk = u.pn >> 2, type = sblk == 2 ? 3 : (sblk == 3 ? 2 : sblk);
        const int row0 = u.pm * 256 + wr * 64 + fr, col0 = (u.pn & 3) * 256 + wc * 32 + 8 * fq;
        if (type == 1) {
            f32x4 lbv[2][2];
#pragma unroll
            for (int bj = 0; bj < 2; ++bj) { lbv[bj][0] = *(const f32x4*)(lb + col0 + bj * 128); lbv[bj][1] = *(const f32x4*)(lb + col0 + bj * 128 + 4); }
#pragma unroll
            for (int ai = 0; ai < 2; ++ai)
#pragma unroll
                for (int m = 0; m < 4; ++m) { bf16_t* rowp = G + (size_t)(row0 + ai * 128 + m * 16) * 1024 + col0;
#pragma unroll
                    for (int bj = 0; bj < 2; ++bj) { f32x4 o0, o1; const f32x4 l0 = lbv[bj][0], l1 = lbv[bj][1];
#pragma unroll
                        for (int e = 0; e < 4; ++e) { o0[e] = ein_elem(1, acc[ai][bj][m][0][e], l0[e]); o1[e] = ein_elem(1, acc[ai][bj][m][1][e], l1[e]); }
                        u32x4 w; w.x = cvt_pk_f16(o0[0], o0[1]); w.y = cvt_pk_f16(o0[2], o0[3]); w.z = cvt_pk_f16(o1[0], o1[1]); w.w = cvt_pk_f16(o1[2], o1[3]);
                        *(u32x4*)(rowp + bj * 128) = w; }
                    asm volatile("" ::: "memory"); }
        } else {
            bf16_t* base = Q + (size_t)(type == 0 ? 0 : type - 1) * (ACT_B / 2);
            if (type == 0) store_bf16<0>(acc, base, row0, col0);
            else if (type == 2) store_bf16<2>(acc, base, row0, col0);
            else store_bf16<3>(acc, base, row0, col0);
        }
    }
    template <int TYPE> __device__ __forceinline__ void store_bf16(const f32x4 (&acc)[2][2][4][2], bf16_t* base, int row0, int col0) const {
#pragma unroll
        for (int ai = 0; ai < 2; ++ai)
#pragma unroll
            for (int m = 0; m < 4; ++m) { bf16_t* rowp = base + (size_t)(row0 + ai * 128 + m * 16) * 1024 + col0;
#pragma unroll
                for (int bj = 0; bj < 2; ++bj) { f32x4 o0, o1;
#pragma unroll
                    for (int e = 0; e < 4; ++e) { o0[e] = ein_elem(TYPE, acc[ai][bj][m][0][e], 0.f); o1[e] = ein_elem(TYPE, acc[ai][bj][m][1][e], 0.f); }
                    u32x4 w; w.x = cvt_pk_bf16(o0[0], o0[1]); w.y = cvt_pk_bf16(o0[2], o0[3]); w.z = cvt_pk_bf16(o1[0], o1[1]); w.w = cvt_pk_bf16(o1[2], o1[3]);
                    *(u32x4*)(rowp + bj * 128) = w; }
                asm volatile("" ::: "memory"); }
    }
};
template <bool IN16, bool OUT32> struct EpiRes {
    static constexpr bool AFTER_DRAIN = false;
    const float* Xin32; const bf16_t* Xin16; float* Xout32; bf16_t* Xb; const float* scale; float* part;
    __device__ __forceinline__ void operator()(const f32x4 (&acc)[2][2][4][2], const pg8::Unit& u, int wr, int wc, int fr, int fq) const {
        const int row0 = u.pm * 256 + wr * 64 + fr, col0 = u.pn * 256 + wc * 32 + 8 * fq;
        constexpr int NB = 2;
        f32x4 sc[2][2];
#pragma unroll
        for (int bj = 0; bj < 2; ++bj) { sc[bj][0] = scale ? *(const f32x4*)(scale + col0 + bj * 128) : (f32x4){1.f, 1.f, 1.f, 1.f}; sc[bj][1] = scale ? *(const f32x4*)(scale + col0 + bj * 128 + 4) : (f32x4){1.f, 1.f, 1.f, 1.f}; }
        constexpr int AIB = 2 / NB;
#pragma unroll
        for (int bt = 0; bt < NB; ++bt) {
            f32x4 xr[AIB][4][2][IN16 ? 1 : 2];
#pragma unroll
            for (int a2 = 0; a2 < AIB; ++a2)
#pragma unroll
                for (int m = 0; m < 4; ++m) { const int ai = bt * AIB + a2; const size_t off = (size_t)(row0 + ai * 128 + m * 16) * 1024 + col0;
#pragma unroll
                    for (int bj = 0; bj < 2; ++bj) {
                        if (IN16) xr[a2][m][bj][0] = __builtin_bit_cast(f32x4, *(const u32x4*)(Xin16 + xb_off(row0 + ai * 128 + m * 16, col0 + bj * 128)));
                        else { xr[a2][m][bj][0] = *(const f32x4*)(Xin32 + off + bj * 128); xr[a2][m][bj][IN16 ? 0 : 1] = *(const f32x4*)(Xin32 + off + bj * 128 + 4); } } }
#pragma unroll
            for (int a2 = 0; a2 < AIB; ++a2)
#pragma unroll
                for (int m = 0; m < 4; ++m) { const int ai = bt * AIB + a2; const int row = row0 + ai * 128 + m * 16; const size_t off = (size_t)row * 1024 + col0; float ss = 0.f;
#pragma unroll
                    for (int bj = 0; bj < 2; ++bj) {
                        const f32x4 a0 = acc[ai][bj][m][0] * sc[bj][0], a1 = acc[ai][bj][m][1] * sc[bj][1];
                        f32x4 x0, x1;
                        if (IN16) { const u32x4 w = __builtin_bit_cast(u32x4, xr[a2][m][bj][0]); x0 = (f32x4){bflo(w.x), bfhi(w.x), bflo(w.y), bfhi(w.y)}; x1 = (f32x4){bflo(w.z), bfhi(w.z), bflo(w.w), bfhi(w.w)}; }
                        else { x0 = xr[a2][m][bj][0]; x1 = xr[a2][m][bj][IN16 ? 0 : 1]; }
                        x0 = x0 + a0; x1 = x1 + a1;
                        if (OUT32) { *(f32x4*)(Xout32 + off + bj * 128) = x0; *(f32x4*)(Xout32 + off + bj * 128 + 4) = x1; }
                        if (Xb) { u32x4 w; w.x = cvt_pk_bf16(x0[0], x0[1]); w.y = cvt_pk_bf16(x0[2], x0[3]); w.z = cvt_pk_bf16(x1[0], x1[1]); w.w = cvt_pk_bf16(x1[2], x1[3]); *(u32x4*)(Xb + xb_off(row, col0 + bj * 128)) = w; }
                        ss += x0[0] * x0[0] + x0[1] * x0[1] + x0[2] * x0[2] + x0[3] * x0[3] + x1[0] * x1[0] + x1[1] * x1[1] + x1[2] * x1[2] + x1[3] * x1[3]; }
                    ss += __shfl_xor(ss, 16); ss += __shfl_xor(ss, 32);
                    if (fq == 0 && part) part[(size_t)row * 16 + u.pn * 4 + wc] = ss; }
            asm volatile("" ::: "memory"); }
    }
};
struct EpiFinal {
    static constexpr bool AFTER_DRAIN = true;
    const bf16_t* Xin16; float* Y; const float* gfin; float* part; unsigned* cnt;
    __device__ __forceinline__ void fused(f32x4 (&acc)[2][2][4][2], const pg8::Unit& u, int wr, int wc, int fr, int fq, LAS unsigned char* lds) const {
        const int row0 = u.pm * 256 + wr * 64 + fr, col0 = u.pn * 256 + wc * 32 + 8 * fq;
        u32x4 xr[2][4][2];
#pragma unroll
        for (int ai = 0; ai < 2; ++ai)
#pragma unroll
            for (int m = 0; m < 4; ++m) { const size_t off = (size_t)(row0 + ai * 128 + m * 16) * 1024 + col0;
#pragma unroll
                for (int bj = 0; bj < 2; ++bj) xr[ai][m][bj] = *(const u32x4*)(Xin16 + xb_off(row0 + ai * 128 + m * 16, col0 + bj * 128)); }
#pragma unroll
        for (int ai = 0; ai < 2; ++ai) {
#pragma unroll
            for (int m = 0; m < 4; ++m) { const int row = row0 + ai * 128 + m * 16; float ss = 0.f;
#pragma unroll
                for (int bj = 0; bj < 2; ++bj) { const u32x4 w = xr[ai][m][bj];
                    const f32x4 x0 = (f32x4){bflo(w.x), bfhi(w.x), bflo(w.y), bfhi(w.y)} + acc[ai][bj][m][0], x1 = (f32x4){bflo(w.z), bfhi(w.z), bflo(w.w), bfhi(w.w)} + acc[ai][bj][m][1];
                    acc[ai][bj][m][0] = x0; acc[ai][bj][m][1] = x1;
                    ss += x0[0] * x0[0] + x0[1] * x0[1] + x0[2] * x0[2] + x0[3] * x0[3] + x1[0] * x1[0] + x1[1] * x1[1] + x1[2] * x1[2] + x1[3] * x1[3]; }
                ss += __shfl_xor(ss, 16); ss += __shfl_xor(ss, 32);
                if (fq == 0) __hip_atomic_store(part + (size_t)row * 16 + u.pn * 4 + wc, ss, __ATOMIC_RELAXED, __HIP_MEMORY_SCOPE_AGENT); }
            asm volatile("" ::: "memory"); }
        asm volatile("s_waitcnt vmcnt(0)" ::: "memory");
        __syncthreads();
        if (threadIdx.x == 0) {
            __hip_atomic_fetch_add(cnt + u.pm, 1u, __ATOMIC_RELAXED, __HIP_MEMORY_SCOPE_AGENT);
            unsigned sp = 0;
            while (__hip_atomic_load(cnt + u.pm, __ATOMIC_RELAXED, __HIP_MEMORY_SCOPE_AGENT) < 4u) { __builtin_amdgcn_s_sleep(1); if (++sp > (1u << 20)) break; }
        }
        __syncthreads();
        LAS float* rsl = (LAS float*)lds;
        if (threadIdx.x < 256) { const float* pr = part + (size_t)(u.pm * 256 + threadIdx.x) * 16; float sq = 0.f;
#pragma unroll
            for (int i = 0; i < 16; ++i) sq += __hip_atomic_load(pr + i, __ATOMIC_RELAXED, __HIP_MEMORY_SCOPE_AGENT);
            rsl[threadIdx.x] = rsqrtf(sq * (1.f / 1024.f) + EPS); }
        __syncthreads();
#pragma unroll
        for (int ai = 0; ai < 2; ++ai)
#pragma unroll
            for (int m = 0; m < 4; ++m) { const int rl = ai * 128 + wr * 64 + m * 16 + fr; const float rs = rsl[rl]; float* yp = Y + (size_t)(u.pm * 256 + rl) * 1024 + col0;
#pragma unroll
                for (int bj = 0; bj < 2; ++bj) { const f32x4 g0 = *(const f32x4*)(gfin + col0 + bj * 128), g1 = *(const f32x4*)(gfin + col0 + bj * 128 + 4);
                    __builtin_nontemporal_store(acc[ai][bj][m][0] * rs * g0, (f32x4*)(yp + bj * 128)); __builtin_nontemporal_store(acc[ai][bj][m][1] * rs * g1, (f32x4*)(yp + bj * 128 + 4)); } }
        __syncthreads();
    }
};
struct EpiNull { float* sink; static constexpr bool AFTER_DRAIN = false;
    __device__ __forceinline__ void operator()(const f32x4 (&acc)[2][2][4][2], const pg8::Unit& u, int wr, int wc, int fr, int fq) const {
        f32x4 t = (f32x4){0.f, 0.f, 0.f, 0.f};
#pragma unroll
        for (int a = 0; a < 2; ++a)
#pragma unroll
            for (int b = 0; b < 2; ++b)
#pragma unroll
                for (int m = 0; m < 4; ++m)
#pragma unroll
                    for (int n = 0; n < 2; ++n) t = t + acc[a][b][m][n];
        if (t[0] + t[1] + t[2] + t[3] == 12345.678f) sink[0] = 1.f; } };
struct SNull { float* sink; __device__ __forceinline__ void rowpart(int, int, float) const {}
    __device__ __forceinline__ float operator()(int r, int c, f32x4 v) const { if (v[0] + v[1] + v[2] + v[3] == 12345.678f) sink[0] = 1.f; return 0.f; } };
struct EpiUp {
    static constexpr bool AFTER_DRAIN = false;
    bf16_t* H; const float* part;
    __device__ __forceinline__ void operator()(const f32x4 (&acc)[2][2][4][2], const pg8::Unit& u, int wr, int wc, int fr, int fq) const {
        const int row0 = u.pm * 256 + wr * 64 + fr, col0 = u.pn * 256 + wc * 32 + 8 * fq;
        f32x4 pv[2][4]; float rs[2][4];
#pragma unroll
        for (int ai = 0; ai < 2; ++ai)
#pragma unroll
            for (int m = 0; m < 4; ++m) pv[ai][m] = *(const f32x4*)(part + (size_t)(row0 + ai * 128 + m * 16) * 16 + fq * 4);
#pragma unroll
        for (int ai = 0; ai < 2; ++ai)
#pragma unroll
            for (int m = 0; m < 4; ++m) { float sq = (pv[ai][m][0] + pv[ai][m][1]) + (pv[ai][m][2] + pv[ai][m][3]); sq += __shfl_xor(sq, 16); sq += __shfl_xor(sq, 32); rs[ai][m] = rsqrtf(sq * (1.f / 1024.f) + EPS); }
#pragma unroll
        for (int ai = 0; ai < 2; ++ai)
#pragma unroll
            for (int m = 0; m < 4; ++m) { const int row = row0 + ai * 128 + m * 16; const float r = rs[ai][m]; bf16_t* rowp = H + ((size_t)(row >> 8) * 64 + (col0 >> 6)) * 16384 + (size_t)(row & 255) * 64 + (col0 & 63);
#pragma unroll
                for (int bj = 0; bj < 2; ++bj) { f32x4 o0, o1;
#pragma unroll
                    for (int e = 0; e < 4; ++e) { float a = fmaxf(acc[ai][bj][m][0][e] * r, 0.f), b2 = fmaxf(acc[ai][bj][m][1][e] * r, 0.f); o0[e] = a * a; o1[e] = b2 * b2; }
                    u32x4 w; w.x = cvt_pk_bf16(o0[0], o0[1]); w.y = cvt_pk_bf16(o0[2], o0[3]); w.z = cvt_pk_bf16(o1[0], o1[1]); w.w = cvt_pk_bf16(o1[2], o1[3]);
                    *(u32x4*)(rowp + (size_t)bj * 2 * 16384) = w; } }
    }
};

template <int NCT, class F>
__device__ __forceinline__ void sample_gemm(LAS unsigned char* lds, const bf16_t* A, int lda, int agroup, const bf16_t* Bt, int K, const F& f) {
    constexpr int CT = NCT * 16;
    const int tid = threadIdx.x, wid = tid >> 6, lane = tid & 63, fr = lane & 15, fq = lane >> 4;
    LAS float* red = (LAS float*)lds;
    for (int blk = blockIdx.x; blk < 256; blk += gridDim.x) {
        const int rb = blk & 3, cb = blk >> 2, r0 = rb * 32, c0 = cb * CT;
        const int Kw = K >> 3, kb = wid * Kw;
        const bf16_t* Ab = A + (size_t)(c0 >> 8) * agroup;
        f32x4 acc[2][NCT];
#pragma unroll
        for (int i = 0; i < 2; ++i)
#pragma unroll
            for (int j = 0; j < NCT; ++j) acc[i][j] = (f32x4){0.f, 0.f, 0.f, 0.f};
        constexpr int UN = NCT == 1 ? 8 : 2;
        for (int k = kb; k < kb + Kw; k += 32 * UN) {
            bf16x8 af[UN][2], bfr[UN][NCT];
#pragma unroll
            for (int uu = 0; uu < UN; ++uu) { const int ku = k + 32 * uu; const bool ok = ku < kb + Kw;
#pragma unroll
                for (int i = 0; i < 2; ++i) af[uu][i] = ok ? *(const bf16x8*)(Ab + (size_t)(r0 + i * 16 + fr) * lda + ku + fq * 8) : (bf16x8){0, 0, 0, 0, 0, 0, 0, 0};
#pragma unroll
                for (int j = 0; j < NCT; ++j) bfr[uu][j] = ok ? *(const bf16x8*)(Bt + (size_t)(c0 + j * 16 + fr) * K + ku + fq * 8) : (bf16x8){0, 0, 0, 0, 0, 0, 0, 0}; }
#pragma unroll
            for (int uu = 0; uu < UN; ++uu)
#pragma unroll
                for (int i = 0; i < 2; ++i)
#pragma unroll
                    for (int j = 0; j < NCT; ++j) acc[i][j] = __builtin_amdgcn_mfma_f32_16x16x32_bf16(bfr[uu][j], af[uu][i], acc[i][j], 0, 0, 0);
        }
#pragma unroll
        for (int i = 0; i < 2; ++i)
#pragma unroll
            for (int j = 0; j < NCT; ++j) *(LAS f32x4*)(red + ((size_t)wid * 32 + i * 16 + fr) * CT + j * 16 + fq * 4) = acc[i][j];
        __syncthreads();
        constexpr int NG = 32 * CT / 4;
        for (int i = tid; i < NG; i += 512) { const int row = i / (CT / 4), cgp = i % (CT / 4);
            f32x4 s = (f32x4){0.f, 0.f, 0.f, 0.f};
#pragma unroll
            for (int w = 0; w < 8; ++w) s = s + *(const LAS f32x4*)(red + ((size_t)w * 32 + row) * CT + cgp * 4);
            float ss = f(r0 + row, c0 + cgp * 4, s);
#pragma unroll
            for (int o = 1; o < CT / 4; o <<= 1) ss += __shfl_xor(ss, o);
            if (cgp == 0) f.rowpart(r0 + row, cb, ss); }
        __syncthreads();
    }
}
struct SIn { bf16_t *Q, *V, *OG; bf16_t* G; const float* lb;
    __device__ __forceinline__ void rowpart(int, int, float) const {}
    __device__ __forceinline__ float operator()(int r, int c, f32x4 v) const { const int sblk = c >> 10, type = sblk == 2 ? 3 : (sblk == 3 ? 2 : sblk), cc = c & 1023; const size_t off = (size_t)(TP + r) * 1024 + cc;
        if (type == 1) { f32x4 o;
#pragma unroll
            for (int e = 0; e < 4; ++e) o[e] = ein_elem(1, v[e], lb[cc + e]);
            u32x2 w; w.x = cvt_pk_f16(o[0], o[1]); w.y = cvt_pk_f16(o[2], o[3]); *(u32x2*)(G + off) = w; }
        else { bf16_t* base = Q + (size_t)(type == 0 ? 0 : type - 1) * (ACT_B / 2); f32x4 o;
            if (type == 0) {
#pragma unroll
                for (int e = 0; e < 4; ++e) o[e] = ein_elem(0, v[e], 0.f); }
            else if (type == 2) o = v;
            else {
#pragma unroll
                for (int e = 0; e < 4; ++e) o[e] = ein_elem(3, v[e], 0.f); }
            u32x2 w; w.x = cvt_pk_bf16(o[0], o[1]); w.y = cvt_pk_bf16(o[2], o[3]); *(u32x2*)(base + off) = w; } return 0.f; } };
struct SRes { const float* Xin; float* Xout; bf16_t* Xb; const float* scale; float* parts;
    __device__ __forceinline__ void rowpart(int r, int cb, float ss) const { if (parts) parts[r * 64 + cb] = ss; }
    __device__ __forceinline__ float operator()(int r, int c, f32x4 v) const { const size_t off = (size_t)r * 1024 + c;
        f32x4 x = *(const f32x4*)(Xin + off); if (scale) v = v * *(const f32x4*)(scale + c); x = x + v; *(f32x4*)(Xout + off) = x;
        if (Xb) { u32x2 w; w.x = cvt_pk_bf16(x[0], x[1]); w.y = cvt_pk_bf16(x[2], x[3]); *(u32x2*)(Xb + off) = w; }
        return x[0] * x[0] + x[1] * x[1] + x[2] * x[2] + x[3] * x[3]; } };
struct SUp { bf16_t* H; const float* parts;
    __device__ __forceinline__ void rowpart(int, int, float) const {}
    __device__ __forceinline__ float operator()(int r, int c, f32x4 v) const { f32x4 t = (f32x4){0.f, 0.f, 0.f, 0.f};
#pragma unroll
        for (int i = 0; i < 16; ++i) t = t + *(const f32x4*)(parts + r * 64 + i * 4);
        const float rs = rsqrtf(((t[0] + t[1]) + (t[2] + t[3])) * (1.f / 1024.f) + EPS); f32x4 o;
#pragma unroll
        for (int e = 0; e < 4; ++e) { float a = fmaxf(v[e] * rs, 0.f); o[e] = a * a; }
        u32x2 w; w.x = cvt_pk_bf16(o[0], o[1]); w.y = cvt_pk_bf16(o[2], o[3]); *(u32x2*)(H + (size_t)r * 4096 + c) = w; return 0.f; } };

struct TJob { const float* src; bf16_t* dst; const float* gain; int N, ldd, k0, n0; };
__device__ __forceinline__ bool prep_job(const Params& p, int it, TJob& j) {
    unsigned char* ws = p.ws;
    constexpr int T_IN = 1024, T_OUT = 256, T_UP = 1024, T_DN = 1024, T_P = 64;
    constexpr int NT = T_IN + T_OUT + 2 * T_UP + 2 * T_DN + T_P;
    if (it >= NT) return false;
    int r = it; j.gain = nullptr;
    if (r < T_IN) { j.src = p.hgrn_w_in; j.N = 4096; j.dst = (bf16_t*)(ws + WS_WIN); j.ldd = 1024; j.k0 = (r >> 6) * 64; j.n0 = (r & 63) * 64; return true; } r -= T_IN;
    if (r < T_OUT) { j.src = p.hgrn_w_out; j.N = 1024; j.dst = (bf16_t*)(ws + WS_WOUT); j.ldd = 1024; j.k0 = (r >> 4) * 64; j.n0 = (r & 15) * 64; return true; } r -= T_OUT;
    if (r < T_UP) { j.src = p.mlp_up; j.N = 4096; j.dst = (bf16_t*)(ws + WS_WUP0); j.ldd = 1024; j.k0 = (r >> 6) * 64; j.n0 = (r & 63) * 64; j.gain = p.mlp_norm; return true; } r -= T_UP;
    if (r < T_UP) { j.src = p.mlp_up + (size_t)1024 * 4096; j.N = 4096; j.dst = (bf16_t*)(ws + WS_WUP1); j.ldd = 1024; j.k0 = (r >> 6) * 64; j.n0 = (r & 63) * 64; j.gain = p.mlp_norm + 1024; return true; } r -= T_UP;
    if (r < T_DN) { j.src = p.mlp_down; j.N = 1024; j.dst = (bf16_t*)(ws + WS_WDN0); j.ldd = 4096; j.k0 = (r >> 4) * 64; j.n0 = (r & 15) * 64; return true; } r -= T_DN;
    if (r < T_DN) { j.src = p.mlp_down + (size_t)4096 * 1024; j.N = 1024; j.dst = (bf16_t*)(ws + WS_WDN1); j.ldd = 4096; j.k0 = (r >> 4) * 64; j.n0 = (r & 15) * 64; return true; } r -= T_DN;
    { const int g = r >> 4, rr = r & 15; j.src = p.pool_w + (size_t)g * 65536; j.N = 256; j.dst = (bf16_t*)(ws + WS_WP) + (size_t)g * 65536; j.ldd = 256; j.k0 = (rr >> 2) * 64; j.n0 = (rr & 3) * 64; }
    return true;
}
__device__ __forceinline__ void phase_prep(const Params& p, LAS unsigned char* lds) {
    LAS float* tiles = (LAS float*)lds;
    unsigned char* ws = p.ws;
    constexpr int NT = 1024 + 256 + 2 * 1024 + 2 * 1024 + 64;
    { const int tid = threadIdx.x, i = tid >> 4, j4 = (tid & 15) * 4, n = tid >> 3, k8 = (tid & 7) * 8;
#pragma unroll 1
      for (int it0 = blockIdx.x; it0 < NT; it0 += 2 * gridDim.x) {
          TJob j[2]; bool ok[2]; f32x4 v[2][2];
#pragma unroll
          for (int q = 0; q < 2; ++q) { ok[q] = prep_job(p, it0 + q * gridDim.x, j[q]);
              if (ok[q]) {
#pragma unroll
                  for (int hh = 0; hh < 2; ++hh) v[q][hh] = __builtin_nontemporal_load((const f32x4*)(j[q].src + (size_t)(j[q].k0 + i + 32 * hh) * j[q].N + j[q].n0 + j4)); } }
#pragma unroll
          for (int q = 0; q < 2; ++q) if (ok[q]) {
#pragma unroll
              for (int hh = 0; hh < 2; ++hh)
#pragma unroll
                  for (int e = 0; e < 4; ++e) tiles[q * 4160 + (j4 + e) * 65 + i + 32 * hh] = v[q][hh][e]; }
          __syncthreads();
#pragma unroll
          for (int q = 0; q < 2; ++q) if (ok[q]) { float o[8];
#pragma unroll
              for (int e = 0; e < 8; ++e) { o[e] = tiles[q * 4160 + n * 65 + k8 + e]; if (j[q].gain) o[e] *= j[q].gain[j[q].k0 + k8 + e]; }
              u32x4 w; w.x = cvt_pk_bf16(o[0], o[1]); w.y = cvt_pk_bf16(o[2], o[3]); w.z = cvt_pk_bf16(o[4], o[5]); w.w = cvt_pk_bf16(o[6], o[7]);
              int nd = j[q].n0; if (j[q].src == p.hgrn_w_in) { const int ob = nd >> 10; nd = (nd & 1023) + ((ob == 2 ? 3 : ob == 3 ? 2 : ob) << 10); }
              *(u32x4*)(j[q].dst + (size_t)(nd + n) * j[q].ldd + j[q].k0 + k8) = w; }
          __syncthreads();
      } }
    const int tid = threadIdx.x, wid = tid >> 6, lane = tid & 63;
    bf16_t* U = (bf16_t*)(ws + WS_R2);
    for (int row0 = blockIdx.x * 8 + wid; row0 < MP; row0 += gridDim.x * 32) {
        f32x4 v[4][4];
#pragma unroll
        for (int rr = 0; rr < 4; ++rr) { const int row = row0 + rr * gridDim.x * 8; if (row < MP) { const float* src = row < TP ? p.x_prompt + (size_t)row * 1024 : p.x_sample + (size_t)(row - TP) * 1024;
#pragma unroll
            for (int j = 0; j < 4; ++j) v[rr][j] = *(const f32x4*)(src + lane * 4 + 256 * j); } }
#pragma unroll
        for (int rr = 0; rr < 4; ++rr) { const int row = row0 + rr * gridDim.x * 8; if (row < MP) { float sacc = 0.f;
#pragma unroll
            for (int j = 0; j < 4; ++j) sacc += v[rr][j][0] * v[rr][j][0] + v[rr][j][1] * v[rr][j][1] + v[rr][j][2] * v[rr][j][2] + v[rr][j][3] * v[rr][j][3];
            const float rs = rsqrtf(wave_sum(sacc) * (1.f / 1024.f) + EPS);
#pragma unroll
            for (int j = 0; j < 4; ++j) { const f32x4 g = *(const f32x4*)(p.hgrn_norm + lane * 4 + 256 * j);
                u32x2 w; w.x = cvt_pk_bf16(v[rr][j][0] * rs * g[0], v[rr][j][1] * rs * g[1]); w.y = cvt_pk_bf16(v[rr][j][2] * rs * g[2], v[rr][j][3] * rs * g[3]);
                *(u32x2*)(U + (size_t)row * 1024 + lane * 4 + 256 * j) = w; } } }
    }
    if (blockIdx.x < 2) { const int c = blockIdx.x * 512 + tid; ((float*)(ws + WS_LB))[c] = lb_of(p.hgrn_lb, c); }
}

__device__ __forceinline__ bf16x8 lds_frag(const LAS bf16_t* p) { return *(const LAS bf16x8*)p; }
__device__ __forceinline__ void rec_prompt(const Params& p, LAS unsigned char* lds, int b, int h, int seg) {
    const int tid = threadIdx.x, wid = tid >> 6, lane = tid & 63, fr = lane & 15, fq = lane >> 4;
    LAS bf16_t* QT = (LAS bf16_t*)(lds + 0);
    LAS bf16_t* KT = (LAS bf16_t*)(lds + 17408);
    LAS bf16_t* KH = (LAS bf16_t*)(lds + 34816);
    LAS bf16_t* VT = (LAS bf16_t*)(lds + 53248);
    LAS bf16_t* SB = (LAS bf16_t*)(lds + 71680);
    LAS bf16_t* AM = (LAS bf16_t*)(lds + 106496);
    LAS float* TOT = (LAS float*)(lds + 115712);
    LAS float* DD = (LAS float*)(lds + 119808);
    LAS float* SSQ = (LAS float*)(lds + 120320);
    const unsigned char* ws = p.ws;
    const size_t gbase = (size_t)b * SEQ * 1024 + h * 128;
    const bf16_t* Qg = (const bf16_t*)(ws + WS_Q) + gbase; const bf16_t* Vg = (const bf16_t*)(ws + WS_V) + gbase; const bf16_t* OGg = (const bf16_t*)(ws + WS_OG) + gbase;
    const bf16_t* Gg = (const bf16_t*)(ws + WS_G) + gbase;
    bf16_t* Og = (bf16_t*)(p.ws + WS_R2) + gbase;
    bf16_t* QCg = (bf16_t*)(p.ws + WS_R2) + gbase;
    float* OLg = p.out + gbase;
    f32x2 Gseg = (f32x2){0.f, 0.f};
    f32x4 Sacc[8];
#pragma unroll
    for (int i = 0; i < 8; ++i) Sacc[i] = (f32x4){0.f, 0.f, 0.f, 0.f};
    const int d2 = (tid & 63) * 2, part = tid >> 6;
    unsigned gr[8], qr[8], vr[8];
#define REC_LOAD(c) do { const unsigned o_ = (unsigned)(((c) * 64 + part * 8) * 1024 + d2); \
        _Pragma("unroll") for (int i = 0; i < 8; ++i) { gr[i] = *(const unsigned*)(Gg + o_ + (unsigned)i * 1024u); qr[i] = *(const unsigned*)(Qg + o_ + (unsigned)i * 1024u); vr[i] = *(const unsigned*)(Vg + o_ + (unsigned)i * 1024u); } } while (0)
    REC_LOAD(seg * 8);
    const int tb = wid & 3, vh = wid >> 2;
    for (int cc = 0; cc < 8; ++cc) {
        const int c = seg * 8 + cc;
#pragma unroll
        for (int vb = 0; vb < 8; ++vb) { u32x2 w; w.x = cvt_pk_bf16(Sacc[vb][0], Sacc[vb][1]); w.y = cvt_pk_bf16(Sacc[vb][2], Sacc[vb][3]);
            *(LAS u32x2*)(SB + (vb * 16 + fr) * 136 + wid * 16 + fq * 4) = w; }
        f32x2 cs[8];
        { f32x2 run = (f32x2){0.f, 0.f};
#pragma unroll
          for (int i = 0; i < 8; ++i) { run = run + h2_to_f2(gr[i]); cs[i] = run; }
          *(LAS f32x2*)(TOT + part * 128 + d2) = run; }
        __syncthreads();
        { f32x2 off = (f32x2){0.f, 0.f}, Gl = (f32x2){0.f, 0.f};
#pragma unroll
          for (int pp = 0; pp < 8; ++pp) { const f32x2 tv = *(const LAS f32x2*)(TOT + pp * 128 + d2); Gl = Gl + tv; if (pp < part) off = off + tv; }
          const float eGl0 = __expf(Gl[0]), eGl1 = __expf(Gl[1]), eGs0 = __expf(Gseg[0]), eGs1 = __expf(Gseg[1]);
          float kh0[8], kh1[8];
#pragma unroll
          for (int i = 0; i < 8; ++i) { const int t = part * 8 + i; const f32x2 G = off + cs[i];
              const float e0 = __expf(G[0]), e1 = __expf(G[1]), ei0 = __builtin_amdgcn_rcpf(e0), ei1 = __builtin_amdgcn_rcpf(e1);
              const f32x2 gv = h2_to_f2(gr[i]); const float k0 = 1.f - __expf(gv[0]), k1 = 1.f - __expf(gv[1]);
              const float q0 = bflo(qr[i]) * e0, q1 = bfhi(qr[i]) * e1;
              *(LAS unsigned*)(QT + t * 136 + d2) = cvt_pk_bf16(q0, q1); *(LAS unsigned*)(KT + t * 136 + d2) = cvt_pk_bf16(k0 * ei0, k1 * ei1);
              kh0[i] = k0 * eGl0 * ei0; kh1[i] = k1 * eGl1 * ei1;
              if (seg > 0) *(unsigned*)(QCg + (unsigned)((c * 64 + t) * 1024 + d2)) = cvt_pk_bf16(q0 * eGs0, q1 * eGs1); }
          Gseg = Gseg + Gl;
          u32x4 w0, w1; w0.x = cvt_pk_bf16(kh0[0], kh0[1]); w0.y = cvt_pk_bf16(kh0[2], kh0[3]); w0.z = cvt_pk_bf16(kh0[4], kh0[5]); w0.w = cvt_pk_bf16(kh0[6], kh0[7]);
          w1.x = cvt_pk_bf16(kh1[0], kh1[1]); w1.y = cvt_pk_bf16(kh1[2], kh1[3]); w1.z = cvt_pk_bf16(kh1[4], kh1[5]); w1.w = cvt_pk_bf16(kh1[6], kh1[7]);
          *(LAS u32x4*)(KH + d2 * 72 + part * 8) = w0; *(LAS u32x4*)(KH + (d2 + 1) * 72 + part * 8) = w1;
          u32x4 v0, v1;
          v0.x = (vr[0] & 0xffffu) | (vr[1] << 16); v0.y = (vr[2] & 0xffffu) | (vr[3] << 16); v0.z = (vr[4] & 0xffffu) | (vr[5] << 16); v0.w = (vr[6] & 0xffffu) | (vr[7] << 16);
          v1.x = (vr[0] >> 16) | (vr[1] & 0xffff0000u); v1.y = (vr[2] >> 16) | (vr[3] & 0xffff0000u); v1.z = (vr[4] >> 16) | (vr[5] & 0xffff0000u); v1.w = (vr[6] >> 16) | (vr[7] & 0xffff0000u);
          *(LAS u32x4*)(VT + d2 * 72 + part * 8) = v0; *(LAS u32x4*)(VT + (d2 + 1) * 72 + part * 8) = v1;
          if (part == 0) *(LAS f32x2*)(DD + d2) = (f32x2){eGl0, eGl1}; }
        if (cc + 1 < 8) REC_LOAD(c + 1);
        __syncthreads();
        { const int sb = wid >> 1;
#pragma unroll
          for (int ti = 0; ti < 2; ++ti) { const int tbb = (wid & 1) * 2 + ti; f32x4 a = (f32x4){0.f, 0.f, 0.f, 0.f};
              if (sb <= tbb) {
#pragma unroll
                  for (int kk = 0; kk < 4; ++kk) a = __builtin_amdgcn_mfma_f32_16x16x32_bf16(lds_frag(KT + (sb * 16 + fr) * 136 + kk * 32 + fq * 8), lds_frag(QT + (tbb * 16 + fr) * 136 + kk * 32 + fq * 8), a, 0, 0, 0);
                  const int t = tbb * 16 + fr, s0 = sb * 16 + fq * 4;
#pragma unroll
                  for (int j = 0; j < 4; ++j) if (s0 + j > t) a[j] = 0.f; }
              u32x2 w; w.x = cvt_pk_bf16(a[0], a[1]); w.y = cvt_pk_bf16(a[2], a[3]);
              *(LAS u32x2*)(AM + (tbb * 16 + fr) * 72 + sb * 16 + fq * 4) = w; } }
        { const f32x4 dd = *(const LAS f32x4*)(DD + wid * 16 + fq * 4);
          const bf16x8 a0 = lds_frag(KH + (wid * 16 + fr) * 72 + fq * 8), a1 = lds_frag(KH + (wid * 16 + fr) * 72 + 32 + fq * 8);
#pragma unroll
          for (int vb = 0; vb < 8; ++vb) { f32x4 a = Sacc[vb] * dd;
              a = __builtin_amdgcn_mfma_f32_16x16x32_bf16(a0, lds_frag(VT + (vb * 16 + fr) * 72 + fq * 8), a, 0, 0, 0);
              a = __builtin_amdgcn_mfma_f32_16x16x32_bf16(a1, lds_frag(VT + (vb * 16 + fr) * 72 + 32 + fq * 8), a, 0, 0, 0);
              Sacc[vb] = a; } }
        __syncthreads();
        f32x4 oacc[4]; u32x2 ogv[4];
        const size_t tok = (size_t)c * 64 + tb * 16 + fr;
        if (seg == 0) {
#pragma unroll
        for (int vi = 0; vi < 4; ++vi) ogv[vi] = *(const u32x2*)(OGg + tok * 1024 + (vh * 4 + vi) * 16 + fq * 4); }
        { bf16x8 qf[4], af[2];
#pragma unroll
          for (int kk = 0; kk < 4; ++kk) qf[kk] = lds_frag(QT + (tb * 16 + fr) * 136 + kk * 32 + fq * 8);
#pragma unroll
          for (int kk = 0; kk < 2; ++kk) af[kk] = lds_frag(AM + (tb * 16 + fr) * 72 + kk * 32 + fq * 8);
#pragma unroll
          for (int vi = 0; vi < 4; ++vi) { const int vb = vh * 4 + vi; f32x4 a = (f32x4){0.f, 0.f, 0.f, 0.f};
#pragma unroll
              for (int kk = 0; kk < 4; ++kk) a = __builtin_amdgcn_mfma_f32_16x16x32_bf16(lds_frag(SB + (vb * 16 + fr) * 136 + kk * 32 + fq * 8), qf[kk], a, 0, 0, 0);
#pragma unroll
              for (int kk = 0; kk < 2; ++kk) a = __builtin_amdgcn_mfma_f32_16x16x32_bf16(lds_frag(VT + (vb * 16 + fr) * 72 + kk * 32 + fq * 8), af[kk], a, 0, 0, 0);
              oacc[vi] = a; } }
        if (seg == 0) {
        { float ss = 0.f;
#pragma unroll
          for (int vi = 0; vi < 4; ++vi) ss += oacc[vi][0] * oacc[vi][0] + oacc[vi][1] * oacc[vi][1] + oacc[vi][2] * oacc[vi][2] + oacc[vi][3] * oacc[vi][3];
          ss += __shfl_xor(ss, 16); ss += __shfl_xor(ss, 32);
          if (fq == 0) SSQ[vh * 64 + tb * 16 + fr] = ss; }
        __syncthreads();
        { const float tot = SSQ[tb * 16 + fr] + SSQ[64 + tb * 16 + fr]; const float rs = rsqrtf(tot * (1.f / 128.f) + EPS);
#pragma unroll
          for (int vi = 0; vi < 4; ++vi) { const f32x4 o = oacc[vi] * rs * *(const f32x4*)(p.hgrn_onorm + h * 128 + (vh * 4 + vi) * 16 + fq * 4);
              u32x2 w; w.x = cvt_pk_bf16(o[0] * bflo(ogv[vi].x), o[1] * bfhi(ogv[vi].x)); w.y = cvt_pk_bf16(o[2] * bflo(ogv[vi].y), o[3] * bfhi(ogv[vi].y));
              *(u32x2*)(Og + tok * 1024 + (vh * 4 + vi) * 16 + fq * 4) = w; } }
        } else {
#pragma unroll
          for (int vi = 0; vi < 4; ++vi) *(f32x4*)(OLg + tok * 1024 + (vh * 4 + vi) * 16 + fq * 4) = oacc[vi];
          __syncthreads();
        }
    }
#undef REC_LOAD
    float* So = seg == 3 ? p.out + O_HP + (size_t)(b * 8 + h) * 16384 : (float*)(p.ws + WS_LSEG) + ((size_t)(b * 8 + h) * 3 + seg) * 16384;
    if (part == 0) *(f32x2*)((float*)(p.ws + WS_DSEG) + ((size_t)(b * 8 + h) * 4 + seg) * 128 + d2) = (f32x2){__expf(Gseg[0]), __expf(Gseg[1])};
#pragma unroll
    for (int vb = 0; vb < 8; ++vb)
#pragma unroll
        for (int j = 0; j < 4; ++j) So[(size_t)(wid * 16 + fq * 4 + j) * 128 + vb * 16 + fr] = Sacc[vb][j];
    __syncthreads();
}
__device__ __forceinline__ void rec_sample(const Params& p, LAS unsigned char* lds, int item) {
    const int tid = threadIdx.x, b = item >> 3, h = item & 7;
    LAS float* qs = (LAS float*)lds; LAS float* fs = qs + 128; LAS float* ks = qs + 256; LAS float* vs = qs + 384; LAS float* red = qs + 512;
    LAS float* sq = qs + 512 + 2048;
    const unsigned char* ws = p.ws;
    const size_t roff = (size_t)(TP + b) * 1024 + h * 128;
    if (tid < 128) { qs[tid] = bf2f(((const bf16_t*)(ws + WS_Q))[roff + tid]); const float f = __expf((float)((const _Float16*)(ws + WS_G))[roff + tid]); fs[tid] = f; ks[tid] = 1.f - f;
        vs[tid] = bf2f(((const bf16_t*)(ws + WS_V))[roff + tid]); }
    __syncthreads();
    const int v4 = (tid & 31) * 4, dg = tid >> 5;
    const float* Sin = p.state_hgrn + (size_t)item * 16384; float* Sout = p.out + O_HS + (size_t)item * 16384;
    const f32x4 vv = *(const LAS f32x4*)(vs + v4);
    f32x4 o = (f32x4){0.f, 0.f, 0.f, 0.f};
    f32x4 sv[8];
#pragma unroll
    for (int i = 0; i < 8; ++i) sv[i] = *(const f32x4*)(Sin + (size_t)(dg * 8 + i) * 128 + v4);
#pragma unroll
    for (int i = 0; i < 8; ++i) { const int dd = dg * 8 + i; const f32x4 sn = sv[i] * fs[dd] + vv * ks[dd]; *(f32x4*)(Sout + (size_t)dd * 128 + v4) = sn; o = o + sn * qs[dd]; }
    *(LAS f32x4*)(red + dg * 128 + v4) = o;
    __syncthreads();
    float ov = 0.f;
    if (tid < 128) {
#pragma unroll
        for (int i = 0; i < 16; ++i) ov += red[i * 128 + tid];
        const float s = wave_sum(ov * ov); if ((tid & 63) == 0) sq[tid >> 6] = s; }
    __syncthreads();
    if (tid < 128) { const float rs = rsqrtf((sq[0] + sq[1]) * (1.f / 128.f) + EPS);
        const float og = bf2f(((const bf16_t*)(ws + WS_OG))[roff + tid]);
        ((bf16_t*)(p.ws + WS_R2))[roff + tid] = f2bf(ov * rs * p.hgrn_onorm[h * 128 + tid] * og); }
    __syncthreads();
}

__device__ __forceinline__ void rec_sample_list(const Params& p, LAS unsigned char* lds, int first, int stride, int count, size_t obase = WS_R2) {
    const int tid = threadIdx.x;
    LAS float* qs = (LAS float*)lds; LAS float* fs = qs + 128; LAS float* ks = qs + 256; LAS float* vs = qs + 384; LAS float* red = qs + 512;
    LAS float* sq = qs + 512 + 2048;
    const unsigned char* ws = p.ws;
    const int v4 = (tid & 31) * 4, dg = tid >> 5;
    f32x4 svA[8], svB[8]; float lqA = 0.f, lgA = 0.f, lvA = 0.f, loA = 0.f, lqB = 0.f, lgB = 0.f, lvB = 0.f, loB = 0.f;
#define RS_ISSUE(item_, sv, lq, lg, lv, lo) do { const int it_ = (item_); const size_t ro_ = (size_t)(TP + (it_ >> 3)) * 1024 + (it_ & 7) * 128; \
        if (tid < 128) { lq = bf2f(((const bf16_t*)(ws + WS_Q))[ro_ + tid]); lg = (float)((const _Float16*)(ws + WS_G))[ro_ + tid]; lv = bf2f(((const bf16_t*)(ws + WS_V))[ro_ + tid]); lo = bf2f(((const bf16_t*)(ws + WS_OG))[ro_ + tid]); } \
        const float* Sin_ = p.state_hgrn + (size_t)it_ * 16384; \
        _Pragma("unroll") for (int i = 0; i < 8; ++i) sv[i] = __builtin_nontemporal_load((const f32x4*)(Sin_ + (size_t)(dg * 8 + i) * 128 + v4)); } while (0)
#define RS_ITEM(j_, sv, lq, lg, lv, lo) do { \
        const int item = first + (j_) * stride, b = item >> 3, h = item & 7; \
        const size_t roff = (size_t)(TP + b) * 1024 + h * 128; \
        const float og = lo; \
        if (tid < 128) { const float f = __expf(lg); qs[tid] = lq; fs[tid] = f; ks[tid] = 1.f - f; vs[tid] = lv; } \
        __syncthreads(); \
        float* Sout = p.out + O_HS + (size_t)item * 16384; \
        const f32x4 vv = *(const LAS f32x4*)(vs + v4); \
        f32x4 o = (f32x4){0.f, 0.f, 0.f, 0.f}; \
        _Pragma("unroll") for (int i = 0; i < 8; ++i) { const int dd = dg * 8 + i; const f32x4 sn = sv[i] * fs[dd] + vv * ks[dd]; __builtin_nontemporal_store(sn, (f32x4*)(Sout + (size_t)dd * 128 + v4)); o = o + sn * qs[dd]; } \
        if ((j_) + 2 < count) RS_ISSUE(first + ((j_) + 2) * stride, sv, lq, lg, lv, lo); \
        *(LAS f32x4*)(red + dg * 128 + v4) = o; \
        __syncthreads(); \
        float ov = 0.f; \
        if (tid < 128) { \
            _Pragma("unroll") for (int i = 0; i < 16; ++i) ov += red[i * 128 + tid]; \
            const float s2 = wave_sum(ov * ov); if ((tid & 63) == 0) sq[tid >> 6] = s2; } \
        __syncthreads(); \
        if (tid < 128) { const float rs = rsqrtf((sq[0] + sq[1]) * (1.f / 128.f) + EPS); \
            ((bf16_t*)(p.ws + obase))[roff + tid] = f2bf(ov * rs * p.hgrn_onorm[h * 128 + tid] * og); } \
        __syncthreads(); } while (0)
    if (count > 0) RS_ISSUE(first, svA, lqA, lgA, lvA, loA);
    if (count > 1) RS_ISSUE(first + stride, svB, lqB, lgB, lvB, loB);
    for (int j = 0; j < count; j += 2) {
        RS_ITEM(j, svA, lqA, lgA, lvA, loA);
        if (j + 1 < count) RS_ITEM(j + 1, svB, lqB, lgB, lvB, loB);
    }
#undef RS_ITEM
#undef RS_ISSUE
}
__device__ __forceinline__ void rec_fix(const Params& p, LAS unsigned char* lds, int b, int h, int seg) {
    const int tid = threadIdx.x, wid = tid >> 6, lane = tid & 63, fr = lane & 15, fq = lane >> 4;
    LAS bf16_t* QT = (LAS bf16_t*)(lds + 0);
    LAS bf16_t* SB = (LAS bf16_t*)(lds + 71680);
    LAS float* SSQ = (LAS float*)(lds + 118272);
    const unsigned char* ws = p.ws;
    const int bh = b * 8 + h;
    const size_t gbase = (size_t)b * SEQ * 1024 + h * 128;
    const bf16_t* OGg = (const bf16_t*)(ws + WS_OG) + gbase; const bf16_t* QCg = (const bf16_t*)(ws + WS_R2) + gbase;
    const float* OLg = p.out + gbase; bf16_t* Og = (bf16_t*)(p.ws + WS_R2) + gbase;
    const float* Ls = (const float*)(ws + WS_LSEG) + (size_t)bh * 3 * 16384; const float* Ds = (const float*)(ws + WS_DSEG) + (size_t)bh * 4 * 128;
    { f32x4 S[8];
#pragma unroll
      for (int i = 0; i < 8; ++i) S[i] = (f32x4){0.f, 0.f, 0.f, 0.f};
      f32x4 Lr[3][8]; float Dr[3][8];
#pragma unroll
      for (int sp = 0; sp < 3; ++sp)
#pragma unroll
          for (int i = 0; i < 8; ++i) { const int e4 = (tid + 512 * i) * 4, dd = e4 >> 7;
              if (sp < seg) { Lr[sp][i] = *(const f32x4*)(Ls + (size_t)sp * 16384 + e4); Dr[sp][i] = Ds[sp * 128 + dd]; } else { Lr[sp][i] = (f32x4){0.f, 0.f, 0.f, 0.f}; Dr[sp][i] = 1.f; } }
#pragma unroll
      for (int sp = 0; sp < 3; ++sp)
#pragma unroll
          for (int i = 0; i < 8; ++i) S[i] = S[i] * Dr[sp][i] + Lr[sp][i];
#pragma unroll
      for (int i = 0; i < 8; ++i) { const int e4 = (tid + 512 * i) * 4, dd = e4 >> 7, v0 = e4 & 127;
#pragma unroll
          for (int j = 0; j < 4; ++j) SB[(v0 + j) * 136 + dd] = f2bf(S[i][j]);
          if (seg == 3) { float* So = p.out + O_HP + (size_t)bh * 16384 + e4; *(f32x4*)So = S[i] * Ds[3 * 128 + dd] + *(const f32x4*)So; } } }
    const int qrow0 = tid >> 4, qc8 = (tid & 15) * 8;
    const int tb = wid & 3, vh = wid >> 2;
    const f32x4 onv[4] = { *(const f32x4*)(p.hgrn_onorm + h * 128 + (vh * 4 + 0) * 16 + fq * 4), *(const f32x4*)(p.hgrn_onorm + h * 128 + (vh * 4 + 1) * 16 + fq * 4),
                           *(const f32x4*)(p.hgrn_onorm + h * 128 + (vh * 4 + 2) * 16 + fq * 4), *(const f32x4*)(p.hgrn_onorm + h * 128 + (vh * 4 + 3) * 16 + fq * 4) };
    u32x4 nq[2];
#pragma unroll
    for (int i = 0; i < 2; ++i) nq[i] = *(const u32x4*)(QCg + ((size_t)seg * 512 + qrow0 + 32 * i) * 1024 + qc8);
    f32x4 nol[4]; u32x2 nog[4];
    { const size_t tokf = (size_t)seg * 512 + tb * 16 + fr;
#pragma unroll
      for (int vi = 0; vi < 4; ++vi) { nol[vi] = *(const f32x4*)(OLg + tokf * 1024 + (vh * 4 + vi) * 16 + fq * 4); nog[vi] = *(const u32x2*)(OGg + tokf * 1024 + (vh * 4 + vi) * 16 + fq * 4); } }
    for (int cc = 0; cc < 8; ++cc) {
        const size_t t0 = (size_t)seg * 512 + cc * 64;
#pragma unroll
        for (int i = 0; i < 2; ++i) *(LAS u32x4*)(QT + (qrow0 + 32 * i) * 136 + qc8) = nq[i];
        __syncthreads();
        if (cc + 1 < 8) {
#pragma unroll
            for (int i = 0; i < 2; ++i) nq[i] = *(const u32x4*)(QCg + (t0 + 64 + qrow0 + 32 * i) * 1024 + qc8); }
        const size_t tok = t0 + tb * 16 + fr;
        f32x4 oacc[4]; u32x2 ogv[4];
#pragma unroll
        for (int vi = 0; vi < 4; ++vi) { oacc[vi] = nol[vi]; ogv[vi] = nog[vi]; }
        if (cc + 1 < 8) {
#pragma unroll
            for (int vi = 0; vi < 4; ++vi) { nol[vi] = *(const f32x4*)(OLg + (tok + 64) * 1024 + (vh * 4 + vi) * 16 + fq * 4); nog[vi] = *(const u32x2*)(OGg + (tok + 64) * 1024 + (vh * 4 + vi) * 16 + fq * 4); } }
        { bf16x8 qf[4];
#pragma unroll
          for (int kk = 0; kk < 4; ++kk) qf[kk] = lds_frag(QT + (tb * 16 + fr) * 136 + kk * 32 + fq * 8);
#pragma unroll
          for (int vi = 0; vi < 4; ++vi) { const int vb = vh * 4 + vi; f32x4 a = oacc[vi];
#pragma unroll
              for (int kk = 0; kk < 4; ++kk) a = __builtin_amdgcn_mfma_f32_16x16x32_bf16(lds_frag(SB + (vb * 16 + fr) * 136 + kk * 32 + fq * 8), qf[kk], a, 0, 0, 0);
              oacc[vi] = a; } }
        { float ss = 0.f;
#pragma unroll
          for (int vi = 0; vi < 4; ++vi) ss += oacc[vi][0] * oacc[vi][0] + oacc[vi][1] * oacc[vi][1] + oacc[vi][2] * oacc[vi][2] + oacc[vi][3] * oacc[vi][3];
          ss += __shfl_xor(ss, 16); ss += __shfl_xor(ss, 32);
          if (fq == 0) SSQ[vh * 64 + tb * 16 + fr] = ss; }
        __syncthreads();
        { const float tot = SSQ[tb * 16 + fr] + SSQ[64 + tb * 16 + fr]; const float rs = rsqrtf(tot * (1.f / 128.f) + EPS);
#pragma unroll
          for (int vi = 0; vi < 4; ++vi) { const f32x4 o = oacc[vi] * rs * onv[vi];
              u32x2 w; w.x = cvt_pk_bf16(o[0] * bflo(ogv[vi].x), o[1] * bfhi(ogv[vi].x)); w.y = cvt_pk_bf16(o[2] * bflo(ogv[vi].y), o[3] * bfhi(ogv[vi].y));
              *(u32x2*)(Og + tok * 1024 + (vh * 4 + vi) * 16 + fq * 4) = w; } }
    }
    __syncthreads();
}

__device__ __forceinline__ float* part_slot(unsigned char* ws, int k) { return (float*)(ws + WS_PART + (size_t)k * PART_SLOT); }
__device__ __forceinline__ float row_ssq16(const float* slot, size_t row) {
    const f32x4* pp = (const f32x4*)(slot + row * 16); const f32x4 t = (pp[0] + pp[1]) + (pp[2] + pp[3]); return (t[0] + t[1]) + (t[2] + t[3]); }
__device__ __forceinline__ float row_ssq64(const float* slot, int r) {
    const f32x4* pp = (const f32x4*)(slot + (size_t)TP * 16 + (size_t)r * 64); f32x4 t = pp[0];
#pragma unroll
    for (int i = 1; i < 16; ++i) t = t + pp[i];
    return (t[0] + t[1]) + (t[2] + t[3]); }
__device__ __forceinline__ void phase_pool(const Params& p, LAS unsigned char* lds) {
    const int tid = threadIdx.x, c = tid * 2, gi = c >> 8, w = 2 << gi;
    LAS f32x2* ring = (LAS f32x2*)lds;
    const float* slot = part_slot(p.ws, 1);
    bf16_t* Z = (bf16_t*)(p.ws + WS_R2);
    const bf16_t* XBs = (const bf16_t*)(p.ws + WS_XB);
    const f32x2 gp = *(const f32x2*)(p.pool_norm + c);
    for (int unit = blockIdx.x; unit < 256; unit += gridDim.x) {
        const int b = unit >> 5, t0 = (unit & 31) * 64;
#pragma unroll
        for (int i = 0; i < 16; ++i) ring[i * 512 + tid] = (f32x2){0.f, 0.f};
        f32x2 sum = (f32x2){0.f, 0.f};
        LAS float* rsl = (LAS float*)(lds + 65536);
        __syncthreads();
        if (tid < 80) { const int t = t0 - 16 + tid; rsl[tid] = t >= 0 ? rsqrtf(row_ssq16(slot, (size_t)b * SEQ + t) * (1.f / 1024.f) + EPS) : 0.f; }
        __syncthreads();
        for (int tt = -16; tt < 64; tt += 16) {
            unsigned xw[16];
#pragma unroll
            for (int i = 0; i < 16; ++i) { const int t = t0 + tt + i; xw[i] = t >= 0 ? *(const unsigned*)(XBs + xb_off(b * SEQ + t, c)) : 0u; }
#pragma unroll
            for (int i = 0; i < 16; ++i) { const int t = t0 + tt + i; const float rs = rsl[tt + 16 + i];
                const f32x2 u = (f32x2){bflo(xw[i]), bfhi(xw[i])} * rs * gp;
                const f32x2 old = ring[((t - w) & 15) * 512 + tid];
                ring[(t & 15) * 512 + tid] = u; sum = sum + u - old;
                if (tt + i >= 0) { const float cnt = (float)min(w, t + 1); const f32x2 z = sum / cnt - u; const size_t row = (size_t)b * SEQ + t;
                    *(unsigned*)(Z + row * 1024 + c) = cvt_pk_bf16(z[0], z[1]);
                    if (t >= SEQ - 15) *(f32x2*)(p.out + O_PP + ((size_t)b * 15 + (t - (SEQ - 15))) * 1024 + c) = u; } }
        }
    }
    for (int sb = blockIdx.x; sb < TS; sb += gridDim.x) {
        const size_t row = (size_t)TP + sb;
        const float rs = rsqrtf(row_ssq64(slot, sb) * (1.f / 1024.f) + EPS);
        const f32x2 u = *(const f32x2*)(p.out + row * 1024 + c) * rs * gp;
        const float* hist = p.state_pool + (size_t)sb * 15 * 1024 + c;
        float* ho = p.out + O_PS + (size_t)sb * 15 * 1024 + c;
        f32x2 sum = u;
#pragma unroll
        for (int j = 0; j < 15; ++j) { const f32x2 hv = *(const f32x2*)(hist + (size_t)j * 1024); if (j >= 16 - w) sum = sum + hv; if (j >= 1) *(f32x2*)(ho + (size_t)(j - 1) * 1024) = hv; }
        *(f32x2*)(ho + (size_t)14 * 1024) = u;
        const f32x2 z = sum / (float)w - u;
        *(unsigned*)(Z + row * 1024 + c) = cvt_pk_bf16(z[0], z[1]);
    }
}

__device__ __forceinline__ void phase_final(const Params& p) {
    const int tid = threadIdx.x, wid = tid >> 6, lane = tid & 63;
    const float* slot = part_slot(p.ws, 3);
    const int r = blockIdx.x * 8 + wid;
    if (r < TS) {
        float* xr = p.out + O_YS + (size_t)r * 1024;
        const float rs = rsqrtf(wave_sum(slot[(size_t)TP * 16 + (size_t)r * 64 + lane]) * (1.f / 1024.f) + EPS);
#pragma unroll
        for (int j = 0; j < 4; ++j) { const f32x4 v = *(const f32x4*)(xr + lane * 4 + 256 * j); const f32x4 g = *(const f32x4*)(p.final_norm + lane * 4 + 256 * j); *(f32x4*)(xr + lane * 4 + 256 * j) = v * rs * g; }
    }
}

#define XB_TMO      128
#define XB_XCNT(j)  (256  + 64 * (j))
#define XB_XSUB(j)  (1280 + 64 * (j))
#define XB_XGEN(j)  (2304 + 64 * (j))
#define XB_TOP      3328
#define XB_TOPGEN   3392
#define XCD_BAR_WORDS 3456
#define XB_SPIN_CAP (1u << 18)
__device__ __forceinline__ unsigned xb_ld(unsigned* p)              { return __hip_atomic_load(p, __ATOMIC_RELAXED, __HIP_MEMORY_SCOPE_AGENT); }
__device__ __forceinline__ unsigned xb_add(unsigned* p, unsigned v) { return __hip_atomic_fetch_add(p, v, __ATOMIC_RELAXED, __HIP_MEMORY_SCOPE_AGENT); }
__device__ __forceinline__ unsigned xb_xcc_id() { return (unsigned)__builtin_amdgcn_s_getreg((3 << 11) | 20) & 0xFu; }
#define XB_SPIN(cond, bar) do { unsigned _sp = 0; while (cond) { __builtin_amdgcn_s_sleep(1); \
    if ((++_sp & 255u) == 0u) { if (xb_ld(&(bar)[XB_TMO])) break; if (_sp > XB_SPIN_CAP) { atomicAdd(&(bar)[XB_TMO], 1u); break; } } } } while (0)
struct XcdBarrier { unsigned* bar; unsigned x; volatile LAS unsigned* st; };
__device__ __forceinline__ XcdBarrier xcd_barrier_post(unsigned* bar, volatile LAS unsigned* st) {
    XcdBarrier b; b.bar = bar; b.x = xb_xcc_id(); b.st = st;
    if (threadIdx.x == 0) (void)xb_add(&bar[XB_XCNT(b.x)], 1u);
    return b;
}
__device__ __forceinline__ void xcd_barrier_complete(unsigned* bar, unsigned x, unsigned& nloc, unsigned& nx) {
    const unsigned G = gridDim.x * gridDim.y * gridDim.z;
    unsigned sum, cnt, mine, sp = 0u;
    for (;;) {
        sum = 0u; cnt = 0u; mine = 0u;
#pragma unroll
        for (unsigned j = 0; j < 16; ++j) { const unsigned c = xb_ld(&bar[XB_XCNT(j)]); sum += c; cnt += (c > 0u) ? 1u : 0u; mine = (j == x) ? c : mine; }
        if (sum == G) break;
        __builtin_amdgcn_s_sleep(1);
        if ((++sp & 255u) == 0u) { if (xb_ld(&bar[XB_TMO])) break; if (sp > XB_SPIN_CAP) { atomicAdd(&bar[XB_TMO], 1u); break; } }
    }
    nloc = mine > 0u ? mine : 1u; nx = cnt > 0u ? cnt : 1u;
}
__device__ __forceinline__ void xcd_barrier(const XcdBarrier& b) {
    asm volatile("s_waitcnt vmcnt(0)" ::: "memory");
    __syncthreads();
    if (threadIdx.x == 0) {
        unsigned* bar = b.bar;
        __builtin_amdgcn_s_waitcnt(0);
        unsigned nloc = b.st[0], nx = b.st[1];
        if (nloc == 0u) { xcd_barrier_complete(bar, b.x, nloc, nx); b.st[0] = nloc; b.st[1] = nx; }
        const unsigned old = xb_add(&bar[XB_XSUB(b.x)], 1u);
        const unsigned gen = old / nloc;
        if (old + 1u == (gen + 1u) * nloc) {
            __builtin_amdgcn_fence(__ATOMIC_RELEASE, "agent");
            asm volatile("s_waitcnt vmcnt(0)" ::: "memory");
            const unsigned og = xb_add(&bar[XB_TOP], 1u);
            const unsigned tg = og / nx;
            if (og + 1u == (tg + 1u) * nx) xb_add(&bar[XB_TOPGEN], 1u);
            else XB_SPIN(xb_ld(&bar[XB_TOPGEN]) == tg, bar);
            __builtin_amdgcn_fence(__ATOMIC_ACQUIRE, "agent");
            xb_add(&bar[XB_XGEN(b.x)], 1u);
            asm volatile("s_waitcnt vmcnt(0)" ::: "memory");
        } else {
            XB_SPIN(xb_ld(&bar[XB_XGEN(b.x)]) == gen, bar);
            __builtin_amdgcn_fence(__ATOMIC_ACQUIRE, "agent");
            asm volatile("s_waitcnt vmcnt(0)" ::: "memory");
        }
    }
    __syncthreads();
}
#define PH_ON(n) ((PHMASK & (1 << (n))) && p.ph_lo <= (n) && (n) < p.ph_hi)
#define PH_SYNC(n) do { if (p.ph_lo < (n) && (n) < p.ph_hi) { xcd_barrier(xb); } } while (0)
__device__ __forceinline__ void ph_in(const Params& p, LAS unsigned char* lds) {
    unsigned char* ws = p.ws; pg8::StaticOrder S;
    EpiIn E{(bf16_t*)(ws + WS_Q), (bf16_t*)(ws + WS_V), (bf16_t*)(ws + WS_OG), (bf16_t*)(ws + WS_G), (const float*)(ws + WS_LB)};
    pg8::Gemm g{(const bf16_t*)(ws + WS_R2), (const bf16_t*)(ws + WS_WIN), TP, 4096, 1024, 1024, 0};
    S.init(g.M, g.N, gridDim.x, blockIdx.x); pg8::gemm_phase(lds, g, S, E);
    SIn F{E.Q, E.V, E.OG, E.G, (const float*)(ws + WS_LB)};
    sample_gemm<4>(lds, (const bf16_t*)(ws + WS_R2) + (size_t)TP * 1024, 1024, 0, (const bf16_t*)(ws + WS_WIN), 1024, F);
}
__device__ __forceinline__ void ph_rec1(const Params& p, LAS unsigned char* lds) {
    for (int it = blockIdx.x; it < 256; it += gridDim.x) { const int seg = it & 3, bh = it >> 2; rec_prompt(p, lds, bh >> 3, bh & 7, seg); }
}
__device__ __forceinline__ void ph_rec2(const Params& p, LAS unsigned char* lds) {
    for (int it = blockIdx.x; it < 256; it += gridDim.x) { const int seg = it & 3, bh = it >> 2; if (seg > 0) rec_fix(p, lds, bh >> 3, bh & 7, seg); }
    if (gridDim.x == 256) {
        const int seg = blockIdx.x & 3, bh = blockIdx.x >> 2;
        if (seg == 0) rec_sample_list(p, lds, bh * 10, 1, 10);
        else { const int k = bh * 3 + (seg - 1); rec_sample_list(p, lds, 640 + k, 192, 2); }
    } else rec_sample_list(p, lds, blockIdx.x, gridDim.x, (TS * 8 - (int)blockIdx.x + (int)gridDim.x - 1) / (int)gridDim.x);
}
__device__ __forceinline__ void ph_out(const Params& p, LAS unsigned char* lds, bool dummy = false) {
    unsigned char* ws = p.ws; pg8::StaticOrder S; float* slot = dummy ? (float*)nullptr : part_slot(ws, 0);
    EpiRes<false, false> E{p.x_prompt, nullptr, nullptr, (bf16_t*)(ws + WS_XB), nullptr, slot};
    pg8::Gemm g{(const bf16_t*)(ws + WS_R2), (const bf16_t*)(ws + WS_WOUT), TP, 1024, 1024, 1024, 0};
    S.init(g.M, g.N, gridDim.x, blockIdx.x); pg8::gemm_phase(lds, g, S, E);
    SRes F{p.x_sample, p.out + O_YS, (bf16_t*)(ws + WS_XB) + (size_t)TP * 1024, nullptr, dummy ? (float*)nullptr : slot + (size_t)TP * 16};
    sample_gemm<1>(lds, (const bf16_t*)(ws + WS_R2) + (size_t)TP * 1024, 1024, 0, (const bf16_t*)(ws + WS_WOUT), 1024, F);
}
__device__ __forceinline__ void ph_up(const Params& p, LAS unsigned char* lds, int L) {
    unsigned char* ws = p.ws; pg8::StaticOrder S; float* sq = part_slot(ws, L ? 2 : 0);
    const bf16_t* W = (const bf16_t*)(ws + (L ? WS_WUP1 : WS_WUP0));
    EpiUp E{(bf16_t*)(ws + WS_H), sq};
    pg8::Gemm g{(const bf16_t*)(ws + WS_XB), W, TP, 4096, 1024, 64, 0, 256 * 64 * 2, 256 * 1024 * 2};
    S.init(g.M, g.N, gridDim.x, blockIdx.x); pg8::gemm_phase(lds, g, S, E);
    SUp F{(bf16_t*)(ws + WS_H) + (size_t)TP * 4096, sq + (size_t)TP * 16};
    sample_gemm<4>(lds, (const bf16_t*)(ws + WS_XB) + (size_t)TP * 1024, 1024, 0, W, 1024, F);
}
__device__ __forceinline__ void ph_down(const Params& p, LAS unsigned char* lds, int L) {
    unsigned char* ws = p.ws; pg8::StaticOrder S; float* sq = part_slot(ws, L ? 3 : 1);
    const bf16_t* W = (const bf16_t*)(ws + (L ? WS_WDN1 : WS_WDN0));
    pg8::Gemm g{(const bf16_t*)(ws + WS_H), W, TP, 1024, 4096, 64, 0, 256 * 64 * 2, 256 * 4096 * 2};
    S.init(g.M, g.N, gridDim.x, blockIdx.x);
    if (L == 0) { EpiRes<true, false> E{nullptr, (const bf16_t*)(ws + WS_XB), nullptr, (bf16_t*)(ws + WS_XB), nullptr, sq}; pg8::gemm_phase(lds, g, S, E); }
    else { EpiFinal E{(const bf16_t*)(ws + WS_XB), p.out, p.final_norm, sq, (unsigned*)(ws + WS_BAR) + XCD_BAR_WORDS}; pg8::gemm_phase(lds, g, S, E); }
    SRes F{p.out + O_YS, p.out + O_YS, nullptr, nullptr, sq + (size_t)TP * 16};
    sample_gemm<1>(lds, (const bf16_t*)(ws + WS_H) + (size_t)TP * 4096, 4096, 0, W, 4096, F);
}
__device__ __forceinline__ void ph_poolg(const Params& p, LAS unsigned char* lds) {
    unsigned char* ws = p.ws; pg8::StaticOrder S; float* sq = part_slot(ws, 2);
    EpiRes<true, false> E{nullptr, (const bf16_t*)(ws + WS_XB), nullptr, (bf16_t*)(ws + WS_XB), p.pool_scale, sq};
    pg8::Gemm g{(const bf16_t*)(ws + WS_R2), (const bf16_t*)(ws + WS_WP), TP, 1024, 256, 1024, 256};
    S.init(g.M, g.N, gridDim.x, blockIdx.x); pg8::gemm_phase(lds, g, S, E);
    SRes F{p.out + O_YS, p.out + O_YS, (bf16_t*)(ws + WS_XB) + (size_t)TP * 1024, p.pool_scale, sq + (size_t)TP * 16};
    sample_gemm<1>(lds, (const bf16_t*)(ws + WS_R2) + (size_t)TP * 1024, 1024, 256, (const bf16_t*)(ws + WS_WP), 256, F);
}
__global__ void __launch_bounds__(512, 2) mega(Params p) {
    extern __shared__ __attribute__((aligned(16))) unsigned char shm[];
    LAS unsigned char* lds = (LAS unsigned char*)shm;
    volatile LAS unsigned* xst = (volatile LAS unsigned*)(lds + 151552);
    if (threadIdx.x == 0) { xst[0] = 0u; xst[1] = 0u; }
    __syncthreads();
    const XcdBarrier xb = xcd_barrier_post((unsigned*)(p.ws + WS_BAR), xst);
    if (p.ph_hi > 4096) cg::this_grid().sync();
    phase_prep(p, lds);
    if (DUP_PHASE == 0) { xcd_barrier(xb); phase_prep(p, lds); }
    if (DUP_PHASE == 20) { for (int i = 0; i < 20; ++i) xcd_barrier(xb); }
    xcd_barrier(xb); ph_in(p, lds);
    if (DUP_PHASE == 1) { xcd_barrier(xb); ph_in(p, lds); }
    xcd_barrier(xb); ph_rec1(p, lds);
    if (DUP_PHASE == 2) { xcd_barrier(xb); ph_rec1(p, lds); }
    xcd_barrier(xb); ph_rec2(p, lds);
    xcd_barrier(xb); ph_out(p, lds);
    if (DUP_PHASE == 3) { xcd_barrier(xb); ph_out(p, lds); }
    xcd_barrier(xb); ph_up(p, lds, 0);
    if (DUP_PHASE == 4) { xcd_barrier(xb); ph_up(p, lds, 0); }
    xcd_barrier(xb); ph_down(p, lds, 0);
    xcd_barrier(xb); phase_pool(p, lds);
    if (DUP_PHASE == 6) { xcd_barrier(xb); phase_pool(p, lds); }
    xcd_barrier(xb); ph_poolg(p, lds);
    xcd_barrier(xb); ph_up(p, lds, 1);
    xcd_barrier(xb); ph_down(p, lds, 1);
    if (DUP_PHASE == 9) { xcd_barrier(xb); ph_down(p, lds, 1); }
    xcd_barrier(xb);
    phase_final(p);
}

extern "C" void kernel_launch(void* const* d_in, const int* in_sizes, int n_in, void* d_out, int out_size, void* d_ws, size_t ws_size, hipStream_t stream) {
    static int grid = 0;
    if (grid == 0) {
        int dev = 0, cus = 0, per_cu = 0;
        hipGetDevice(&dev);
        hipDeviceGetAttribute(&cus, hipDeviceAttributeMultiprocessorCount, dev);
        if (hipFuncSetAttribute((const void*)mega, hipFuncAttributeMaxDynamicSharedMemorySize, LDS_BYTES) != hipSuccess) fprintf(stderr, "kernel_launch: hipFuncSetAttribute failed\n");
        if (hipOccupancyMaxActiveBlocksPerMultiprocessor(&per_cu, (const void*)mega, 512, LDS_BYTES) != hipSuccess || per_cu < 1) { fprintf(stderr, "kernel_launch: occupancy query gave %d\n", per_cu); per_cu = 1; }
        (void)hipGetLastError();
        grid = cus * per_cu;
        if (ws_size < WS_END3) fprintf(stderr, "kernel_launch: workspace too small: %zu < %zu\n", ws_size, (size_t)WS_END3);
        fprintf(stderr, "kernel_launch: grid %d (cus %d x %d), ws %zu\n", grid, cus, per_cu, ws_size);
    }
    Params p{};
    const float** pp = (const float**)&p;
    for (int i = 0; i < 16; ++i) pp[i] = (const float*)d_in[i];
    p.out = (float*)d_out; p.ws = (unsigned char*)d_ws;
    (void)hipMemsetAsync((unsigned char*)d_ws + WS_BAR, 0, 16384, stream);
    p.ph_lo = 0; p.ph_hi = NPHASE;
    void* args[] = {&p};
    hipError_t e = hipLaunchCooperativeKernel((const void*)mega, dim3(grid), dim3(512), args, LDS_BYTES, stream);
    if (e != hipSuccess) fprintf(stderr, "cooperative launch failed: %s (grid %d)\n", hipGetErrorString(e), grid);
}
```

```cpp
#include <hip/hip_runtime.h>
#include <hip/hip_cooperative_groups.h>
#include <cstdio>
namespace cg = cooperative_groups;

#define LAS __attribute__((address_space(3)))
typedef unsigned short bf16_t;
typedef short bf16x8 __attribute__((ext_vector_type(8)));
typedef float f32x4 __attribute__((ext_vector_type(4)));
typedef float f32x2 __attribute__((ext_vector_type(2)));
typedef unsigned u32x4 __attribute__((ext_vector_type(4)));
typedef unsigned u32x2 __attribute__((ext_vector_type(2)));

#ifndef PHMASK
#define PHMASK 0x7ff
#endif
#ifndef DUP_PHASE
#define DUP_PHASE -1
#endif
#ifndef EXTRA_SYNCS
#define EXTRA_SYNCS 0
#endif
#ifndef MK_LAUNCHES
#define MK_LAUNCHES 1
#endif

constexpr int D = 1024, TP = 16384, TS = 128, MP = TP + TS, FF = 4096, SEQ = 2048;
constexpr float EPS = 1e-6f;
constexpr int NPHASE = 11;
constexpr int LDS_BYTES = 151552 + 16;

constexpr size_t WS_WIN = 0;
constexpr size_t WS_WOUT = WS_WIN + (size_t)4096 * 1024 * 2;
constexpr size_t WS_WUP0 = WS_WOUT + (size_t)1024 * 1024 * 2;
constexpr size_t WS_WDN0 = WS_WUP0 + (size_t)4096 * 1024 * 2;
constexpr size_t WS_WP = WS_WDN0 + (size_t)4096 * 1024 * 2;
constexpr size_t WS_WUP1 = WS_WP + (size_t)1024 * 256 * 2;
constexpr size_t WS_WDN1 = WS_WUP1 + (size_t)4096 * 1024 * 2;
constexpr size_t WS_SSQ = WS_WDN1 + (size_t)4096 * 1024 * 2;
constexpr size_t WS_LB = WS_SSQ + 264192;
constexpr size_t WS_BAR = WS_SSQ + 268288;
constexpr size_t WS_R2 = WS_SSQ + 284672;
constexpr size_t ACT_B = (size_t)MP * 1024 * 2;
constexpr size_t WS_R1 = WS_R2 + ACT_B;
constexpr size_t WS_Q = WS_R1, WS_V = WS_R1 + ACT_B, WS_OG = WS_R1 + 2 * ACT_B, WS_G = WS_R1 + 3 * ACT_B;
constexpr size_t WS_H = WS_R1;
constexpr size_t WS_XB = WS_R1 + (size_t)MP * 4096 * 2;
constexpr size_t WS_END = WS_R1 + 5 * ACT_B;
constexpr size_t WS_PART = WS_END;
constexpr size_t PART_SLOT = (size_t)TP * 16 * 4 + (size_t)TS * 64 * 4;
constexpr size_t WS_END2 = WS_PART + 4 * PART_SLOT;
constexpr size_t WS_LSEG = WS_END2;
constexpr size_t WS_END3 = WS_LSEG + (size_t)64 * 3 * 16384 * 4;
constexpr size_t WS_DSEG = WS_SSQ;

constexpr size_t O_YP = 0, O_YS = 16777216, O_HP = 16908288, O_HS = 17956864, O_PP = 34734080, O_PS = 34856960;

struct Params {
    const float *x_prompt, *x_sample, *state_hgrn, *state_pool, *hgrn_norm, *hgrn_w_in, *hgrn_lb, *hgrn_onorm, *hgrn_w_out,
        *pool_norm, *pool_w, *pool_scale, *mlp_norm, *mlp_up, *mlp_down, *final_norm;
    float* out;
    unsigned char* ws;
    int ph_lo, ph_hi;
};

typedef __bf16 bf16x2_native __attribute__((ext_vector_type(2)));
__device__ __forceinline__ unsigned cvt_pk_bf16(float lo, float hi) { const f32x2 f = {lo, hi}; return __builtin_bit_cast(unsigned, __builtin_convertvector(f, bf16x2_native)); }
__device__ __forceinline__ float bf2f(bf16_t b) { return __uint_as_float(((unsigned)b) << 16); }
__device__ __forceinline__ float bflo(unsigned w) { return __uint_as_float(w << 16); }
__device__ __forceinline__ float bfhi(unsigned w) { return __uint_as_float(w & 0xffff0000u); }
__device__ __forceinline__ bf16_t f2bf(float f) { return (bf16_t)(cvt_pk_bf16(f, 0.f) & 0xffffu); }
typedef _Float16 half2_t __attribute__((ext_vector_type(2)));
__device__ __forceinline__ unsigned cvt_pk_f16(float a, float b) { half2_t h = {(_Float16)a, (_Float16)b}; return __builtin_bit_cast(unsigned, h); }
__device__ __forceinline__ f32x2 h2_to_f2(unsigned w) { const half2_t h = __builtin_bit_cast(half2_t, w); return (f32x2){(float)h[0], (float)h[1]}; }
__device__ __forceinline__ float sigmoidf_(float x) { return __builtin_amdgcn_rcpf(1.f + __expf(-x)); }
__device__ __forceinline__ float wave_sum(float v) {
#pragma unroll
    for (int o = 1; o < 64; o <<= 1) v += __shfl_xor(v, o);
    return v;
}
__device__ __forceinline__ size_t xb_off(int row, int col) { return ((size_t)(row >> 8) * 16 + (col >> 6)) * 16384 + (size_t)(row & 255) * 64 + (col & 63); }
__device__ __forceinline__ float ein_elem(int type, float x, float lbc) {
    if (type == 0) return x * sigmoidf_(x) * 0.08838834764831845f;
    if (type == 1) return __builtin_amdgcn_logf(lbc + (1.f - lbc) * sigmoidf_(x)) * 0.6931471805599453f;
    if (type == 2) return x;
    return sigmoidf_(x);
}
__device__ __forceinline__ float lb_of(const float* lb, int c) { return 1.f / (1.f + __expf(lb[1024 + c] - lb[c])); }

namespace pg8 {
constexpr int BM = 256, BK = 64, HALF = 128, HTB = HALF * BK * 2, STAGE_BYTES = 8 * HTB, NXCD = 8, WGM = 4;
__host__ __device__ __forceinline__ int lds_byte(int r, int c) { const int st = (r >> 4) * 2 + (c >> 5), rr = r & 15, cc = c & 31, ob = rr * 64 + cc * 2; return st * 1024 + (ob ^ (((ob >> 9) & 1) << 5)); }
__host__ __device__ __forceinline__ void stage_rc(int b, int& R, int& C) { const int st = b / 1024, sb = b % 1024, swz = sb ^ (((sb >> 9) & 1) << 5); R = (st >> 1) * 16 + swz / 64; C = (st & 1) * 32 + (swz % 64) / 2; }
__host__ __device__ __forceinline__ int perm32(int rho) { const int n = rho >> 4, i = rho & 15; return 8 * (i >> 2) + 4 * n + (i & 3); }
struct Unit { int pm, pn; };
struct Gemm { const bf16_t* A; const bf16_t* Bt; int M, N, K, lda, agroup, akt, apanel; };
struct StaticOrder {
    int nM, nN, nwg, G, c, wgm;
    __device__ void init(int M, int N, int G_, int c_) { nM = M / BM; nN = N / BM; nwg = nM * nN; G = G_; c = c_; wgm = nN >= 16 ? 4 : 8; }
    __device__ bool next(int i, Unit& u) const {
        const long L = (long)i * G + c; if (L >= nwg) return false;
        int wgid = (int)L; { const int q = nwg / NXCD, r = nwg % NXCD, xcd = wgid % NXCD, off = wgid / NXCD; wgid = (xcd < r ? xcd * (q + 1) : r * (q + 1) + (xcd - r) * q) + off; }
        const int nig = wgm * nN, gid = wgid / nig, fm = gid * wgm, gsz = (nM - fm) < wgm ? (nM - fm) : wgm;
        u.pm = fm + ((wgid % nig) % gsz); u.pn = (wgid % nig) / gsz; return true;
    }
};

template <class Epi>
__device__ __forceinline__ void gemm_phase(LAS unsigned char* lds, const Gemm g, const StaticOrder& S, const Epi& E) {
    int tid_ = threadIdx.x; asm volatile("" : "+v"(tid_));
    const int tid = tid_, wid = __builtin_amdgcn_readfirstlane(tid >> 6), lane = tid & 63, wr = wid >> 2, wc = wid & 3, fr = lane & 15, fq = lane >> 4;
    const int K = g.K, nt = K / BK, lda = g.lda;
    unsigned voffA[2], voffB[2];
#pragma unroll
    for (int i = 0; i < 2; ++i) { int R, C; stage_rc(tid * 16 + i * 8192, R, C); const int Rb = (R & ~31) + perm32(R & 31);
        voffA[i] = (unsigned)(R * lda + C) * 2u; voffB[i] = (unsigned)(Rb * K + C) * 2u; }
    const size_t kstep = (size_t)(BK * 2), kstepA = g.akt ? (size_t)g.akt : kstep;
    const size_t hstepA = (size_t)HALF * lda * 2, hstepB = (size_t)HALF * K * 2;
    const size_t tstepA = g.apanel ? (size_t)g.apanel : 2 * hstepA, tstepB = 2 * hstepB;
    const unsigned ldsw = (unsigned)wid * 1024u;
    const int aoff = lds_byte(wr * 64 + fr, fq * 8), boff = lds_byte(wc * 32 + fr, fq * 8);
#define PG8_SA(b, h) (((b) * 2 + (h)) * HTB)
#define PG8_SB(b, h) ((4 + (b) * 2 + (h)) * HTB)
#define PG8_STAGE(bufoff, gbase, voff) do { _Pragma("unroll") for (int _i = 0; _i < 2; ++_i) \
        __builtin_amdgcn_global_load_lds((const unsigned*)((const char*)(gbase) + (voff)[_i]), (LAS unsigned*)(lds + (bufoff) + ldsw + _i * 8192), 16, 0, 0); } while (0)
#define PG8_LDA(dst, b, h) do { _Pragma("unroll") for (int m = 0; m < 4; ++m) _Pragma("unroll") for (int k = 0; k < 2; ++k) dst[m][k] = *(const LAS bf16x8*)(lds + PG8_SA(b, h) + aoff + m * 2048 + k * 1024); } while (0)
#define PG8_LDB(dst, b, h) do { _Pragma("unroll") for (int n = 0; n < 2; ++n) _Pragma("unroll") for (int k = 0; k < 2; ++k) dst[n][k] = *(const LAS bf16x8*)(lds + PG8_SB(b, h) + boff + n * 2048 + k * 1024); } while (0)
#define PG8_MMA(ai, bj, At, Bt) do { __builtin_amdgcn_s_setprio(1); _Pragma("unroll") for (int m = 0; m < 4; ++m) _Pragma("unroll") for (int n = 0; n < 2; ++n) _Pragma("unroll") for (int k = 0; k < 2; ++k) \
        acc[ai][bj][m][n] = __builtin_amdgcn_mfma_f32_16x16x32_bf16(Bt[n][k], At[m][k], acc[ai][bj][m][n], 0, 0, 0); __builtin_amdgcn_s_setprio(0); } while (0)
#define PG8_WAIT_V(n) asm volatile("s_waitcnt vmcnt(" #n ")" ::: "memory")
#define PG8_WAIT_L(n) asm volatile("s_waitcnt lgkmcnt(" #n ")" ::: "memory")
#define PG8_BAR __builtin_amdgcn_s_barrier()
#define PG8_SCHED __builtin_amdgcn_sched_barrier(0)
    Unit cur, nxt; int ui = 0;
    if (!S.next(0, cur)) return;
    f32x4 acc[2][2][4][2];
#pragma unroll
    for (int a = 0; a < 2; ++a)
#pragma unroll
        for (int b = 0; b < 2; ++b)
#pragma unroll
            for (int m = 0; m < 4; ++m)
#pragma unroll
                for (int n = 0; n < 2; ++n) acc[a][b][m][n] = (f32x4){0.f, 0.f, 0.f, 0.f};
    bf16x8 At[4][2], B0[2][2], B1[2][2];
    const char* cA = (const char*)g.A + (size_t)cur.pm * tstepA + (size_t)cur.pn * g.agroup * 2; const char* cB = (const char*)g.Bt + (size_t)cur.pn * tstepB;
    PG8_STAGE(PG8_SB(0, 0), cB, voffB); PG8_STAGE(PG8_SA(0, 0), cA, voffA); PG8_STAGE(PG8_SB(0, 1), cB + hstepB, voffB); PG8_STAGE(PG8_SA(0, 1), cA + hstepA, voffA);
    if (wr == 1) PG8_BAR;
    PG8_WAIT_V(4); PG8_BAR;
    PG8_STAGE(PG8_SB(1, 0), cB + kstep, voffB); PG8_STAGE(PG8_SA(1, 0), cA + kstepA, voffA); PG8_STAGE(PG8_SB(1, 1), cB + hstepB + kstep, voffB);
    PG8_WAIT_V(6); PG8_BAR;
    for (;;) {
        const bool has_next = S.next(ui + 1, nxt);
        const char* nA = has_next ? (const char*)g.A + (size_t)nxt.pm * tstepA + (size_t)nxt.pn * g.agroup * 2 : cA; const char* nB = has_next ? (const char*)g.Bt + (size_t)nxt.pn * tstepB : cB;
        for (int t = 0; t < nt; t += 2) {
            const bool last = (t == nt - 2);
            const char* a1 = cA + (size_t)(t + 1) * kstepA;
            const char* a2 = last ? nA : cA + (size_t)(t + 2) * kstepA; const char* b2 = last ? nB : cB + (size_t)(t + 2) * kstep;
            const char* a3 = a2 + kstepA; const char* b3 = b2 + kstep;
            PG8_LDB(B0, 0, 0); PG8_SCHED; PG8_LDA(At, 0, 0); PG8_STAGE(PG8_SA(1, 1), a1 + hstepA, voffA);
            PG8_WAIT_L(8); PG8_BAR; PG8_WAIT_L(0); PG8_MMA(0, 0, At, B0); PG8_BAR; PG8_SCHED;
            PG8_LDB(B1, 0, 1); PG8_STAGE(PG8_SB(0, 0), b2, voffB);
            PG8_BAR; PG8_WAIT_L(0); PG8_MMA(0, 1, At, B1); PG8_BAR;
            PG8_LDA(At, 0, 1); PG8_STAGE(PG8_SA(0, 0), a2, voffA);
            PG8_BAR; PG8_WAIT_L(0); PG8_MMA(1, 0, At, B0); PG8_BAR; PG8_SCHED;
            PG8_STAGE(PG8_SB(0, 1), b2 + hstepB, voffB);
            PG8_WAIT_V(6); PG8_BAR; PG8_MMA(1, 1, At, B1); PG8_BAR;
            PG8_LDB(B0, 1, 0); PG8_SCHED; PG8_LDA(At, 1, 0); PG8_STAGE(PG8_SA(0, 1), a2 + hstepA, voffA);
            PG8_WAIT_L(8); PG8_BAR; PG8_WAIT_L(0); PG8_MMA(0, 0, At, B0); PG8_BAR; PG8_SCHED;
            PG8_LDB(B1, 1, 1); PG8_STAGE(PG8_SB(1, 0), b3, voffB);
            PG8_BAR; PG8_WAIT_L(0); PG8_MMA(0, 1, At, B1); PG8_BAR;
            PG8_LDA(At, 1, 1); PG8_STAGE(PG8_SA(1, 0), a3, voffA);
            PG8_BAR; PG8_WAIT_L(0); PG8_MMA(1, 0, At, B0); PG8_BAR; PG8_SCHED;
            PG8_STAGE(PG8_SB(1, 1), b3 + hstepB, voffB);
            PG8_WAIT_V(6); PG8_BAR; PG8_MMA(1, 1, At, B1); PG8_BAR;
        }
        if constexpr (!Epi::AFTER_DRAIN) E(acc, cur, wr, wc, fr, fq);
        if (!has_next) break;
#pragma unroll
        for (int a = 0; a < 2; ++a)
#pragma unroll
            for (int b = 0; b < 2; ++b)
#pragma unroll
                for (int m = 0; m < 4; ++m)
#pragma unroll
                    for (int n = 0; n < 2; ++n) acc[a][b][m][n] = (f32x4){0.f, 0.f, 0.f, 0.f};
        cur = nxt; cA = nA; cB = nB; ++ui;
    }
    PG8_WAIT_V(0);
    if (wr == 0) PG8_BAR;
    PG8_BAR;
    if constexpr (Epi::AFTER_DRAIN) E.fused(acc, cur, wr, wc, fr, fq, lds);
#undef PG8_SA
#undef PG8_SB
#undef PG8_STAGE
#undef PG8_LDA
#undef PG8_LDB
#undef PG8_MMA
#undef PG8_WAIT_V
#undef PG8_WAIT_L
#undef PG8_BAR
#undef PG8_SCHED
}
}

struct EpiIn {
    static constexpr bool AFTER_DRAIN = false;
    bf16_t *Q, *V, *OG; bf16_t* G; const float* lb;
    __device__ __forceinline__ void operator()(const f32x4 (&acc)[2][2][4][2], const pg8::Unit& u, int wr, int wc, int fr, int fq) const {
        const int sblk = u.pn >> 2, type = sblk == 2 ? 3 : (sblk == 3 ? 2 : sblk);
        const int row0 = u.pm * 256 + wr * 64 + fr, col0 = (u.pn & 3) * 256 + wc * 32 + 8 * fq;
        if (type == 1) {
            f32x4 lbv[2][2];
#pragma unroll
            for (int bj = 0; bj < 2; ++bj) { lbv[bj][0] = *(const f32x4*)(lb + col0 + bj * 128); lbv[bj][1] = *(const f32x4*)(lb + col0 + bj * 128 + 4); }
#pragma unroll
            for (int ai = 0; ai < 2; ++ai)
#pragma unroll
                for (int m = 0; m < 4; ++m) { bf16_t* rowp = G + (size_t)(row0 + ai * 128 + m * 16) * 1024 + col0;
#pragma unroll
                    for (int bj = 0; bj < 2; ++bj) { f32x4 o0, o1; const f32x4 l0 = lbv[bj][0], l1 = lbv[bj][1];
#pragma unroll
                        for (int e = 0; e < 4; ++e) { o0[e] = ein_elem(1, acc[ai][bj][m][0][e], l0[e]); o1[e] = ein_elem(1, acc[ai][bj][m][1][e], l1[e]); }
                        u32x4 w; w.x = cvt_pk_f16(o0[0], o0[1]); w.y = cvt_pk_f16(o0[2], o0[3]); w.z = cvt_pk_f16(o1[0], o1[1]); w.w = cvt_pk_f16(o1[2], o1[3]);
                        *(u32x4*)(rowp + bj * 128) = w; }
                    asm volatile("" ::: "memory"); }
        } else {
            bf16_t* base = Q + (size_t)(type == 0 ? 0 : type - 1) * (ACT_B / 2);
            if (type == 0) store_bf16<0>(acc, base, row0, col0);
            else if (type == 2) store_bf16<2>(acc, base, row0, col0);
            else store_bf16<3>(acc, base, row0, col0);
        }
    }
    template <int TYPE> __device__ __forceinline__ void store_bf16(const f32x4 (&acc)[2][2][4][2], bf16_t* base, int row0, int col0) const {
#pragma unroll
        for (int ai = 0; ai < 2; ++ai)
#pragma unroll
            for (int m = 0; m < 4; ++m) { bf16_t* rowp = base + (size_t)(row0 + ai * 128 + m * 16) * 1024 + col0;
#pragma unroll
                for (int bj = 0; bj < 2; ++bj) { f32x4 o0, o1;
#pragma unroll
                    for (int e = 0; e < 4; ++e) { o0[e] = ein_elem(TYPE, acc[ai][bj][m][0][e], 0.f); o1[e] = ein_elem(TYPE, acc[ai][bj][m][1][e], 0.f); }
                    u32x4 w; w.x = cvt_pk_bf16(o0[0], o0[1]); w.y = cvt_pk_bf16(o0[2], o0[3]); w.z = cvt_pk_bf16(o1[0], o1[1]); w.w = cvt_pk_bf16(o1[2], o1[3]);
                    *(u32x4*)(rowp + bj * 128) = w; }
                asm volatile("" ::: "memory"); }
    }
};
template <bool IN16, bool OUT32> struct EpiRes {
    static constexpr bool AFTER_DRAIN = false;
    const float* Xin32; const bf16_t* Xin16; float* Xout32; bf16_t* Xb; const float* scale; float* part;
    __device__ __forceinline__ void operator()(const f32x4 (&acc)[2][2][4][2], const pg8::Unit& u, int wr, int wc, int fr, int fq) const {
        const int row0 = u.pm * 256 + wr * 64 + fr, col0 = u.pn * 256 + wc * 32 + 8 * fq;
        constexpr int NB = 2;
        f32x4 sc[2][2];
#pragma unroll
        for (int bj = 0; bj < 2; ++bj) { sc[bj][0] = scale ? *(const f32x4*)(scale + col0 + bj * 128) : (f32x4){1.f, 1.f, 1.f, 1.f}; sc[bj][1] = scale ? *(const f32x4*)(scale + col0 + bj * 128 + 4) : (f32x4){1.f, 1.f, 1.f, 1.f}; }
        constexpr int AIB = 2 / NB;
#pragma unroll
        for (int bt = 0; bt < NB; ++bt) {
            f32x4 xr[AIB][4][2][IN16 ? 1 : 2];
#pragma unroll
            for (int a2 = 0; a2 < AIB; ++a2)
#pragma unroll
                for (int m = 0; m < 4; ++m) { const int ai = bt * AIB + a2; const size_t off = (size_t)(row0 + ai * 128 + m * 16) * 1024 + col0;
#pragma unroll
                    for (int bj = 0; bj < 2; ++bj) {
                        if (IN16) xr[a2][m][bj][0] = __builtin_bit_cast(f32x4, *(const u32x4*)(Xin16 + xb_off(row0 + ai * 128 + m * 16, col0 + bj * 128)));
                        else { xr[a2][m][bj][0] = *(const f32x4*)(Xin32 + off + bj * 128); xr[a2][m][bj][IN16 ? 0 : 1] = *(const f32x4*)(Xin32 + off + bj * 128 + 4); } } }
#pragma unroll
            for (int a2 = 0; a2 < AIB; ++a2)
#pragma unroll
                for (int m = 0; m < 4; ++m) { const int ai = bt * AIB + a2; const int row = row0 + ai * 128 + m * 16; const size_t off = (size_t)row * 1024 + col0; float ss = 0.f;
#pragma unroll
                    for (int bj = 0; bj < 2; ++bj) {
                        const f32x4 a0 = acc[ai][bj][m][0] * sc[bj][0], a1 = acc[ai][bj][m][1] * sc[bj][1];
                        f32x4 x0, x1;
                        if (IN16) { const u32x4 w = __builtin_bit_cast(u32x4, xr[a2][m][bj][0]); x0 = (f32x4){bflo(w.x), bfhi(w.x), bflo(w.y), bfhi(w.y)}; x1 = (f32x4){bflo(w.z), bfhi(w.z), bflo(w.w), bfhi(w.w)}; }
                        else { x0 = xr[a2][m][bj][0]; x1 = xr[a2][m][bj][IN16 ? 0 : 1]; }
                        x0 = x0 + a0; x1 = x1 + a1;
                        if (OUT32) { *(f32x4*)(Xout32 + off + bj * 128) = x0; *(f32x4*)(Xout32 + off + bj * 128 + 4) = x1; }
                        if (Xb) { u32x4 w; w.x = cvt_pk_bf16(x0[0], x0[1]); w.y = cvt_pk_bf16(x0[2], x0[3]); w.z = cvt_pk_bf16(x1[0], x1[1]); w.w = cvt_pk_bf16(x1[2], x1[3]); *(u32x4*)(Xb + xb_off(row, col0 + bj * 128)) = w; }
                        ss += x0[0] * x0[0] + x0[1] * x0[1] + x0[2] * x0[2] + x0[3] * x0[3] + x1[0] * x1[0] + x1[1] * x1[1] + x1[2] * x1[2] + x1[3] * x1[3]; }
                    ss += __shfl_xor(ss, 16); ss += __shfl_xor(ss, 32);
                    if (fq == 0 && part) part[(size_t)row * 16 + u.pn * 4 + wc] = ss; }
            asm volatile("" ::: "memory"); }
    }
};
struct EpiFinal {
    static constexpr bool AFTER_DRAIN = true;
    const bf16_t* Xin16; float* Y; const float* gfin; float* part; unsigned* cnt;
    __device__ __forceinline__ void fused(f32x4 (&acc)[2][2][4][2], const pg8::Unit& u, int wr, int wc, int fr, int fq, LAS unsigned char* lds) const {
        const int row0 = u.pm * 256 + wr * 64 + fr, col0 = u.pn * 256 + wc * 32 + 8 * fq;
        u32x4 xr[2][4][2];
#pragma unroll
        for (int ai = 0; ai < 2; ++ai)
#pragma unroll
            for (int m = 0; m < 4; ++m) { const size_t off = (size_t)(row0 + ai * 128 + m * 16) * 1024 + col0;
#pragma unroll
                for (int bj = 0; bj < 2; ++bj) xr[ai][m][bj] = *(const u32x4*)(Xin16 + xb_off(row0 + ai * 128 + m * 16, col0 + bj * 128)); }
#pragma unroll
        for (int ai = 0; ai < 2; ++ai) {
#pragma unroll
            for (int m = 0; m < 4; ++m) { const int row = row0 + ai * 128 + m * 16; float ss = 0.f;
#pragma unroll
                for (int bj = 0; bj < 2; ++bj) { const u32x4 w = xr[ai][m][bj];
                    const f32x4 x0 = (f32x4){bflo(w.x), bfhi(w.x), bflo(w.y), bfhi(w.y)} + acc[ai][bj][m][0], x1 = (f32x4){bflo(w.z), bfhi(w.z), bflo(w.w), bfhi(w.w)} + acc[ai][bj][m][1];
                    acc[ai][bj][m][0] = x0; acc[ai][bj][m][1] = x1;
                    ss += x0[0] * x0[0] + x0[1] * x0[1] + x0[2] * x0[2] + x0[3] * x0[3] + x1[0] * x1[0] + x1[1] * x1[1] + x1[2] * x1[2] + x1[3] * x1[3]; }
                ss += __shfl_xor(ss, 16); ss += __shfl_xor(ss, 32);
                if (fq == 0) __hip_atomic_store(part + (size_t)row * 16 + u.pn * 4 + wc, ss, __ATOMIC_RELAXED, __HIP_MEMORY_SCOPE_AGENT); }
            asm volatile("" ::: "memory"); }
        asm volatile("s_waitcnt vmcnt(0)" ::: "memory");
        __syncthreads();
        if (threadIdx.x == 0) {
            __hip_atomic_fetch_add(cnt + u.pm, 1u, __ATOMIC_RELAXED, __HIP_MEMORY_SCOPE_AGENT);
            unsigned sp = 0;
            while (__hip_atomic_load(cnt + u.pm, __ATOMIC_RELAXED, __HIP_MEMORY_SCOPE_AGENT) < 4u) { __builtin_amdgcn_s_sleep(1); if (++sp > (1u << 20)) break; }
        }
        __syncthreads();
        LAS float* rsl = (LAS float*)lds;
        if (threadIdx.x < 256) { const float* pr = part + (size_t)(u.pm * 256 + threadIdx.x) * 16; float sq = 0.f;
#pragma unroll
            for (int i = 0; i < 16; ++i) sq += __hip_atomic_load(pr + i, __ATOMIC_RELAXED, __HIP_MEMORY_SCOPE_AGENT);
            rsl[threadIdx.x] = rsqrtf(sq * (1.f / 1024.f) + EPS); }
        __syncthreads();
#pragma unroll
        for (int ai = 0; ai < 2; ++ai)
#pragma unroll
            for (int m = 0; m < 4; ++m) { const int rl = ai * 128 + wr * 64 + m * 16 + fr; const float rs = rsl[rl]; float* yp = Y + (size_t)(u.pm * 256 + rl) * 1024 + col0;
#pragma unroll
                for (int bj = 0; bj < 2; ++bj) { const f32x4 g0 = *(const f32x4*)(gfin + col0 + bj * 128), g1 = *(const f32x4*)(gfin + col0 + bj * 128 + 4);
                    __builtin_nontemporal_store(acc[ai][bj][m][0] * rs * g0, (f32x4*)(yp + bj * 128)); __builtin_nontemporal_store(acc[ai][bj][m][1] * rs * g1, (f32x4*)(yp + bj * 128 + 4)); } }
        __syncthreads();
    }
};
struct EpiNull { float* sink; static constexpr bool AFTER_DRAIN = false;
    __device__ __forceinline__ void operator()(const f32x4 (&acc)[2][2][4][2], const pg8::Unit& u, int wr, int wc, int fr, int fq) const {
        f32x4 t = (f32x4){0.f, 0.f, 0.f, 0.f};
#pragma unroll
        for (int a = 0; a < 2; ++a)
#pragma unroll
            for (int b = 0; b < 2; ++b)
#pragma unroll
                for (int m = 0; m < 4; ++m)
#pragma unroll
                    for (int n = 0; n < 2; ++n) t = t + acc[a][b][m][n];
        if (t[0] + t[1] + t[2] + t[3] == 12345.678f) sink[0] = 1.f; } };
struct SNull { float* sink; __device__ __forceinline__ void rowpart(int, int, float) const {}
    __device__ __forceinline__ float operator()(int r, int c, f32x4 v) const { if (v[0] + v[1] + v[2] + v[3] == 12345.678f) sink[0] = 1.f; return 0.f; } };
struct EpiUp {
    static constexpr bool AFTER_DRAIN = false;
    bf16_t* H; const float* part;
    __device__ __forceinline__ void operator()(const f32x4 (&acc)[2][2][4][2], const pg8::Unit& u, int wr, int wc, int fr, int fq) const {
        const int row0 = u.pm * 256 + wr * 64 + fr, col0 = u.pn * 256 + wc * 32 + 8 * fq;
        f32x4 pv[2][4]; float rs[2][4];
#pragma unroll
        for (int ai = 0; ai < 2; ++ai)
#pragma unroll
            for (int m = 0; m < 4; ++m) pv[ai][m] = *(const f32x4*)(part + (size_t)(row0 + ai * 128 + m * 16) * 16 + fq * 4);
#pragma unroll
        for (int ai = 0; ai < 2; ++ai)
#pragma unroll
            for (int m = 0; m < 4; ++m) { float sq = (pv[ai][m][0] + pv[ai][m][1]) + (pv[ai][m][2] + pv[ai][m][3]); sq += __shfl_xor(sq, 16); sq += __shfl_xor(sq, 32); rs[ai][m] = rsqrtf(sq * (1.f / 1024.f) + EPS); }
#pragma unroll
        for (int ai = 0; ai < 2; ++ai)
#pragma unroll
            for (int m = 0; m < 4; ++m) { const int row = row0 + ai * 128 + m * 16; const float r = rs[ai][m]; bf16_t* rowp = H + ((size_t)(row >> 8) * 64 + (col0 >> 6)) * 16384 + (size_t)(row & 255) * 64 + (col0 & 63);
#pragma unroll
                for (int bj = 0; bj < 2; ++bj) { f32x4 o0, o1;
#pragma unroll
                    for (int e = 0; e < 4; ++e) { float a = fmaxf(acc[ai][bj][m][0][e] * r, 0.f), b2 = fmaxf(acc[ai][bj][m][1][e] * r, 0.f); o0[e] = a * a; o1[e] = b2 * b2; }
                    u32x4 w; w.x = cvt_pk_bf16(o0[0], o0[1]); w.y = cvt_pk_bf16(o0[2], o0[3]); w.z = cvt_pk_bf16(o1[0], o1[1]); w.w = cvt_pk_bf16(o1[2], o1[3]);
                    *(u32x4*)(rowp + (size_t)bj * 2 * 16384) = w; } }
    }
};

template <int NCT, class F>
__device__ __forceinline__ void sample_gemm(LAS unsigned char* lds, const bf16_t* A, int lda, int agroup, const bf16_t* Bt, int K, const F& f) {
    constexpr int CT = NCT * 16;
    const int tid = threadIdx.x, wid = tid >> 6, lane = tid & 63, fr = lane & 15, fq = lane >> 4;
    LAS float* red = (LAS float*)lds;
    for (int blk = blockIdx.x; blk < 256; blk += gridDim.x) {
        const int rb = blk & 3, cb = blk >> 2, r0 = rb * 32, c0 = cb * CT;
        const int Kw = K >> 3, kb = wid * Kw;
        const bf16_t* Ab = A + (size_t)(c0 >> 8) * agroup;
        f32x4 acc[2][NCT];
#pragma unroll
        for (int i = 0; i < 2; ++i)
#pragma unroll
            for (int j = 0; j < NCT; ++j) acc[i][j] = (f32x4){0.f, 0.f, 0.f, 0.f};
        constexpr int UN = NCT == 1 ? 8 : 2;
        for (int k = kb; k < kb + Kw; k += 32 * UN) {
            bf16x8 af[UN][2], bfr[UN][NCT];
#pragma unroll
            for (int uu = 0; uu < UN; ++uu) { const int ku = k + 32 * uu; const bool ok = ku < kb + Kw;
#pragma unroll
                for (int i = 0; i < 2; ++i) af[uu][i] = ok ? *(const bf16x8*)(Ab + (size_t)(r0 + i * 16 + fr) * lda + ku + fq * 8) : (bf16x8){0, 0, 0, 0, 0, 0, 0, 0};
#pragma unroll
                for (int j = 0; j < NCT; ++j) bfr[uu][j] = ok ? *(const bf16x8*)(Bt + (size_t)(c0 + j * 16 + fr) * K + ku + fq * 8) : (bf16x8){0, 0, 0, 0, 0, 0, 0, 0}; }
#pragma unroll
            for (int uu = 0; uu < UN; ++uu)
#pragma unroll
                for (int i = 0; i < 2; ++i)
#pragma unroll
                    for (int j = 0; j < NCT; ++j) acc[i][j] = __builtin_amdgcn_mfma_f32_16x16x32_bf16(bfr[uu][j], af[uu][i], acc[i][j], 0, 0, 0);
        }
#pragma unroll
        for (int i = 0; i < 2; ++i)
#pragma unroll
            for (int j = 0; j < NCT; ++j) *(LAS f32x4*)(red + ((size_t)wid * 32 + i * 16 + fr) * CT + j * 16 + fq * 4) = acc[i][j];
        __syncthreads();
        constexpr int NG = 32 * CT / 4;
        for (int i = tid; i < NG; i += 512) { const int row = i / (CT / 4), cgp = i % (CT / 4);
            f32x4 s = (f32x4){0.f, 0.f, 0.f, 0.f};
#pragma unroll
            for (int w = 0; w < 8; ++w) s = s + *(const LAS f32x4*)(red + ((size_t)w * 32 + row) * CT + cgp * 4);
            float ss = f(r0 + row, c0 + cgp * 4, s);
#pragma unroll
            for (int o = 1; o < CT / 4; o <<= 1) ss += __shfl_xor(ss, o);
            if (cgp == 0) f.rowpart(r0 + row, cb, ss); }
        __syncthreads();
    }
}
struct SIn { bf16_t *Q, *V, *OG; bf16_t* G; const float* lb;
    __device__ __forceinline__ void rowpart(int, int, float) const {}
    __device__ __forceinline__ float operator()(int r, int c, f32x4 v) const { const int sblk = c >> 10, type = sblk == 2 ? 3 : (sblk == 3 ? 2 : sblk), cc = c & 1023; const size_t off = (size_t)(TP + r) * 1024 + cc;
        if (type == 1) { f32x4 o;
#pragma unroll
            for (int e = 0; e < 4; ++e) o[e] = ein_elem(1, v[e], lb[cc + e]);
            u32x2 w; w.x = cvt_pk_f16(o[0], o[1]); w.y = cvt_pk_f16(o[2], o[3]); *(u32x2*)(G + off) = w; }
        else { bf16_t* base = Q + (size_t)(type == 0 ? 0 : type - 1) * (ACT_B / 2); f32x4 o;
            if (type == 0) {
#pragma unroll
                for (int e = 0; e < 4; ++e) o[e] = ein_elem(0, v[e], 0.f); }
            else if (type == 2) o = v;
            else {
#pragma unroll
                for (int e = 0; e < 4; ++e) o[e] = ein_elem(3, v[e], 0.f); }
            u32x2 w; w.x = cvt_pk_bf16(o[0], o[1]); w.y = cvt_pk_bf16(o[2], o[3]); *(u32x2*)(base + off) = w; } return 0.f; } };
struct SRes { const float* Xin; float* Xout; bf16_t* Xb; const float* scale; float* parts;
    __device__ __forceinline__ void rowpart(int r, int cb, float ss) const { if (parts) parts[r * 64 + cb] = ss; }
    __device__ __forceinline__ float operator()(int r, int c, f32x4 v) const { const size_t off = (size_t)r * 1024 + c;
        f32x4 x = *(const f32x4*)(Xin + off); if (scale) v = v * *(const f32x4*)(scale + c); x = x + v; *(f32x4*)(Xout + off) = x;
        if (Xb) { u32x2 w; w.x = cvt_pk_bf16(x[0], x[1]); w.y = cvt_pk_bf16(x[2], x[3]); *(u32x2*)(Xb + off) = w; }
        return x[0] * x[0] + x[1] * x[1] + x[2] * x[2] + x[3] * x[3]; } };
struct SUp { bf16_t* H; const float* parts;
    __device__ __forceinline__ void rowpart(int, int, float) const {}
    __device__ __forceinline__ float operator()(int r, int c, f32x4 v) const { f32x4 t = (f32x4){0.f, 0.f, 0.f, 0.f};
#pragma unroll
        for (int i = 0; i < 16; ++i) t = t + *(const f32x4*)(parts + r * 64 + i * 4);
        const float rs = rsqrtf(((t[0] + t[1]) + (t[2] + t[3])) * (1.f / 1024.f) + EPS); f32x4 o;
#pragma unroll
        for (int e = 0; e < 4; ++e) { float a = fmaxf(v[e] * rs, 0.f); o[e] = a * a; }
        u32x2 w; w.x = cvt_pk_bf16(o[0], o[1]); w.y = cvt_pk_bf16(o[2], o[3]); *(u32x2*)(H + (size_t)r * 4096 + c) = w; return 0.f; } };

struct TJob { const float* src; bf16_t* dst; const float* gain; int N, ldd, k0, n0; };
__device__ __forceinline__ bool prep_job(const Params& p, int it, TJob& j) {
    unsigned char* ws = p.ws;
    constexpr int T_IN = 1024, T_OUT = 256, T_UP = 1024, T_DN = 1024, T_P = 64;
    constexpr int NT = T_IN + T_OUT + 2 * T_UP + 2 * T_DN + T_P;
    if (it >= NT) return false;
    int r = it; j.gain = nullptr;
    if (r < T_IN) { j.src = p.hgrn_w_in; j.N = 4096; j.dst = (bf16_t*)(ws + WS_WIN); j.ldd = 1024; j.k0 = (r >> 6) * 64; j.n0 = (r & 63) * 64; return true; } r -= T_IN;
    if (r < T_OUT) { j.src = p.hgrn_w_out; j.N = 1024; j.dst = (bf16_t*)(ws + WS_WOUT); j.ldd = 1024; j.k0 = (r >> 4) * 64; j.n0 = (r & 15) * 64; return true; } r -= T_OUT;
    if (r < T_UP) { j.src = p.mlp_up; j.N = 4096; j.dst = (bf16_t*)(ws + WS_WUP0); j.ldd = 1024; j.k0 = (r >> 6) * 64; j.n0 = (r & 63) * 64; j.gain = p.mlp_norm; return true; } r -= T_UP;
    if (r < T_UP) { j.src = p.mlp_up + (size_t)1024 * 4096; j.N = 4096; j.dst = (bf16_t*)(ws + WS_WUP1); j.ldd = 1024; j.k0 = (r >> 6) * 64; j.n0 = (r & 63) * 64; j.gain = p.mlp_norm + 1024; return true; } r -= T_UP;
    if (r < T_DN) { j.src = p.mlp_down; j.N = 1024; j.dst = (bf16_t*)(ws + WS_WDN0); j.ldd = 4096; j.k0 = (r >> 4) * 64; j.n0 = (r & 15) * 64; return true; } r -= T_DN;
    if (r < T_DN) { j.src = p.mlp_down + (size_t)4096 * 1024; j.N = 1024; j.dst = (bf16_t*)(ws + WS_WDN1); j.ldd = 4096; j.k0 = (r >> 4) * 64; j.n0 = (r & 15) * 64; return true; } r -= T_DN;
    { const int g = r >> 4, rr = r & 15; j.src = p.pool_w + (size_t)g * 65536; j.N = 256; j.dst = (bf16_t*)(ws + WS_WP) + (size_t)g * 65536; j.ldd = 256; j.k0 = (rr >> 2) * 64; j.n0 = (rr & 3) * 64; }
    return true;
}
__device__ __forceinline__ void phase_prep(const Params& p, LAS unsigned char* lds) {
    LAS float* tiles = (LAS float*)lds;
    unsigned char* ws = p.ws;
    constexpr int NT = 1024 + 256 + 2 * 1024 + 2 * 1024 + 64;
    { const int tid = threadIdx.x, i = tid >> 4, j4 = (tid & 15) * 4, n = tid >> 3, k8 = (tid & 7) * 8;
#pragma unroll 1
      for (int it0 = blockIdx.x; it0 < NT; it0 += 2 * gridDim.x) {
          TJob j[2]; bool ok[2]; f32x4 v[2][2];
#pragma unroll
          for (int q = 0; q < 2; ++q) { ok[q] = prep_job(p, it0 + q * gridDim.x, j[q]);
              if (ok[q]) {
#pragma unroll
                  for (int hh = 0; hh < 2; ++hh) v[q][hh] = __builtin_nontemporal_load((const f32x4*)(j[q].src + (size_t)(j[q].k0 + i + 32 * hh) * j[q].N + j[q].n0 + j4)); } }
#pragma unroll
          for (int q = 0; q < 2; ++q) if (ok[q]) {
#pragma unroll
              for (int hh = 0; hh < 2; ++hh)
#pragma unroll
                  for (int e = 0; e < 4; ++e) tiles[q * 4160 + (j4 + e) * 65 + i + 32 * hh] = v[q][hh][e]; }
          __syncthreads();
#pragma unroll
          for (int q = 0; q < 2; ++q) if (ok[q]) { float o[8];
#pragma unroll
              for (int e = 0; e < 8; ++e) { o[e] = tiles[q * 4160 + n * 65 + k8 + e]; if (j[q].gain) o[e] *= j[q].gain[j[q].k0 + k8 + e]; }
              u32x4 w; w.x = cvt_pk_bf16(o[0], o[1]); w.y = cvt_pk_bf16(o[2], o[3]); w.z = cvt_pk_bf16(o[4], o[5]); w.w = cvt_pk_bf16(o[6], o[7]);
              int nd = j[q].n0; if (j[q].src == p.hgrn_w_in) { const int ob = nd >> 10; nd = (nd & 1023) + ((ob == 2 ? 3 : ob == 3 ? 2 : ob) << 10); }
              *(u32x4*)(j[q].dst + (size_t)(nd + n) * j[q].ldd + j[q].k0 + k8) = w; }
          __syncthreads();
      } }
    const int tid = threadIdx.x, wid = tid >> 6, lane = tid & 63;
    bf16_t* U = (bf16_t*)(ws + WS_R2);
    for (int row0 = blockIdx.x * 8 + wid; row0 < MP; row0 += gridDim.x * 32) {
        f32x4 v[4][4];
#pragma unroll
        for (int rr = 0; rr < 4; ++rr) { const int row = row0 + rr * gridDim.x * 8; if (row < MP) { const float* src = row < TP ? p.x_prompt + (size_t)row * 1024 : p.x_sample + (size_t)(row - TP) * 1024;
#pragma unroll
            for (int j = 0; j < 4; ++j) v[rr][j] = *(const f32x4*)(src + lane * 4 + 256 * j); } }
#pragma unroll
        for (int rr = 0; rr < 4; ++rr) { const int row = row0 + rr * gridDim.x * 8; if (row < MP) { float sacc = 0.f;
#pragma unroll
            for (int j = 0; j < 4; ++j) sacc += v[rr][j][0] * v[rr][j][0] + v[rr][j][1] * v[rr][j][1] + v[rr][j][2] * v[rr][j][2] + v[rr][j][3] * v[rr][j][3];
            const float rs = rsqrtf(wave_sum(sacc) * (1.f / 1024.f) + EPS);
#pragma unroll
            for (int j = 0; j < 4; ++j) { const f32x4 g = *(const f32x4*)(p.hgrn_norm + lane * 4 + 256 * j);
                u32x2 w; w.x = cvt_pk_bf16(v[rr][j][0] * rs * g[0], v[rr][j][1] * rs * g[1]); w.y = cvt_pk_bf16(v[rr][j][2] * rs * g[2], v[rr][j][3] * rs * g[3]);
                *(u32x2*)(U + (size_t)row * 1024 + lane * 4 + 256 * j) = w; } } }
    }
    if (blockIdx.x < 2) { const int c = blockIdx.x * 512 + tid; ((float*)(ws + WS_LB))[c] = lb_of(p.hgrn_lb, c); }
}

__device__ __forceinline__ bf16x8 lds_frag(const LAS bf16_t* p) { return *(const LAS bf16x8*)p; }
__device__ __forceinline__ void rec_prompt(const Params& p, LAS unsigned char* lds, int b, int h, int seg) {
    const int tid = threadIdx.x, wid = tid >> 6, lane = tid & 63, fr = lane & 15, fq = lane >> 4;
    LAS bf16_t* QT = (LAS bf16_t*)(lds + 0);
    LAS bf16_t* KT = (LAS bf16_t*)(lds + 17408);
    LAS bf16_t* KH = (LAS bf16_t*)(lds + 34816);
    LAS bf16_t* VT = (LAS bf16_t*)(lds + 53248);
    LAS bf16_t* SB = (LAS bf16_t*)(lds + 71680);
    LAS bf16_t* AM = (LAS bf16_t*)(lds + 106496);
    LAS float* TOT = (LAS float*)(lds + 115712);
    LAS float* DD = (LAS float*)(lds + 119808);
    LAS float* SSQ = (LAS float*)(lds + 120320);
    const unsigned char* ws = p.ws;
    const size_t gbase = (size_t)b * SEQ * 1024 + h * 128;
    const bf16_t* Qg = (const bf16_t*)(ws + WS_Q) + gbase; const bf16_t* Vg = (const bf16_t*)(ws + WS_V) + gbase; const bf16_t* OGg = (const bf16_t*)(ws + WS_OG) + gbase;
    const bf16_t* Gg = (const bf16_t*)(ws + WS_G) + gbase;
    bf16_t* Og = (bf16_t*)(p.ws + WS_R2) + gbase;
    bf16_t* QCg = (bf16_t*)(p.ws + WS_R2) + gbase;
    float* OLg = p.out + gbase;
    f32x2 Gseg = (f32x2){0.f, 0.f};
    f32x4 Sacc[8];
#pragma unroll
    for (int i = 0; i < 8; ++i) Sacc[i] = (f32x4){0.f, 0.f, 0.f, 0.f};
    const int d2 = (tid & 63) * 2, part = tid >> 6;
    unsigned gr[8], qr[8], vr[8];
#define REC_LOAD(c) do { const unsigned o_ = (unsigned)(((c) * 64 + part * 8) * 1024 + d2); \
        _Pragma("unroll") for (int i = 0; i < 8; ++i) { gr[i] = *(const unsigned*)(Gg + o_ + (unsigned)i * 1024u); qr[i] = *(const unsigned*)(Qg + o_ + (unsigned)i * 1024u); vr[i] = *(const unsigned*)(Vg + o_ + (unsigned)i * 1024u); } } while (0)
    REC_LOAD(seg * 8);
    const int tb = wid & 3, vh = wid >> 2;
    for (int cc = 0; cc < 8; ++cc) {
        const int c = seg * 8 + cc;
#pragma unroll
        for (int vb = 0; vb < 8; ++vb) { u32x2 w; w.x = cvt_pk_bf16(Sacc[vb][0], Sacc[vb][1]); w.y = cvt_pk_bf16(Sacc[vb][2], Sacc[vb][3]);
            *(LAS u32x2*)(SB + (vb * 16 + fr) * 136 + wid * 16 + fq * 4) = w; }
        f32x2 cs[8];
        { f32x2 run = (f32x2){0.f, 0.f};
#pragma unroll
          for (int i = 0; i < 8; ++i) { run = run + h2_to_f2(gr[i]); cs[i] = run; }
          *(LAS f32x2*)(TOT + part * 128 + d2) = run; }
        __syncthreads();
        { f32x2 off = (f32x2){0.f, 0.f}, Gl = (f32x2){0.f, 0.f};
#pragma unroll
          for (int pp = 0; pp < 8; ++pp) { const f32x2 tv = *(const LAS f32x2*)(TOT + pp * 128 + d2); Gl = Gl + tv; if (pp < part) off = off + tv; }
          const float eGl0 = __expf(Gl[0]), eGl1 = __expf(Gl[1]), eGs0 = __expf(Gseg[0]), eGs1 = __expf(Gseg[1]);
          float kh0[8], kh1[8];
#pragma unroll
          for (int i = 0; i < 8; ++i) { const int t = part * 8 + i; const f32x2 G = off + cs[i];
              const float e0 = __expf(G[0]), e1 = __expf(G[1]), ei0 = __builtin_amdgcn_rcpf(e0), ei1 = __builtin_amdgcn_rcpf(e1);
              const f32x2 gv = h2_to_f2(gr[i]); const float k0 = 1.f - __expf(gv[0]), k1 = 1.f - __expf(gv[1]);
              const float q0 = bflo(qr[i]) * e0, q1 = bfhi(qr[i]) * e1;
              *(LAS unsigned*)(QT + t * 136 + d2) = cvt_pk_bf16(q0, q1); *(LAS unsigned*)(KT + t * 136 + d2) = cvt_pk_bf16(k0 * ei0, k1 * ei1);
              kh0[i] = k0 * eGl0 * ei0; kh1[i] = k1 * eGl1 * ei1;
              if (seg > 0) *(unsigned*)(QCg + (unsigned)((c * 64 + t) * 1024 + d2)) = cvt_pk_bf16(q0 * eGs0, q1 * eGs1); }
          Gseg = Gseg + Gl;
          u32x4 w0, w1; w0.x = cvt_pk_bf16(kh0[0], kh0[1]); w0.y = cvt_pk_bf16(kh0[2], kh0[3]); w0.z = cvt_pk_bf16(kh0[4], kh0[5]); w0.w = cvt_pk_bf16(kh0[6], kh0[7]);
          w1.x = cvt_pk_bf16(kh1[0], kh1[1]); w1.y = cvt_pk_bf16(kh1[2], kh1[3]); w1.z = cvt_pk_bf16(kh1[4], kh1[5]); w1.w = cvt_pk_bf16(kh1[6], kh1[7]);
          *(LAS u32x4*)(KH + d2 * 72 + part * 8) = w0; *(LAS u32x4*)(KH + (d2 + 1) * 72 + part * 8) = w1;
          u32x4 v0, v1;
          v0.x = (vr[0] & 0xffffu) | (vr[1] << 16); v0.y = (vr[2] & 0xffffu) | (vr[3] << 16); v0.z = (vr[4] & 0xffffu) | (vr[5] << 16); v0.w = (vr[6] & 0xffffu) | (vr[7] << 16);
          v1.x = (vr[0] >> 16) | (vr[1] & 0xffff0000u); v1.y = (vr[2] >> 16) | (vr[3] & 0xffff0000u); v1.z = (vr[4] >> 16) | (vr[5] & 0xffff0000u); v1.w = (vr[6] >> 16) | (vr[7] & 0xffff0000u);
          *(LAS u32x4*)(VT + d2 * 72 + part * 8) = v0; *(LAS u32x4*)(VT + (d2 + 1) * 72 + part * 8) = v1;
          if (part == 0) *(LAS f32x2*)(DD + d2) = (f32x2){eGl0, eGl1}; }
        if (cc + 1 < 8) REC_LOAD(c + 1);
        __syncthreads();
        { const int sb = wid >> 1;
#pragma unroll
          for (int ti = 0; ti < 2; ++ti) { const int tbb = (wid & 1) * 2 + ti; f32x4 a = (f32x4){0.f, 0.f, 0.f, 0.f};
              if (sb <= tbb) {
#pragma unroll
                  for (int kk = 0; kk < 4; ++kk) a = __builtin_amdgcn_mfma_f32_16x16x32_bf16(lds_frag(KT + (sb * 16 + fr) * 136 + kk * 32 + fq * 8), lds_frag(QT + (tbb * 16 + fr) * 136 + kk * 32 + fq * 8), a, 0, 0, 0);
                  const int t = tbb * 16 + fr, s0 = sb * 16 + fq * 4;
#pragma unroll
                  for (int j = 0; j < 4; ++j) if (s0 + j > t) a[j] = 0.f; }
              u32x2 w; w.x = cvt_pk_bf16(a[0], a[1]); w.y = cvt_pk_bf16(a[2], a[3]);
              *(LAS u32x2*)(AM + (tbb * 16 + fr) * 72 + sb * 16 + fq * 4) = w; } }
        { const f32x4 dd = *(const LAS f32x4*)(DD + wid * 16 + fq * 4);
          const bf16x8 a0 = lds_frag(KH + (wid * 16 + fr) * 72 + fq * 8), a1 = lds_frag(KH + (wid * 16 + fr) * 72 + 32 + fq * 8);
#pragma unroll
          for (int vb = 0; vb < 8; ++vb) { f32x4 a = Sacc[vb] * dd;
              a = __builtin_amdgcn_mfma_f32_16x16x32_bf16(a0, lds_frag(VT + (vb * 16 + fr) * 72 + fq * 8), a, 0, 0, 0);
              a = __builtin_amdgcn_mfma_f32_16x16x32_bf16(a1, lds_frag(VT + (vb * 16 + fr) * 72 + 32 + fq * 8), a, 0, 0, 0);
              Sacc[vb] = a; } }
        __syncthreads();
        f32x4 oacc[4]; u32x2 ogv[4];
        const size_t tok = (size_t)c * 64 + tb * 16 + fr;
        if (seg == 0) {
#pragma unroll
        for (int vi = 0; vi < 4; ++vi) ogv[vi] = *(const u32x2*)(OGg + tok * 1024 + (vh * 4 + vi) * 16 + fq * 4); }
        { bf16x8 qf[4], af[2];
#pragma unroll
          for (int kk = 0; kk < 4; ++kk) qf[kk] = lds_frag(QT + (tb * 16 + fr) * 136 + kk * 32 + fq * 8);
#pragma unroll
          for (int kk = 0; kk < 2; ++kk) af[kk] = lds_frag(AM + (tb * 16 + fr) * 72 + kk * 32 + fq * 8);
#pragma unroll
          for (int vi = 0; vi < 4; ++vi) { const int vb = vh * 4 + vi; f32x4 a = (f32x4){0.f, 0.f, 0.f, 0.f};
#pragma unroll
              for (int kk = 0; kk < 4; ++kk) a = __builtin_amdgcn_mfma_f32_16x16x32_bf16(lds_frag(SB + (vb * 16 + fr) * 136 + kk * 32 + fq * 8), qf[kk], a, 0, 0, 0);
#pragma unroll
              for (int kk = 0; kk < 2; ++kk) a = __builtin_amdgcn_mfma_f32_16x16x32_bf16(lds_frag(VT + (vb * 16 + fr) * 72 + kk * 32 + fq * 8), af[kk], a, 0, 0, 0);
              oacc[vi] = a; } }
        if (seg == 0) {
        { float ss = 0.f;
#pragma unroll
          for (int vi = 0; vi < 4; ++vi) ss += oacc[vi][0] * oacc[vi][0] + oacc[vi][1] * oacc[vi][1] + oacc[vi][2] * oacc[vi][2] + oacc[vi][3] * oacc[vi][3];
          ss += __shfl_xor(ss, 16); ss += __shfl_xor(ss, 32);
          if (fq == 0) SSQ[vh * 64 + tb * 16 + fr] = ss; }
        __syncthreads();
        { const float tot = SSQ[tb * 16 + fr] + SSQ[64 + tb * 16 + fr]; const float rs = rsqrtf(tot * (1.f / 128.f) + EPS);
#pragma unroll
          for (int vi = 0; vi < 4; ++vi) { const f32x4 o = oacc[vi] * rs * *(const f32x4*)(p.hgrn_onorm + h * 128 + (vh * 4 + vi) * 16 + fq * 4);
              u32x2 w; w.x = cvt_pk_bf16(o[0] * bflo(ogv[vi].x), o[1] * bfhi(ogv[vi].x)); w.y = cvt_pk_bf16(o[2] * bflo(ogv[vi].y), o[3] * bfhi(ogv[vi].y));
              *(u32x2*)(Og + tok * 1024 + (vh * 4 + vi) * 16 + fq * 4) = w; } }
        } else {
#pragma unroll
          for (int vi = 0; vi < 4; ++vi) *(f32x4*)(OLg + tok * 1024 + (vh * 4 + vi) * 16 + fq * 4) = oacc[vi];
          __syncthreads();
        }
    }
#undef REC_LOAD
    float* So = seg == 3 ? p.out + O_HP + (size_t)(b * 8 + h) * 16384 : (float*)(p.ws + WS_LSEG) + ((size_t)(b * 8 + h) * 3 + seg) * 16384;
    if (part == 0) *(f32x2*)((float*)(p.ws + WS_DSEG) + ((size_t)(b * 8 + h) * 4 + seg) * 128 + d2) = (f32x2){__expf(Gseg[0]), __expf(Gseg[1])};
#pragma unroll
    for (int vb = 0; vb < 8; ++vb)
#pragma unroll
        for (int j = 0; j < 4; ++j) So[(size_t)(wid * 16 + fq * 4 + j) * 128 + vb * 16 + fr] = Sacc[vb][j];
    __syncthreads();
}
__device__ __forceinline__ void rec_sample(const Params& p, LAS unsigned char* lds, int item) {
    const int tid = threadIdx.x, b = item >> 3, h = item & 7;
    LAS float* qs = (LAS float*)lds; LAS float* fs = qs + 128; LAS float* ks = qs + 256; LAS float* vs = qs + 384; LAS float* red = qs + 512;
    LAS float* sq = qs + 512 + 2048;
    const unsigned char* ws = p.ws;
    const size_t roff = (size_t)(TP + b) * 1024 + h * 128;
    if (tid < 128) { qs[tid] = bf2f(((const bf16_t*)(ws + WS_Q))[roff + tid]); const float f = __expf((float)((const _Float16*)(ws + WS_G))[roff + tid]); fs[tid] = f; ks[tid] = 1.f - f;
        vs[tid] = bf2f(((const bf16_t*)(ws + WS_V))[roff + tid]); }
    __syncthreads();
    const int v4 = (tid & 31) * 4, dg = tid >> 5;
    const float* Sin = p.state_hgrn + (size_t)item * 16384; float* Sout = p.out + O_HS + (size_t)item * 16384;
    const f32x4 vv = *(const LAS f32x4*)(vs + v4);
    f32x4 o = (f32x4){0.f, 0.f, 0.f, 0.f};
    f32x4 sv[8];
#pragma unroll
    for (int i = 0; i < 8; ++i) sv[i] = *(const f32x4*)(Sin + (size_t)(dg * 8 + i) * 128 + v4);
#pragma unroll
    for (int i = 0; i < 8; ++i) { const int dd = dg * 8 + i; const f32x4 sn = sv[i] * fs[dd] + vv * ks[dd]; *(f32x4*)(Sout + (size_t)dd * 128 + v4) = sn; o = o + sn * qs[dd]; }
    *(LAS f32x4*)(red + dg * 128 + v4) = o;
    __syncthreads();
    float ov = 0.f;
    if (tid < 128) {
#pragma unroll
        for (int i = 0; i < 16; ++i) ov += red[i * 128 + tid];
        const float s = wave_sum(ov * ov); if ((tid & 63) == 0) sq[tid >> 6] = s; }
    __syncthreads();
    if (tid < 128) { const float rs = rsqrtf((sq[0] + sq[1]) * (1.f / 128.f) + EPS);
        const float og = bf2f(((const bf16_t*)(ws + WS_OG))[roff + tid]);
        ((bf16_t*)(p.ws + WS_R2))[roff + tid] = f2bf(ov * rs * p.hgrn_onorm[h * 128 + tid] * og); }
    __syncthreads();
}

__device__ __forceinline__ void rec_sample_list(const Params& p, LAS unsigned char* lds, int first, int stride, int count, size_t obase = WS_R2) {
    const int tid = threadIdx.x;
    LAS float* qs = (LAS float*)lds; LAS float* fs = qs + 128; LAS float* ks = qs + 256; LAS float* vs = qs + 384; LAS float* red = qs + 512;
    LAS float* sq = qs + 512 + 2048;
    const unsigned char* ws = p.ws;
    const int v4 = (tid & 31) * 4, dg = tid >> 5;
    f32x4 svA[8], svB[8]; float lqA = 0.f, lgA = 0.f, lvA = 0.f, loA = 0.f, lqB = 0.f, lgB = 0.f, lvB = 0.f, loB = 0.f;
#define RS_ISSUE(item_, sv, lq, lg, lv, lo) do { const int it_ = (item_); const size_t ro_ = (size_t)(TP + (it_ >> 3)) * 1024 + (it_ & 7) * 128; \
        if (tid < 128) { lq = bf2f(((const bf16_t*)(ws + WS_Q))[ro_ + tid]); lg = (float)((const _Float16*)(ws + WS_G))[ro_ + tid]; lv = bf2f(((const bf16_t*)(ws + WS_V))[ro_ + tid]); lo = bf2f(((const bf16_t*)(ws + WS_OG))[ro_ + tid]); } \
        const float* Sin_ = p.state_hgrn + (size_t)it_ * 16384; \
        _Pragma("unroll") for (int i = 0; i < 8; ++i) sv[i] = __builtin_nontemporal_load((const f32x4*)(Sin_ + (size_t)(dg * 8 + i) * 128 + v4)); } while (0)
#define RS_ITEM(j_, sv, lq, lg, lv, lo) do { \
        const int item = first + (j_) * stride, b = item >> 3, h = item & 7; \
        const size_t roff = (size_t)(TP + b) * 1024 + h * 128; \
        const float og = lo; \
        if (tid < 128) { const float f = __expf(lg); qs[tid] = lq; fs[tid] = f; ks[tid] = 1.f - f; vs[tid] = lv; } \
        __syncthreads(); \
        float* Sout = p.out + O_HS + (size_t)item * 16384; \
        const f32x4 vv = *(const LAS f32x4*)(vs + v4); \
        f32x4 o = (f32x4){0.f, 0.f, 0.f, 0.f}; \
        _Pragma("unroll") for (int i = 0; i < 8; ++i) { const int dd = dg * 8 + i; const f32x4 sn = sv[i] * fs[dd] + vv * ks[dd]; __builtin_nontemporal_store(sn, (f32x4*)(Sout + (size_t)dd * 128 + v4)); o = o + sn * qs[dd]; } \
        if ((j_) + 2 < count) RS_ISSUE(first + ((j_) + 2) * stride, sv, lq, lg, lv, lo); \
        *(LAS f32x4*)(red + dg * 128 + v4) = o; \
        __syncthreads(); \
        float ov = 0.f; \
        if (tid < 128) { \
            _Pragma("unroll") for (int i = 0; i < 16; ++i) ov += red[i * 128 + tid]; \
            const float s2 = wave_sum(ov * ov); if ((tid & 63) == 0) sq[tid >> 6] = s2; } \
        __syncthreads(); \
        if (tid < 128) { const float rs = rsqrtf((sq[0] + sq[1]) * (1.f / 128.f) + EPS); \
            ((bf16_t*)(p.ws + obase))[roff + tid] = f2bf(ov * rs * p.hgrn_onorm[h * 128 + tid] * og); } \
        __syncthreads(); } while (0)
    if (count > 0) RS_ISSUE(first, svA, lqA, lgA, lvA, loA);
    if (count > 1) RS_ISSUE(first + stride, svB, lqB, lgB, lvB, loB);
    for (int j = 0; j < count; j += 2) {
        RS_ITEM(j, svA, lqA, lgA, lvA, loA);
        if (j + 1 < count) RS_ITEM(j + 1, svB, lqB, lgB, lvB, loB);
    }
#undef RS_ITEM
#undef RS_ISSUE
}
__device__ __forceinline__ void rec_fix(const Params& p, LAS unsigned char* lds, int b, int h, int seg) {
    const int tid = threadIdx.x, wid = tid >> 6, lane = tid & 63, fr = lane & 15, fq = lane >> 4;
    LAS bf16_t* QT = (LAS bf16_t*)(lds + 0);
    LAS bf16_t* SB = (LAS bf16_t*)(lds + 71680);
    LAS float* SSQ = (LAS float*)(lds + 118272);
    const unsigned char* ws = p.ws;
    const int bh = b * 8 + h;
    const size_t gbase = (size_t)b * SEQ * 1024 + h * 128;
    const bf16_t* OGg = (const bf16_t*)(ws + WS_OG) + gbase; const bf16_t* QCg = (const bf16_t*)(ws + WS_R2) + gbase;
    const float* OLg = p.out + gbase; bf16_t* Og = (bf16_t*)(p.ws + WS_R2) + gbase;
    const float* Ls = (const float*)(ws + WS_LSEG) + (size_t)bh * 3 * 16384; const float* Ds = (const float*)(ws + WS_DSEG) + (size_t)bh * 4 * 128;
    { f32x4 S[8];
#pragma unroll
      for (int i = 0; i < 8; ++i) S[i] = (f32x4){0.f, 0.f, 0.f, 0.f};
      f32x4 Lr[3][8]; float Dr[3][8];
#pragma unroll
      for (int sp = 0; sp < 3; ++sp)
#pragma unroll
          for (int i = 0; i < 8; ++i) { const int e4 = (tid + 512 * i) * 4, dd = e4 >> 7;
              if (sp < seg) { Lr[sp][i] = *(const f32x4*)(Ls + (size_t)sp * 16384 + e4); Dr[sp][i] = Ds[sp * 128 + dd]; } else { Lr[sp][i] = (f32x4){0.f, 0.f, 0.f, 0.f}; Dr[sp][i] = 1.f; } }
#pragma unroll
      for (int sp = 0; sp < 3; ++sp)
#pragma unroll
          for (int i = 0; i < 8; ++i) S[i] = S[i] * Dr[sp][i] + Lr[sp][i];
#pragma unroll
      for (int i = 0; i < 8; ++i) { const int e4 = (tid + 512 * i) * 4, dd = e4 >> 7, v0 = e4 & 127;
#pragma unroll
          for (int j = 0; j < 4; ++j) SB[(v0 + j) * 136 + dd] = f2bf(S[i][j]);
          if (seg == 3) { float* So = p.out + O_HP + (size_t)bh * 16384 + e4; *(f32x4*)So = S[i] * Ds[3 * 128 + dd] + *(const f32x4*)So; } } }
    const int qrow0 = tid >> 4, qc8 = (tid & 15) * 8;
    const int tb = wid & 3, vh = wid >> 2;
    const f32x4 onv[4] = { *(const f32x4*)(p.hgrn_onorm + h * 128 + (vh * 4 + 0) * 16 + fq * 4), *(const f32x4*)(p.hgrn_onorm + h * 128 + (vh * 4 + 1) * 16 + fq * 4),
                           *(const f32x4*)(p.hgrn_onorm + h * 128 + (vh * 4 + 2) * 16 + fq * 4), *(const f32x4*)(p.hgrn_onorm + h * 128 + (vh * 4 + 3) * 16 + fq * 4) };
    u32x4 nq[2];
#pragma unroll
    for (int i = 0; i < 2; ++i) nq[i] = *(const u32x4*)(QCg + ((size_t)seg * 512 + qrow0 + 32 * i) * 1024 + qc8);
    f32x4 nol[4]; u32x2 nog[4];
    { const size_t tokf = (size_t)seg * 512 + tb * 16 + fr;
#pragma unroll
      for (int vi = 0; vi < 4; ++vi) { nol[vi] = *(const f32x4*)(OLg + tokf * 1024 + (vh * 4 + vi) * 16 + fq * 4); nog[vi] = *(const u32x2*)(OGg + tokf * 1024 + (vh * 4 + vi) * 16 + fq * 4); } }
    for (int cc = 0; cc < 8; ++cc) {
        const size_t t0 = (size_t)seg * 512 + cc * 64;
#pragma unroll
        for (int i = 0; i < 2; ++i) *(LAS u32x4*)(QT + (qrow0 + 32 * i) * 136 + qc8) = nq[i];
        __syncthreads();
        if (cc + 1 < 8) {
#pragma unroll
            for (int i = 0; i < 2; ++i) nq[i] = *(const u32x4*)(QCg + (t0 + 64 + qrow0 + 32 * i) * 1024 + qc8); }
        const size_t tok = t0 + tb * 16 + fr;
        f32x4 oacc[4]; u32x2 ogv[4];
#pragma unroll
        for (int vi = 0; vi < 4; ++vi) { oacc[vi] = nol[vi]; ogv[vi] = nog[vi]; }
        if (cc + 1 < 8) {
#pragma unroll
            for (int vi = 0; vi < 4; ++vi) { nol[vi] = *(const f32x4*)(OLg + (tok + 64) * 1024 + (vh * 4 + vi) * 16 + fq * 4); nog[vi] = *(const u32x2*)(OGg + (tok + 64) * 1024 + (vh * 4 + vi) * 16 + fq * 4); } }
        { bf16x8 qf[4];
#pragma unroll
          for (int kk = 0; kk < 4; ++kk) qf[kk] = lds_frag(QT + (tb * 16 + fr) * 136 + kk * 32 + fq * 8);
#pragma unroll
          for (int vi = 0; vi < 4; ++vi) { const int vb = vh * 4 + vi; f32x4 a = oacc[vi];
#pragma unroll
              for (int kk = 0; kk < 4; ++kk) a = __builtin_amdgcn_mfma_f32_16x16x32_bf16(lds_frag(SB + (vb * 16 + fr) * 136 + kk * 32 + fq * 8), qf[kk], a, 0, 0, 0);
              oacc[vi] = a; } }
        { float ss = 0.f;
#pragma unroll
          for (int vi = 0; vi < 4; ++vi) ss += oacc[vi][0] * oacc[vi][0] + oacc[vi][1] * oacc[vi][1] + oacc[vi][2] * oacc[vi][2] + oacc[vi][3] * oacc[vi][3];
          ss += __shfl_xor(ss, 16); ss += __shfl_xor(ss, 32);
          if (fq == 0) SSQ[vh * 64 + tb * 16 + fr] = ss; }
        __syncthreads();
        { const float tot = SSQ[tb * 16 + fr] + SSQ[64 + tb * 16 + fr]; const float rs = rsqrtf(tot * (1.f / 128.f) + EPS);
#pragma unroll
          for (int vi = 0; vi < 4; ++vi) { const f32x4 o = oacc[vi] * rs * onv[vi];
              u32x2 w; w.x = cvt_pk_bf16(o[0] * bflo(ogv[vi].x), o[1] * bfhi(ogv[vi].x)); w.y = cvt_pk_bf16(o[2] * bflo(ogv[vi].y), o[3] * bfhi(ogv[vi].y));
              *(u32x2*)(Og + tok * 1024 + (vh * 4 + vi) * 16 + fq * 4) = w; } }
    }
    __syncthreads();
}

__device__ __forceinline__ float* part_slot(unsigned char* ws, int k) { return (float*)(ws + WS_PART + (size_t)k * PART_SLOT); }
__device__ __forceinline__ float row_ssq16(const float* slot, size_t row) {
    const f32x4* pp = (const f32x4*)(slot + row * 16); const f32x4 t = (pp[0] + pp[1]) + (pp[2] + pp[3]); return (t[0] + t[1]) + (t[2] + t[3]); }
__device__ __forceinline__ float row_ssq64(const float* slot, int r) {
    const f32x4* pp = (const f32x4*)(slot + (size_t)TP * 16 + (size_t)r * 64); f32x4 t = pp[0];
#pragma unroll
    for (int i = 1; i < 16; ++i) t = t + pp[i];
    return (t[0] + t[1]) + (t[2] + t[3]); }
__device__ __forceinline__ void phase_pool(const Params& p, LAS unsigned char* lds) {
    const int tid = threadIdx.x, c = tid * 2, gi = c >> 8, w = 2 << gi;
    LAS f32x2* ring = (LAS f32x2*)lds;
    const float* slot = part_slot(p.ws, 1);
    bf16_t* Z = (bf16_t*)(p.ws + WS_R2);
    const bf16_t* XBs = (const bf16_t*)(p.ws + WS_XB);
    const f32x2 gp = *(const f32x2*)(p.pool_norm + c);
    for (int unit = blockIdx.x; unit < 256; unit += gridDim.x) {
        const int b = unit >> 5, t0 = (unit & 31) * 64;
#pragma unroll
        for (int i = 0; i < 16; ++i) ring[i * 512 + tid] = (f32x2){0.f, 0.f};
        f32x2 sum = (f32x2){0.f, 0.f};
        LAS float* rsl = (LAS float*)(lds + 65536);
        __syncthreads();
        if (tid < 80) { const int t = t0 - 16 + tid; rsl[tid] = t >= 0 ? rsqrtf(row_ssq16(slot, (size_t)b * SEQ + t) * (1.f / 1024.f) + EPS) : 0.f; }
        __syncthreads();
        for (int tt = -16; tt < 64; tt += 16) {
            unsigned xw[16];
#pragma unroll
            for (int i = 0; i < 16; ++i) { const int t = t0 + tt + i; xw[i] = t >= 0 ? *(const unsigned*)(XBs + xb_off(b * SEQ + t, c)) : 0u; }
#pragma unroll
            for (int i = 0; i < 16; ++i) { const int t = t0 + tt + i; const float rs = rsl[tt + 16 + i];
                const f32x2 u = (f32x2){bflo(xw[i]), bfhi(xw[i])} * rs * gp;
                const f32x2 old = ring[((t - w) & 15) * 512 + tid];
                ring[(t & 15) * 512 + tid] = u; sum = sum + u - old;
                if (tt + i >= 0) { const float icnt = __builtin_amdgcn_rcpf((float)min(w, t + 1)); const f32x2 z = sum * icnt - u; const size_t row = (size_t)b * SEQ + t;
                    *(unsigned*)(Z + row * 1024 + c) = cvt_pk_bf16(z[0], z[1]);
                    if (t >= SEQ - 15) *(f32x2*)(p.out + O_PP + ((size_t)b * 15 + (t - (SEQ - 15))) * 1024 + c) = u; } }
        }
    }
    for (int sb = blockIdx.x; sb < TS; sb += gridDim.x) {
        const size_t row = (size_t)TP + sb;
        const float rs = rsqrtf(row_ssq64(slot, sb) * (1.f / 1024.f) + EPS);
        const f32x2 u = *(const f32x2*)(p.out + row * 1024 + c) * rs * gp;
        const float* hist = p.state_pool + (size_t)sb * 15 * 1024 + c;
        float* ho = p.out + O_PS + (size_t)sb * 15 * 1024 + c;
        f32x2 sum = u;
#pragma unroll
        for (int j = 0; j < 15; ++j) { const f32x2 hv = *(const f32x2*)(hist + (size_t)j * 1024); if (j >= 16 - w) sum = sum + hv; if (j >= 1) *(f32x2*)(ho + (size_t)(j - 1) * 1024) = hv; }
        *(f32x2*)(ho + (size_t)14 * 1024) = u;
        const f32x2 z = sum / (float)w - u;
        *(unsigned*)(Z + row * 1024 + c) = cvt_pk_bf16(z[0], z[1]);
    }
}

__device__ __forceinline__ void phase_final(const Params& p) {
    const int tid = threadIdx.x, wid = tid >> 6, lane = tid & 63;
    const float* slot = part_slot(p.ws, 3);
    const int r = blockIdx.x * 8 + wid;
    if (r < TS) {
        float* xr = p.out + O_YS + (size_t)r * 1024;
        const float rs = rsqrtf(wave_sum(slot[(size_t)TP * 16 + (size_t)r * 64 + lane]) * (1.f / 1024.f) + EPS);
#pragma unroll
        for (int j = 0; j < 4; ++j) { const f32x4 v = *(const f32x4*)(xr + lane * 4 + 256 * j); const f32x4 g = *(const f32x4*)(p.final_norm + lane * 4 + 256 * j); *(f32x4*)(xr + lane * 4 + 256 * j) = v * rs * g; }
    }
}

#define XB_TMO      128
#define XB_XCNT(j)  (256  + 64 * (j))
#define XB_XSUB(j)  (1280 + 64 * (j))
#define XB_XGEN(j)  (2304 + 64 * (j))
#define XB_TOP      3328
#define XB_TOPGEN   3392
#define XCD_BAR_WORDS 3456
#define XB_SPIN_CAP (1u << 18)
__device__ __forceinline__ unsigned xb_ld(unsigned* p)              { return __hip_atomic_load(p, __ATOMIC_RELAXED, __HIP_MEMORY_SCOPE_AGENT); }
__device__ __forceinline__ unsigned xb_add(unsigned* p, unsigned v) { return __hip_atomic_fetch_add(p, v, __ATOMIC_RELAXED, __HIP_MEMORY_SCOPE_AGENT); }
__device__ __forceinline__ unsigned xb_xcc_id() { return (unsigned)__builtin_amdgcn_s_getreg((3 << 11) | 20) & 0xFu; }
#define XB_SPIN(cond, bar) do { unsigned _sp = 0; while (cond) { __builtin_amdgcn_s_sleep(1); \
    if ((++_sp & 255u) == 0u) { if (xb_ld(&(bar)[XB_TMO])) break; if (_sp > XB_SPIN_CAP) { atomicAdd(&(bar)[XB_TMO], 1u); break; } } } } while (0)
struct XcdBarrier { unsigned* bar; unsigned x; volatile LAS unsigned* st; };
__device__ __forceinline__ XcdBarrier xcd_barrier_post(unsigned* bar, volatile LAS unsigned* st) {
    XcdBarrier b; b.bar = bar; b.x = xb_xcc_id(); b.st = st;
    if (threadIdx.x == 0) (void)xb_add(&bar[XB_XCNT(b.x)], 1u);
    return b;
}
__device__ __forceinline__ void xcd_barrier_complete(unsigned* bar, unsigned x, unsigned& nloc, unsigned& nx) {
    const unsigned G = gridDim.x * gridDim.y * gridDim.z;
    unsigned sum, cnt, mine, sp = 0u;
    for (;;) {
        sum = 0u; cnt = 0u; mine = 0u;
#pragma unroll
        for (unsigned j = 0; j < 16; ++j) { const unsigned c = xb_ld(&bar[XB_XCNT(j)]); sum += c; cnt += (c > 0u) ? 1u : 0u; mine = (j == x) ? c : mine; }
        if (sum == G) break;
        __builtin_amdgcn_s_sleep(1);
        if ((++sp & 255u) == 0u) { if (xb_ld(&bar[XB_TMO])) break; if (sp > XB_SPIN_CAP) { atomicAdd(&bar[XB_TMO], 1u); break; } }
    }
    nloc = mine > 0u ? mine : 1u; nx = cnt > 0u ? cnt : 1u;
}
__device__ __forceinline__ void xcd_barrier(const XcdBarrier& b) {
    asm volatile("s_waitcnt vmcnt(0)" ::: "memory");
    __syncthreads();
    if (threadIdx.x == 0) {
        unsigned* bar = b.bar;
        __builtin_amdgcn_s_waitcnt(0);
        unsigned nloc = b.st[0], nx = b.st[1];
        if (nloc == 0u) { xcd_barrier_complete(bar, b.x, nloc, nx); b.st[0] = nloc; b.st[1] = nx; }
        const unsigned old = xb_add(&bar[XB_XSUB(b.x)], 1u);
        const unsigned gen = old / nloc;
        if (old + 1u == (gen + 1u) * nloc) {
            __builtin_amdgcn_fence(__ATOMIC_RELEASE, "agent");
            asm volatile("s_waitcnt vmcnt(0)" ::: "memory");
            const unsigned og = xb_add(&bar[XB_TOP], 1u);
            const unsigned tg = og / nx;
            if (og + 1u == (tg + 1u) * nx) xb_add(&bar[XB_TOPGEN], 1u);
            else XB_SPIN(xb_ld(&bar[XB_TOPGEN]) == tg, bar);
            __builtin_amdgcn_fence(__ATOMIC_ACQUIRE, "agent");
            xb_add(&bar[XB_XGEN(b.x)], 1u);
            asm volatile("s_waitcnt vmcnt(0)" ::: "memory");
        } else {
            XB_SPIN(xb_ld(&bar[XB_XGEN(b.x)]) == gen, bar);
            __builtin_amdgcn_fence(__ATOMIC_ACQUIRE, "agent");
            asm volatile("s_waitcnt vmcnt(0)" ::: "memory");
        }
    }
    __syncthreads();
}
#define PH_ON(n) ((PHMASK & (1 << (n))) && p.ph_lo <= (n) && (n) < p.ph_hi)
#define PH_SYNC(n) do { if (p.ph_lo < (n) && (n) < p.ph_hi) { xcd_barrier(xb); } } while (0)
__device__ __forceinline__ void ph_in(const Params& p, LAS unsigned char* lds) {
    unsigned char* ws = p.ws; pg8::StaticOrder S;
    EpiIn E{(bf16_t*)(ws + WS_Q), (bf16_t*)(ws + WS_V), (bf16_t*)(ws + WS_OG), (bf16_t*)(ws + WS_G), (const float*)(ws + WS_LB)};
    pg8::Gemm g{(const bf16_t*)(ws + WS_R2), (const bf16_t*)(ws + WS_WIN), TP, 4096, 1024, 1024, 0};
    S.init(g.M, g.N, gridDim.x, blockIdx.x); pg8::gemm_phase(lds, g, S, E);
    SIn F{E.Q, E.V, E.OG, E.G, (const float*)(ws + WS_LB)};
    sample_gemm<4>(lds, (const bf16_t*)(ws + WS_R2) + (size_t)TP * 1024, 1024, 0, (const bf16_t*)(ws + WS_WIN), 1024, F);
}
__device__ __forceinline__ void ph_rec1(const Params& p, LAS unsigned char* lds) {
    for (int it = blockIdx.x; it < 256; it += gridDim.x) { const int seg = it & 3, bh = it >> 2; rec_prompt(p, lds, bh >> 3, bh & 7, seg); }
}
__device__ __forceinline__ void ph_rec2(const Params& p, LAS unsigned char* lds) {
    for (int it = blockIdx.x; it < 256; it += gridDim.x) { const int seg = it & 3, bh = it >> 2; if (seg > 0) rec_fix(p, lds, bh >> 3, bh & 7, seg); }
    if (gridDim.x == 256) {
        const int seg = blockIdx.x & 3, bh = blockIdx.x >> 2;
        if (seg == 0) rec_sample_list(p, lds, bh * 10, 1, 10);
        else { const int k = bh * 3 + (seg - 1); rec_sample_list(p, lds, 640 + k, 192, 2); }
    } else rec_sample_list(p, lds, blockIdx.x, gridDim.x, (TS * 8 - (int)blockIdx.x + (int)gridDim.x - 1) / (int)gridDim.x);
}
__device__ __forceinline__ void ph_out(const Params& p, LAS unsigned char* lds, bool dummy = false) {
    unsigned char* ws = p.ws; pg8::StaticOrder S; float* slot = dummy ? (float*)nullptr : part_slot(ws, 0);
    EpiRes<false, false> E{p.x_prompt, nullptr, nullptr, (bf16_t*)(ws + WS_XB), nullptr, slot};
    pg8::Gemm g{(const bf16_t*)(ws + WS_R2), (const bf16_t*)(ws + WS_WOUT), TP, 1024, 1024, 1024, 0};
    S.init(g.M, g.N, gridDim.x, blockIdx.x); pg8::gemm_phase(lds, g, S, E);
    SRes F{p.x_sample, p.out + O_YS, (bf16_t*)(ws + WS_XB) + (size_t)TP * 1024, nullptr, dummy ? (float*)nullptr : slot + (size_t)TP * 16};
    sample_gemm<1>(lds, (const bf16_t*)(ws + WS_R2) + (size_t)TP * 1024, 1024, 0, (const bf16_t*)(ws + WS_WOUT), 1024, F);
}
__device__ __forceinline__ void ph_up(const Params& p, LAS unsigned char* lds, int L) {
    unsigned char* ws = p.ws; pg8::StaticOrder S; float* sq = part_slot(ws, L ? 2 : 0);
    const bf16_t* W = (const bf16_t*)(ws + (L ? WS_WUP1 : WS_WUP0));
    EpiUp E{(bf16_t*)(ws + WS_H), sq};
    pg8::Gemm g{(const bf16_t*)(ws + WS_XB), W, TP, 4096, 1024, 64, 0, 256 * 64 * 2, 256 * 1024 * 2};
    S.init(g.M, g.N, gridDim.x, blockIdx.x); pg8::gemm_phase(lds, g, S, E);
    SUp F{(bf16_t*)(ws + WS_H) + (size_t)TP * 4096, sq + (size_t)TP * 16};
    sample_gemm<4>(lds, (const bf16_t*)(ws + WS_XB) + (size_t)TP * 1024, 1024, 0, W, 1024, F);
}
__device__ __forceinline__ void ph_down(const Params& p, LAS unsigned char* lds, int L) {
    unsigned char* ws = p.ws; pg8::StaticOrder S; float* sq = part_slot(ws, L ? 3 : 1);
    const bf16_t* W = (const bf16_t*)(ws + (L ? WS_WDN1 : WS_WDN0));
    pg8::Gemm g{(const bf16_t*)(ws + WS_H), W, TP, 1024, 4096, 64, 0, 256 * 64 * 2, 256 * 4096 * 2};
    S.init(g.M, g.N, gridDim.x, blockIdx.x);
    if (L == 0) { EpiRes<true, false> E{nullptr, (const bf16_t*)(ws + WS_XB), nullptr, (bf16_t*)(ws + WS_XB), nullptr, sq}; pg8::gemm_phase(lds, g, S, E); }
    else { EpiFinal E{(const bf16_t*)(ws + WS_XB), p.out, p.final_norm, sq, (unsigned*)(ws + WS_BAR) + XCD_BAR_WORDS}; pg8::gemm_phase(lds, g, S, E); }
    SRes F{p.out + O_YS, p.out + O_YS, nullptr, nullptr, sq + (size_t)TP * 16};
    sample_gemm<1>(lds, (const bf16_t*)(ws + WS_H) + (size_t)TP * 4096, 4096, 0, W, 4096, F);
}
__device__ __forceinline__ void ph_poolg(const Params& p, LAS unsigned char* lds) {
    unsigned char* ws = p.ws; pg8::StaticOrder S; float* sq = part_slot(ws, 2);
    EpiRes<true, false> E{nullptr, (const bf16_t*)(ws + WS_XB), nullptr, (bf16_t*)(ws + WS_XB), p.pool_scale, sq};
    pg8::Gemm g{(const bf16_t*)(ws + WS_R2), (const bf16_t*)(ws + WS_WP), TP, 1024, 256, 1024, 256};
    S.init(g.M, g.N, gridDim.x, blockIdx.x); pg8::gemm_phase(lds, g, S, E);
    SRes F{p.out + O_YS, p.out + O_YS, (bf16_t*)(ws + WS_XB) + (size_t)TP * 1024, p.pool_scale, sq + (size_t)TP * 16};
    sample_gemm<1>(lds, (const bf16_t*)(ws + WS_R2) + (size_t)TP * 1024, 1024, 256, (const bf16_t*)(ws + WS_WP), 256, F);
}
__global__ void __launch_bounds__(512, 2) mega(Params p) {
    extern __shared__ __attribute__((aligned(16))) unsigned char shm[];
    LAS unsigned char* lds = (LAS unsigned char*)shm;
    volatile LAS unsigned* xst = (volatile LAS unsigned*)(lds + 151552);
    if (threadIdx.x == 0) { xst[0] = 0u; xst[1] = 0u; }
    __syncthreads();
    const XcdBarrier xb = xcd_barrier_post((unsigned*)(p.ws + WS_BAR), xst);
    if (p.ph_hi > 4096) cg::this_grid().sync();
    phase_prep(p, lds);
    if (DUP_PHASE == 0) { xcd_barrier(xb); phase_prep(p, lds); }
    if (DUP_PHASE == 20) { for (int i = 0; i < 20; ++i) xcd_barrier(xb); }
    xcd_barrier(xb); ph_in(p, lds);
    if (DUP_PHASE == 1) { xcd_barrier(xb); ph_in(p, lds); }
    xcd_barrier(xb); ph_rec1(p, lds);
    if (DUP_PHASE == 2) { xcd_barrier(xb); ph_rec1(p, lds); }
    xcd_barrier(xb); ph_rec2(p, lds);
    xcd_barrier(xb); ph_out(p, lds);
    if (DUP_PHASE == 3) { xcd_barrier(xb); ph_out(p, lds); }
    xcd_barrier(xb); ph_up(p, lds, 0);
    if (DUP_PHASE == 4) { xcd_barrier(xb); ph_up(p, lds, 0); }
    xcd_barrier(xb); ph_down(p, lds, 0);
    xcd_barrier(xb); phase_pool(p, lds);
    if (DUP_PHASE == 6) { xcd_barrier(xb); phase_pool(p, lds); }
    xcd_barrier(xb); ph_poolg(p, lds);
    xcd_barrier(xb); ph_up(p, lds, 1);
    xcd_barrier(xb); ph_down(p, lds, 1);
    if (DUP_PHASE == 9) { xcd_barrier(xb); ph_down(p, lds, 1); }
    xcd_barrier(xb);
    phase_final(p);
}

extern "C" void kernel_launch(void* const* d_in, const int* in_sizes, int n_in, void* d_out, int out_size, void* d_ws, size_t ws_size, hipStream_t stream) {
    static int grid = 0;
    if (grid == 0) {
        int dev = 0, cus = 0, per_cu = 0;
        hipGetDevice(&dev);
        hipDeviceGetAttribute(&cus, hipDeviceAttributeMultiprocessorCount, dev);
        if (hipFuncSetAttribute((const void*)mega, hipFuncAttributeMaxDynamicSharedMemorySize, LDS_BYTES) != hipSuccess) fprintf(stderr, "kernel_launch: hipFuncSetAttribute failed\n");
        if (hipOccupancyMaxActiveBlocksPerMultiprocessor(&per_cu, (const void*)mega, 512, LDS_BYTES) != hipSuccess || per_cu < 1) { fprintf(stderr, "kernel_launch: occupancy query gave %d\n", per_cu); per_cu = 1; }
        (void)hipGetLastError();
        grid = cus * per_cu;
        if (ws_size < WS_END3) fprintf(stderr, "kernel_launch: workspace too small: %zu < %zu\n", ws_size, (size_t)WS_END3);
        fprintf(stderr, "kernel_launch: grid %d (cus %d x %d), ws %zu\n", grid, cus, per_cu, ws_size);
    }
    Params p{};
    const float** pp = (const float**)&p;
    for (int i = 0; i < 16; ++i) pp[i] = (const float*)d_in[i];
    p.out = (float*)d_out; p.ws = (unsigned char*)d_ws;
    (void)hipMemsetAsync((unsigned char*)d_ws + WS_BAR, 0, 16384, stream);
    p.ph_lo = 0; p.ph_hi = NPHASE;
    void* args[] = {&p};
    hipError_t e = hipLaunchCooperativeKernel((const void*)mega, dim3(grid), dim3(512), args, LDS_BYTES, stream);
    if (e != hipSuccess) fprintf(stderr, "cooperative launch failed: %s (grid %d)\n", hipGetErrorString(e), grid);
}
```
